# Optimizing an MI355X kernel written in HIP

```python
import math
import jax, jax.numpy as jnp
from jax import lax
import numpy as np


D_MODEL = 1024
BATCH = 4
SEQ = 4096
DEPTH = 4
DEC_BATCH = 128
DEC_SEQ = 1
PAST_LEN = 2048
PAGE_SIZE = 128

N_A_LAYERS = DEPTH // 2
N_B_LAYERS = DEPTH - N_A_LAYERS
HEAD_DIM = 64
MIX_W = 3 * D_MODEL // 4
MEM_W = D_MODEL // 4
MEM_HEADS = MEM_W // HEAD_DIM
MEM_TOKENS = 256
SSM_GROUP = 16
SSM_GROUPS = MIX_W // SSM_GROUP
SSM_STATE = 64
DT_MIN = 0.001
DT_MAX = 0.1
MOBA_HEADS = MIX_W // HEAD_DIM
MOBA_KV_HEADS = 4
KV_W = MOBA_KV_HEADS * HEAD_DIM
MOBA_BLOCK = 256
MOBA_TOPK = 3
Q_BLOCK = 64
D_FF = ((-(-8 * D_MODEL // 3) + 255) // 256) * 256
EPS = 1e-6

kernel_name = 'yoco_s5_moba_memory_decoder_step'


def _rmsnorm(x, g):
    x32 = x.astype(jnp.float32)
    y = x32 * lax.rsqrt(jnp.mean(x32 * x32, axis=-1, keepdims=True) + EPS)
    return (y * g.astype(jnp.float32)).astype(x.dtype)


def _swiglu(a, w_gu, w_down):
    g, u = jnp.split(a @ w_gu, 2, axis=-1)
    return (jax.nn.silu(g) * u) @ w_down


def _complex_affine_combine(e1, e2):
    a1r, a1i, b1r, b1i = e1
    a2r, a2i, b2r, b2i = e2
    return (a2r * a1r - a2i * a1i, a2r * a1i + a2i * a1r,
            a2r * b1r - a2i * b1i + b2r, a2r * b1i + a2i * b1r + b2i)


def _s5_mixer(u, h0_re, h0_im, a_re, a_im, log_dt, b_re, b_im, c_re, c_im, d_skip, w_glu):
    f32 = jnp.float32
    bsz, seq, _ = u.shape
    uf = u.astype(f32).reshape(bsz, seq, SSM_GROUPS, SSM_GROUP)
    dt = jnp.exp(log_dt.astype(f32))[:, None]
    lam_re = jnp.minimum(a_re.astype(f32), -1e-4)
    lam_im = a_im.astype(f32)
    mag = jnp.exp(dt * lam_re)
    ang = dt * lam_im
    ab_re, ab_im = mag * jnp.cos(ang), mag * jnp.sin(ang)
    den = lam_re * lam_re + lam_im * lam_im
    num_re = ab_re - 1.0
    f_re = (num_re * lam_re + ab_im * lam_im) / den
    f_im = (ab_im * lam_re - num_re * lam_im) / den
    b_re32, b_im32 = b_re.astype(f32), b_im.astype(f32)
    bb_re = f_re[..., None] * b_re32 - f_im[..., None] * b_im32
    bb_im = f_re[..., None] * b_im32 + f_im[..., None] * b_re32
    bu_re = jnp.einsum('blgh,gph->lbgp', uf, bb_re)
    bu_im = jnp.einsum('blgh,gph->lbgp', uf, bb_im)
    a_l_re = jnp.broadcast_to(ab_re[None, None], (seq, 1) + ab_re.shape)
    a_l_im = jnp.broadcast_to(ab_im[None, None], (seq, 1) + ab_im.shape)
    cum_re, cum_im, x_re, x_im = lax.associative_scan(
        _complex_affine_combine, (a_l_re, a_l_im, bu_re, bu_im), axis=0)
    h_re = h0_re.astype(f32)[None]
    h_im = h0_im.astype(f32)[None]
    xr = x_re + cum_re * h_re - cum_im * h_im
    xi = x_im + cum_re * h_im + cum_im * h_re
    y = (jnp.einsum('lbgp,ghp->blgh', xr, c_re.astype(f32))
         - jnp.einsum('lbgp,ghp->blgh', xi, c_im.astype(f32))
         + d_skip.astype(f32) * uf)
    y = jax.nn.gelu(y.reshape(bsz, seq, MIX_W))
    y = y * jax.nn.sigmoid(y @ w_glu.astype(f32))
    return y.astype(u.dtype), xr[-1], xi[-1]


def _moba_attend(q, k, v, q_pos0):
    f32 = jnp.float32
    bq, lq, nh, hd = q.shape
    t_len = k.shape[1]
    nb = -(-t_len // MOBA_BLOCK)
    pad = nb * MOBA_BLOCK - t_len
    kp = jnp.pad(k, ((0, 0), (0, pad), (0, 0), (0, 0))).reshape(bq, nb, MOBA_BLOCK, MOBA_KV_HEADS, hd)
    vp = jnp.pad(v, ((0, 0), (0, pad), (0, 0), (0, 0))).reshape(bq, nb, MOBA_BLOCK, MOBA_KV_HEADS, hd)
    kmean = jnp.mean(kp.astype(f32), axis=2)
    kv_of_h = jnp.arange(nh, dtype=jnp.int32) // (nh // MOBA_KV_HEADS)
    qb = math.gcd(lq, Q_BLOCK)
    nq = lq // qb
    k_sel = min(MOBA_TOPK, nb)
    q_items = q.reshape(bq * nq, qb, nh, hd)
    b_items = jnp.repeat(jnp.arange(bq, dtype=jnp.int32), nq)
    p_items = q_pos0 + jnp.tile(jnp.arange(nq, dtype=jnp.int32) * qb, bq)
    scale = HEAD_DIM ** -0.5

    def one(item):
        qi, b, p0 = item
        qi32 = qi.astype(f32)
        pos = p0 + jnp.arange(qb, dtype=jnp.int32)
        blk = pos // MOBA_BLOCK
        gate = jnp.einsum('qhd,jhd->qhj', qi32, kmean[b][:, kv_of_h])
        past = jnp.arange(nb, dtype=jnp.int32)[None, None, :] < blk[:, None, None]
        gate = jnp.where(past, gate, -jnp.inf)
        _, top = lax.top_k(gate, k_sel)
        slot_ok = jnp.broadcast_to(jnp.arange(k_sel, dtype=jnp.int32)[None, None, :] < blk[:, None, None], (qb, nh, k_sel))
        own = jnp.broadcast_to(blk[:, None, None], (qb, nh, 1))
        idx = jnp.concatenate([top.astype(jnp.int32), own], axis=-1)
        ok = jnp.concatenate([slot_ok, jnp.ones((qb, nh, 1), bool)], axis=-1)
        kh = kv_of_h[None, :, None]
        kg = kp[b, idx, :, kh].astype(f32)
        vg = vp[b, idx, :, kh].astype(f32)
        s = jnp.einsum('qhd,qhsnd->qhsn', qi32, kg) * scale
        kpos = idx[..., None] * MOBA_BLOCK + jnp.arange(MOBA_BLOCK, dtype=jnp.int32)
        mask = ok[..., None] & (kpos <= pos[:, None, None, None])
        s = jnp.where(mask, s, -jnp.inf)
        pr = jax.nn.softmax(s.reshape(qb, nh, -1), axis=-1).reshape(s.shape)
        return jnp.einsum('qhsn,qhsnd->qhd', pr, vg).astype(q.dtype)

    out = lax.map(one, (q_items, b_items, p_items))
    return out.reshape(bq, lq, nh, hd)


def _mem_kv(mem, g_mem, w_mem_kv, g_mk):
    m = _rmsnorm(mem, g_mem)
    mk, mv = jnp.split(m @ w_mem_kv, 2, axis=-1)
    bsz, nm, _ = mem.shape
    mk = _rmsnorm(mk.reshape(bsz, nm, MEM_HEADS, HEAD_DIM), g_mk)
    return mk, mv.reshape(bsz, nm, MEM_HEADS, HEAD_DIM)


def _mem_attend(q, mk, mv):
    s = jnp.einsum('blhd,bmhd->bhlm', q.astype(jnp.float32), mk.astype(jnp.float32)) * (HEAD_DIM ** -0.5)
    pr = jax.nn.softmax(s, axis=-1)
    return jnp.einsum('bhlm,bmhd->blhd', pr, mv.astype(jnp.float32)).astype(q.dtype)


def _shared_kv(h, g_kv, w_kv, g_k):
    a = _rmsnorm(h, g_kv)
    k, v = jnp.split(a @ w_kv, 2, axis=-1)
    bsz, seq, _ = h.shape
    k = _rmsnorm(k.reshape(bsz, seq, MOBA_KV_HEADS, HEAD_DIM), g_k)
    return k, v.reshape(bsz, seq, MOBA_KV_HEADS, HEAD_DIM)


def _run_trunk(x, pos0, h0_re, h0_im, mem_k, mem_v, k_past, v_past, p):
    bsz, seq, _ = x.shape
    h = x
    fin_re, fin_im = [], []
    k_new = v_new = k_all = v_all = None
    for l in range(DEPTH):
        a = _rmsnorm(h, p['g_mix'][l])
        proj = a @ p['w_in'][l]
        mix_in, mq = proj[..., :MIX_W], proj[..., MIX_W:]
        if l < N_A_LAYERS:
            mix_out, fr, fi = _s5_mixer(mix_in, h0_re[l], h0_im[l], p['ssm_a_re'][l], p['ssm_a_im'][l],
                                        p['ssm_log_dt'][l], p['ssm_b_re'][l], p['ssm_b_im'][l],
                                        p['ssm_c_re'][l], p['ssm_c_im'][l], p['ssm_d'][l], p['w_glu'][l])
            fin_re.append(fr.astype(h0_re.dtype))
            fin_im.append(fi.astype(h0_im.dtype))
        else:
            j = l - N_A_LAYERS
            q = _rmsnorm(mix_in.reshape(bsz, seq, MOBA_HEADS, HEAD_DIM), p['g_q'][j])
            mix_out = _moba_attend(q, k_all, v_all, pos0).reshape(bsz, seq, MIX_W)
        mqh = _rmsnorm(mq.reshape(bsz, seq, MEM_HEADS, HEAD_DIM), p['g_mq'][l])
        mem_out = _mem_attend(mqh, mem_k[l], mem_v[l]).reshape(bsz, seq, MEM_W)
        h = h + jnp.concatenate([mix_out, mem_out], axis=-1) @ p['w_out'][l]
        h = h + _swiglu(_rmsnorm(h, p['g_ffn'][l]), p['w_gu'][l], p['w_down'][l])
        if l == N_A_LAYERS - 1:
            k_new, v_new = _shared_kv(h, p['g_kv'], p['w_kv'], p['g_k'])
            k_all = jnp.concatenate([k_past.astype(k_new.dtype), k_new], axis=1)
            v_all = jnp.concatenate([v_past.astype(v_new.dtype), v_new], axis=1)
    return h, jnp.stack(fin_re), jnp.stack(fin_im), k_new, v_new


def setup_inputs(seed: int = 0) -> dict:
    key = jax.random.key(seed)
    ks = jax.random.split(key, 40)
    f32 = jnp.float32

    def nrm(i, shape, scale):
        return jax.random.normal(ks[i], shape, f32) * scale

    n_pages = PAST_LEN // PAGE_SIZE
    n_used = DEC_BATCH * n_pages
    n_phys = n_used + max(1, n_used // 4)
    page_table = jax.random.permutation(ks[0], n_phys)[:n_used].reshape(DEC_BATCH, n_pages).astype(jnp.int32)
    mix_total = MIX_W + MEM_W
    return {
        'x_prompt': nrm(1, (BATCH, SEQ, D_MODEL), 1.0),
        'x_sample': nrm(2, (DEC_BATCH, DEC_SEQ, D_MODEL), 1.0),
        'mem_prompt': nrm(3, (BATCH, MEM_TOKENS, D_MODEL), 1.0),
        'state_ssm_re': nrm(4, (N_A_LAYERS, DEC_BATCH, SSM_GROUPS, SSM_STATE), 0.1),
        'state_ssm_im': nrm(5, (N_A_LAYERS, DEC_BATCH, SSM_GROUPS, SSM_STATE), 0.1),
        'cache_k': nrm(6, (n_phys, PAGE_SIZE, MOBA_KV_HEADS, HEAD_DIM), 1.0),
        'cache_v': nrm(7, (n_phys, PAGE_SIZE, MOBA_KV_HEADS, HEAD_DIM), 1.0),
        'page_table': page_table,
        'cache_mem_k': nrm(8, (DEPTH, DEC_BATCH, MEM_TOKENS, MEM_HEADS, HEAD_DIM), 1.0),
        'cache_mem_v': nrm(9, (DEPTH, DEC_BATCH, MEM_TOKENS, MEM_HEADS, HEAD_DIM), 1.0),
        'g_mix': 1.0 + nrm(10, (DEPTH, D_MODEL), 0.02),
        'w_in': nrm(11, (DEPTH, D_MODEL, mix_total), D_MODEL ** -0.5),
        'w_out': nrm(12, (DEPTH, mix_total, D_MODEL), mix_total ** -0.5),
        'g_ffn': 1.0 + nrm(13, (DEPTH, D_MODEL), 0.02),
        'w_gu': nrm(14, (DEPTH, D_MODEL, 2 * D_FF), D_MODEL ** -0.5),
        'w_down': nrm(15, (DEPTH, D_FF, D_MODEL), D_FF ** -0.5),
        'ssm_a_re': -0.5 + nrm(16, (N_A_LAYERS, SSM_GROUPS, SSM_STATE), 0.01),
        'ssm_a_im': jnp.pi * jnp.arange(SSM_STATE, dtype=f32) + nrm(17, (N_A_LAYERS, SSM_GROUPS, SSM_STATE), 0.01),
        'ssm_log_dt': jax.random.uniform(ks[18], (N_A_LAYERS, SSM_GROUPS), f32, math.log(DT_MIN), math.log(DT_MAX)),
        'ssm_b_re': nrm(19, (N_A_LAYERS, SSM_GROUPS, SSM_STATE, SSM_GROUP), (2.0 * SSM_GROUP) ** -0.5),
        'ssm_b_im': nrm(20, (N_A_LAYERS, SSM_GROUPS, SSM_STATE, SSM_GROUP), (2.0 * SSM_GROUP) ** -0.5),
        'ssm_c_re': nrm(21, (N_A_LAYERS, SSM_GROUPS, SSM_GROUP, SSM_STATE), SSM_STATE ** -0.25),
        'ssm_c_im': nrm(22, (N_A_LAYERS, SSM_GROUPS, SSM_GROUP, SSM_STATE), SSM_STATE ** -0.25),
        'ssm_d': 1.0 + nrm(23, (N_A_LAYERS, SSM_GROUPS, SSM_GROUP), 0.02),
        'w_glu': nrm(24, (N_A_LAYERS, MIX_W, MIX_W), MIX_W ** -0.5),
        'g_q': 1.0 + nrm(25, (N_B_LAYERS, HEAD_DIM), 0.02),
        'g_mq': 1.0 + nrm(26, (DEPTH, HEAD_DIM), 0.02),
        'g_mem': 1.0 + nrm(27, (DEPTH, D_MODEL), 0.02),
        'w_mem_kv': nrm(28, (DEPTH, D_MODEL, 2 * MEM_W), D_MODEL ** -0.5),
        'g_mk': 1.0 + nrm(29, (DEPTH, HEAD_DIM), 0.02),
        'g_kv': 1.0 + nrm(30, (D_MODEL,), 0.02),
        'w_kv': nrm(31, (D_MODEL, 2 * KV_W), D_MODEL ** -0.5),
        'g_k': 1.0 + nrm(32, (HEAD_DIM,), 0.02),
    }


def reference(x_prompt, x_sample, mem_prompt, state_ssm_re, state_ssm_im, cache_k, cache_v, page_table,
              cache_mem_k, cache_mem_v, g_mix, w_in, w_out, g_ffn, w_gu, w_down, ssm_a_re, ssm_a_im,
              ssm_log_dt, ssm_b_re, ssm_b_im, ssm_c_re, ssm_c_im, ssm_d, w_glu, g_q, g_mq, g_mem,
              w_mem_kv, g_mk, g_kv, w_kv, g_k):
    p = dict(g_mix=g_mix, w_in=w_in, w_out=w_out, g_ffn=g_ffn, w_gu=w_gu, w_down=w_down,
             ssm_a_re=ssm_a_re, ssm_a_im=ssm_a_im, ssm_log_dt=ssm_log_dt, ssm_b_re=ssm_b_re,
             ssm_b_im=ssm_b_im, ssm_c_re=ssm_c_re, ssm_c_im=ssm_c_im, ssm_d=ssm_d, w_glu=w_glu,
             g_q=g_q, g_mq=g_mq, g_kv=g_kv, w_kv=w_kv, g_k=g_k)
    mks, mvs = [], []
    for l in range(DEPTH):
        mk, mv = _mem_kv(mem_prompt, g_mem[l], w_mem_kv[l], g_mk[l])
        mks.append(mk)
        mvs.append(mv)
    p_mem_k = jnp.stack(mks)
    p_mem_v = jnp.stack(mvs)
    bp = x_prompt.shape[0]
    h0 = jnp.zeros((N_A_LAYERS, bp, SSM_GROUPS, SSM_STATE), state_ssm_re.dtype)
    kv_empty = jnp.zeros((bp, 0, MOBA_KV_HEADS, HEAD_DIM), x_prompt.dtype)
    y_prompt, p_ssm_re, p_ssm_im, p_k, p_v = _run_trunk(
        x_prompt, 0, h0, h0, p_mem_k, p_mem_v, kv_empty, kv_empty, p)
    bs = x_sample.shape[0]
    n_pages = page_table.shape[1]
    past_len = n_pages * cache_k.shape[1]
    k_past = cache_k[page_table].reshape(bs, past_len, MOBA_KV_HEADS, HEAD_DIM)
    v_past = cache_v[page_table].reshape(bs, past_len, MOBA_KV_HEADS, HEAD_DIM)
    y_sample, s_ssm_re, s_ssm_im, s_k, s_v = _run_trunk(
        x_sample, past_len, state_ssm_re, state_ssm_im, cache_mem_k, cache_mem_v, k_past, v_past, p)
    return (y_prompt, y_sample, p_ssm_re, p_ssm_im, p_k, p_v, p_mem_k, p_mem_v, s_ssm_re, s_ssm_im, s_k, s_v)
```

```cpp
#include <hip/hip_runtime.h>
#include <cstdio>
#include <cstdint>
#include <cmath>
#define MK_ONE_LAUNCH 1
namespace pg8 {
#define PG8_LAS __attribute__((address_space(3)))
typedef unsigned short bf16_t;
typedef short bf16x8 __attribute__((ext_vector_type(8)));
typedef float f32x4 __attribute__((ext_vector_type(4)));
typedef unsigned u32x4 __attribute__((ext_vector_type(4)));
constexpr int BM = 256, BK = 64, HALF = 128, HTB = HALF * BK * 2  , STAGE_BYTES = 8 * HTB, NXCD = 8, WGM = 8;

__host__ __device__ __forceinline__ int lds_byte(int r, int c) { const int st = (r >> 4) * 2 + (c >> 5), rr = r & 15, cc = c & 31, ob = rr * 64 + cc * 2; return st * 1024 + (ob ^ (((ob >> 9) & 1) << 5)); }
__host__ __device__ __forceinline__ void stage_rc(int b, int& R, int& C) { const int st = b / 1024, sb = b % 1024, swz = sb ^ (((sb >> 9) & 1) << 5); R = (st >> 1) * 16 + swz / 64; C = (st & 1) * 32 + (swz % 64) / 2; }
__host__ __device__ __forceinline__ int perm32(int rho) { const int n = rho >> 4, i = rho & 15; return 8 * (i >> 2) + 4 * n + (i & 3); }

struct Unit { int pm, pn; };
struct Gemm { const bf16_t* A; const bf16_t* Bt; int M, N, K; };

struct StaticOrder {
    int nM, nN, nwg, G, c;
    __host__ __device__ void init(int M, int N, int G_, int c_) { nM = M / BM; nN = N / BM; nwg = nM * nN; G = G_; c = c_; }
    __host__ __device__ bool next(int i, Unit& u) const {
        const long L = (long)i * G + c; if (L >= nwg) return false;
        int wgid = (int)L; { const int q = nwg / NXCD, r = nwg % NXCD, xcd = wgid % NXCD, off = wgid / NXCD; wgid = (xcd < r ? xcd * (q + 1) : r * (q + 1) + (xcd - r) * q) + off; }
        const int nig = WGM * nN, gid = wgid / nig, fm = gid * WGM, gsz = (nM - fm) < WGM ? (nM - fm) : WGM;
        u.pm = fm + ((wgid % nig) % gsz); u.pn = (wgid % nig) / gsz; return true;
    }
    __device__ __forceinline__ void a_ready(const Unit&) const {}
    __device__ __forceinline__ void done(const Unit&) const {}
};

struct ListSched {
    int nM0, nN0, m1, nM1, n1, nN1, n0, ntot, G, c;
    __device__ void init(int nM0_, int nN0_, int m1_, int nM1_, int n1_, int nN1_, int G_, int c_) { nM0 = nM0_; nN0 = nN0_; m1 = m1_; nM1 = nM1_; n1 = n1_; nN1 = nN1_; n0 = nM0_ * nN0_; ntot = n0 + nM1_ * nN1_; G = G_; c = c_; }
    __device__ bool next(int i, Unit& u) const {
        const long L = (long)i * G + c; if (L >= ntot) return false;
        if (L < n0) {
            int wgid = (int)L; const int nwg = n0; { const int q = nwg / NXCD, r = nwg % NXCD, xcd = wgid % NXCD, off = wgid / NXCD; wgid = (xcd < r ? xcd * (q + 1) : r * (q + 1) + (xcd - r) * q) + off; }
            const int nig = WGM * nN0, gid = wgid / nig, fm = gid * WGM, gsz = (nM0 - fm) < WGM ? (nM0 - fm) : WGM;
            u.pm = fm + ((wgid % nig) % gsz); u.pn = (wgid % nig) / gsz;
        } else { const int r = (int)L - n0; u.pm = m1 + r % nM1; u.pn = n1 + r / nM1; }
        return true;
    }
    __device__ __forceinline__ void a_ready(const Unit&) const {}
    __device__ __forceinline__ void done(const Unit&) const {}
};
__device__ __forceinline__ unsigned cvt_pk_bf16(float lo, float hi) { unsigned r; asm volatile("v_cvt_pk_bf16_f32 %0, %1, %2" : "=v"(r) : "v"(lo), "v"(hi)); return r; }
__device__ __forceinline__ float bf_lo(unsigned w) { return __builtin_bit_cast(float, w << 16); }
__device__ __forceinline__ float bf_hi(unsigned w) { return __builtin_bit_cast(float, w & 0xffff0000u); }
constexpr float RMS_EPS = 1e-6f;
__device__ __forceinline__ float row_rstd(const float* ssq, int row, int fq) {
    const f32x4 p = *(const f32x4*)(ssq + (size_t)row * 16 + 4 * fq);
    float s = (p[0] + p[1]) + (p[2] + p[3]); s += __shfl_xor(s, 16); s += __shfl_xor(s, 32);
    return __builtin_amdgcn_rsqf(s * (1.0f / 1024.0f) + RMS_EPS);
}
__device__ __forceinline__ float sigm(float x) { return __builtin_amdgcn_rcpf(1.0f + __builtin_amdgcn_exp2f(-1.4426950408889634f * x)); }

struct EpiProj {
    static constexpr bool PERM = true, AFTER_DRAIN = false;
    const float* ssq; bf16_t* proj; float* kvraw; float* pmk; float* pmv; int npt;
    __device__ __forceinline__ void operator()(const f32x4 (&acc)[2][2][4][2], const Unit& u, int wr, int wc, int fr, int fq) const {
        const int row0 = u.pm * BM + wr * 64 + fr, cl = wc * 32 + 8 * fq;
#pragma unroll
        for (int ai = 0; ai < 2; ++ai)
#pragma unroll
            for (int m = 0; m < 4; ++m) {
                const int row = row0 + ai * HALF + m * 16; const float rs = row_rstd(ssq, row, fq);
                if (u.pm < npt) {
                    if (u.pn < 4) { bf16_t* rowp = proj + (size_t)row * 1024 + u.pn * BM + cl;
#pragma unroll
                        for (int bj = 0; bj < 2; ++bj) { const f32x4 v0 = acc[ai][bj][m][0] * rs, v1 = acc[ai][bj][m][1] * rs; u32x4 w; w.x = cvt_pk_bf16(v0[0], v0[1]); w.y = cvt_pk_bf16(v0[2], v0[3]); w.z = cvt_pk_bf16(v1[0], v1[1]); w.w = cvt_pk_bf16(v1[2], v1[3]); *(u32x4*)(rowp + bj * HALF) = w; }
                    } else { float* rowp = kvraw + (size_t)row * 512 + (u.pn - 4) * BM + cl;
#pragma unroll
                        for (int bj = 0; bj < 2; ++bj) { *(f32x4*)(rowp + bj * HALF) = acc[ai][bj][m][0] * rs; *(f32x4*)(rowp + bj * HALF + 4) = acc[ai][bj][m][1] * rs; }
                    }
                } else { const int t = u.pn - 4; float* rowp = ((t & 1) ? pmv : pmk) + (size_t)(t >> 1) * 262144 + (size_t)(row - npt * BM) * 256 + cl;
#pragma unroll
                    for (int bj = 0; bj < 2; ++bj) { *(f32x4*)(rowp + bj * HALF) = acc[ai][bj][m][0] * rs; *(f32x4*)(rowp + bj * HALF + 4) = acc[ai][bj][m][1] * rs; }
                }
            }
    }
};
struct EpiGlu {
    static constexpr bool PERM = true, AFTER_DRAIN = false;
    const bf16_t* y; bf16_t* out;
    __device__ __forceinline__ void operator()(const f32x4 (&acc)[2][2][4][2], const Unit& u, int wr, int wc, int fr, int fq) const {
        const int row0 = u.pm * BM + wr * 64 + fr, col0 = u.pn * BM + wc * 32 + 8 * fq;
#pragma unroll
        for (int ai = 0; ai < 2; ++ai)
#pragma unroll
            for (int m = 0; m < 4; ++m) { const int row = row0 + ai * HALF + m * 16;
#pragma unroll
                for (int bj = 0; bj < 2; ++bj) { const u32x4 yw = *(const u32x4*)(y + (size_t)row * 768 + col0 + bj * HALF); const f32x4 z0 = acc[ai][bj][m][0], z1 = acc[ai][bj][m][1]; u32x4 w;
                    w.x = cvt_pk_bf16(bf_lo(yw.x) * sigm(z0[0]), bf_hi(yw.x) * sigm(z0[1])); w.y = cvt_pk_bf16(bf_lo(yw.y) * sigm(z0[2]), bf_hi(yw.y) * sigm(z0[3]));
                    w.z = cvt_pk_bf16(bf_lo(yw.z) * sigm(z1[0]), bf_hi(yw.z) * sigm(z1[1])); w.w = cvt_pk_bf16(bf_lo(yw.w) * sigm(z1[2]), bf_hi(yw.w) * sigm(z1[3]));
                    *(u32x4*)(out + (size_t)row * 1024 + col0 + bj * HALF) = w; } }
    }
};
struct EpiSwiglu {
    static constexpr bool PERM = true, AFTER_DRAIN = false;
    const float* ssq; bf16_t* out;
    __device__ __forceinline__ void operator()(const f32x4 (&acc)[2][2][4][2], const Unit& u, int wr, int wc, int fr, int fq) const {
        const int row0 = u.pm * BM + wr * 64 + fr, col0 = u.pn * HALF + wc * 32 + 8 * fq;
#pragma unroll
        for (int ai = 0; ai < 2; ++ai)
#pragma unroll
            for (int m = 0; m < 4; ++m) { const int row = row0 + ai * HALF + m * 16; const float rs = row_rstd(ssq, row, fq);
                float o[8];
#pragma unroll
                for (int n = 0; n < 2; ++n)
#pragma unroll
                    for (int e = 0; e < 4; ++e) { const float g = acc[ai][0][m][n][e] * rs, uu = acc[ai][1][m][n][e] * rs; o[4 * n + e] = g * sigm(g) * uu; }
                u32x4 w; w.x = cvt_pk_bf16(o[0], o[1]); w.y = cvt_pk_bf16(o[2], o[3]); w.z = cvt_pk_bf16(o[4], o[5]); w.w = cvt_pk_bf16(o[6], o[7]);
                *(u32x4*)(out + (size_t)row * 2816 + col0) = w; }
    }
};
struct EpiResid {
    static constexpr bool PERM = true, AFTER_DRAIN = false;
    float* h; bf16_t* hb; float* ssq_out; float* yout; int ylim;
    __device__ __forceinline__ void operator()(const f32x4 (&acc)[2][2][4][2], const Unit& u, int wr, int wc, int fr, int fq) const {
        const int row0 = u.pm * BM + wr * 64 + fr, col0 = u.pn * BM + wc * 32 + 8 * fq;
#pragma unroll
        for (int ai = 0; ai < 2; ++ai)
#pragma unroll
            for (int m = 0; m < 4; ++m) { const int row = row0 + ai * HALF + m * 16; float ss = 0.f;
#pragma unroll
                for (int bj = 0; bj < 2; ++bj) { float* hp = h + (size_t)row * 1024 + col0 + bj * HALF;
                    const f32x4 v0 = *(const f32x4*)hp + acc[ai][bj][m][0], v1 = *(const f32x4*)(hp + 4) + acc[ai][bj][m][1];
                    *(f32x4*)hp = v0; *(f32x4*)(hp + 4) = v1;
                    if (yout && row < ylim) { float* yp = yout + (size_t)row * 1024 + col0 + bj * HALF; *(f32x4*)yp = v0; *(f32x4*)(yp + 4) = v1; }
                    u32x4 w; w.x = cvt_pk_bf16(v0[0], v0[1]); w.y = cvt_pk_bf16(v0[2], v0[3]); w.z = cvt_pk_bf16(v1[0], v1[1]); w.w = cvt_pk_bf16(v1[2], v1[3]);
                    *(u32x4*)(hb + (size_t)row * 1024 + col0 + bj * HALF) = w;
                    ss += (v0[0] * v0[0] + v0[1] * v0[1]) + (v0[2] * v0[2] + v0[3] * v0[3]) + (v1[0] * v1[0] + v1[1] * v1[1]) + (v1[2] * v1[2] + v1[3] * v1[3]); }
                ss += __shfl_xor(ss, 16); ss += __shfl_xor(ss, 32);
                if (fq == 0) ssq_out[(size_t)row * 16 + 4 * u.pn + wc] = ss; }
    }
};

template <class Epi, class Sched, bool ALIGN_EPI = false, bool SP2 = false>
__device__ __forceinline__ void gemm_phase(PG8_LAS unsigned char* lds, const Gemm g, const Sched& S, const Epi& E) {
    int tid_ = threadIdx.x; asm volatile("" : "+v"(tid_)); const int tid = tid_, wid = __builtin_amdgcn_readfirstlane(tid >> 6), lane = tid & 63, wr = wid >> 2, wc = wid & 3, fr = lane & 15, fq = lane >> 4;
    const int K = g.K, nt = K / BK;
    unsigned voffA[2], voffB[2];
#pragma unroll
    for (int i = 0; i < 2; ++i) { int R, C; stage_rc(tid * 16 + i * 8192, R, C); const int Rb = Epi::PERM ? ((R & ~31) + perm32(R & 31)) : R;
        voffA[i] = (unsigned)(R * K + C) * 2u; voffB[i] = (unsigned)(Rb * K + C) * 2u; }
    const size_t kstep = (size_t)(BK * 2);
    const size_t hstep = (size_t)HALF * K * 2;
    const size_t tstep = 2 * hstep;
    const unsigned ldsw = (unsigned)wid * 1024u;
    const int aoff = lds_byte(wr * 64 + fr, fq * 8), boff = lds_byte(wc * 32 + fr, fq * 8);
#define PG8_SA(b, h) (((b) * 2 + (h)) * HTB)
#define PG8_SB(b, h) ((4 + (b) * 2 + (h)) * HTB)
#define PG8_STAGE(bufoff, gbase, voff) do { _Pragma("unroll") for (int _i = 0; _i < 2; ++_i) \
        __builtin_amdgcn_global_load_lds((const unsigned*)((const char*)(gbase) + (voff)[_i]), (PG8_LAS unsigned*)(lds + (bufoff) + ldsw + _i * 8192), 16, 0, 0); } while (0)
#define PG8_LDA(dst, b, h) do { _Pragma("unroll") for (int m = 0; m < 4; ++m) _Pragma("unroll") for (int k = 0; k < 2; ++k) dst[m][k] = *(const PG8_LAS bf16x8*)(lds + PG8_SA(b, h) + aoff + m * 2048 + k * 1024); } while (0)
#define PG8_LDB(dst, b, h) do { _Pragma("unroll") for (int n = 0; n < 2; ++n) _Pragma("unroll") for (int k = 0; k < 2; ++k) dst[n][k] = *(const PG8_LAS bf16x8*)(lds + PG8_SB(b, h) + boff + n * 2048 + k * 1024); } while (0)
#define PG8_MMA(ai, bj, At, Bt) do { __builtin_amdgcn_s_setprio(1); _Pragma("unroll") for (int m = 0; m < 4; ++m) _Pragma("unroll") for (int n = 0; n < 2; ++n) _Pragma("unroll") for (int k = 0; k < 2; ++k) \
        acc[ai][bj][m][n] = __builtin_amdgcn_mfma_f32_16x16x32_bf16(Bt[n][k], At[m][k], acc[ai][bj][m][n], 0, 0, 0); __builtin_amdgcn_s_setprio(0); } while (0)
#define PG8_WAIT_V(n) asm volatile("s_waitcnt vmcnt(" #n ")" ::: "memory")
#define PG8_WAIT_L(n) asm volatile("s_waitcnt lgkmcnt(" #n ")" ::: "memory")
#define PG8_BAR __builtin_amdgcn_s_barrier()
#define PG8_SCHED __builtin_amdgcn_sched_barrier(0)
    Unit cur, nxt; int ui = 0;
    if (!S.next(0, cur)) return;
    f32x4 acc[2][2][4][2];
#pragma unroll
    for (int a = 0; a < 2; ++a)
#pragma unroll
        for (int b = 0; b < 2; ++b)
#pragma unroll
            for (int m = 0; m < 4; ++m)
#pragma unroll
                for (int n = 0; n < 2; ++n) acc[a][b][m][n] = (f32x4){0.f, 0.f, 0.f, 0.f};
    bf16x8 At[4][2], B0[2][2], B1[2][2];
    const char* cA = (const char*)g.A + (size_t)cur.pm * tstep; const char* cB = (const char*)g.Bt + (size_t)cur.pn * tstep;
    S.a_ready(cur);
    if constexpr (SP2) {
        PG8_STAGE(PG8_SB(0, 0), cB, voffB); PG8_STAGE(PG8_SB(0, 1), cB + hstep, voffB); PG8_STAGE(PG8_SA(0, 0), cA, voffA); PG8_STAGE(PG8_SA(0, 1), cA + hstep, voffA);
        if (wr == 1) PG8_BAR;
        PG8_WAIT_V(2); PG8_BAR;
        PG8_STAGE(PG8_SB(1, 0), cB + kstep, voffB); PG8_STAGE(PG8_SA(1, 0), cA + kstep, voffA); PG8_STAGE(PG8_SB(1, 1), cB + hstep + kstep, voffB);
        PG8_WAIT_V(6); PG8_BAR;
    } else {
        PG8_STAGE(PG8_SB(0, 0), cB, voffB); PG8_STAGE(PG8_SA(0, 0), cA, voffA); PG8_STAGE(PG8_SB(0, 1), cB + hstep, voffB); PG8_STAGE(PG8_SA(0, 1), cA + hstep, voffA);
        if (wr == 1) PG8_BAR;
        PG8_WAIT_V(4); PG8_BAR;
        PG8_STAGE(PG8_SB(1, 0), cB + kstep, voffB); PG8_STAGE(PG8_SA(1, 0), cA + kstep, voffA); PG8_STAGE(PG8_SB(1, 1), cB + hstep + kstep, voffB);
        PG8_WAIT_V(6); PG8_BAR;
    }
    for (;;) {
        const bool has_next = S.next(ui + 1, nxt);
        const char* nA = has_next ? (const char*)g.A + (size_t)nxt.pm * tstep : cA; const char* nB = has_next ? (const char*)g.Bt + (size_t)nxt.pn * tstep : cB;
        for (int t = 0; t < nt; t += 2) {
            const bool last = (t == nt - 2);
            const char* a1 = cA + (size_t)(t + 1) * kstep;
            const char* a2 = last ? nA : cA + (size_t)(t + 2) * kstep; const char* b2 = last ? nB : cB + (size_t)(t + 2) * kstep;
            const char* a3 = a2 + kstep; const char* b3 = b2 + kstep;
            if (last && has_next) S.a_ready(nxt);
            if constexpr (SP2) {
            PG8_LDB(B0, 0, 0); PG8_LDB(B1, 0, 1); PG8_SCHED; PG8_LDA(At, 0, 0); PG8_STAGE(PG8_SA(1, 1), a1 + hstep, voffA);
            PG8_WAIT_V(8); PG8_WAIT_L(0); PG8_BAR; PG8_MMA(0, 0, At, B0); PG8_MMA(0, 1, At, B1); PG8_BAR; PG8_SCHED;
            PG8_LDA(At, 0, 1); PG8_STAGE(PG8_SB(0, 0), b2, voffB); PG8_STAGE(PG8_SB(0, 1), b2 + hstep, voffB); PG8_STAGE(PG8_SA(0, 0), a2, voffA);
            PG8_WAIT_V(8); PG8_WAIT_L(0); PG8_BAR; PG8_MMA(1, 0, At, B0); PG8_MMA(1, 1, At, B1); PG8_BAR; PG8_SCHED;
            PG8_LDB(B0, 1, 0); PG8_LDB(B1, 1, 1); PG8_SCHED; PG8_LDA(At, 1, 0); PG8_STAGE(PG8_SA(0, 1), a2 + hstep, voffA);
            PG8_WAIT_V(8); PG8_WAIT_L(0); PG8_BAR; PG8_MMA(0, 0, At, B0); PG8_MMA(0, 1, At, B1); PG8_BAR; PG8_SCHED;
            PG8_LDA(At, 1, 1); PG8_STAGE(PG8_SB(1, 0), b3, voffB); PG8_STAGE(PG8_SB(1, 1), b3 + hstep, voffB); PG8_STAGE(PG8_SA(1, 0), a3, voffA);
            PG8_WAIT_V(8); PG8_WAIT_L(0); PG8_BAR; PG8_MMA(1, 0, At, B0); PG8_MMA(1, 1, At, B1); PG8_BAR; PG8_SCHED;
            } else {
            PG8_LDB(B0, 0, 0); PG8_SCHED; PG8_LDA(At, 0, 0); PG8_STAGE(PG8_SA(1, 1), a1 + hstep, voffA);
            PG8_WAIT_L(8); PG8_BAR; PG8_WAIT_L(0); PG8_MMA(0, 0, At, B0); PG8_BAR; PG8_SCHED;
            PG8_LDB(B1, 0, 1); PG8_STAGE(PG8_SB(0, 0), b2, voffB);
            PG8_BAR; PG8_WAIT_L(0); PG8_MMA(0, 1, At, B1); PG8_BAR;
            PG8_LDA(At, 0, 1); PG8_STAGE(PG8_SA(0, 0), a2, voffA);
            PG8_BAR; PG8_WAIT_L(0); PG8_MMA(1, 0, At, B0); PG8_BAR; PG8_SCHED;
            PG8_STAGE(PG8_SB(0, 1), b2 + hstep, voffB);
            PG8_WAIT_V(6); PG8_BAR; PG8_MMA(1, 1, At, B1); PG8_BAR;
            PG8_LDB(B0, 1, 0); PG8_SCHED; PG8_LDA(At, 1, 0); PG8_STAGE(PG8_SA(0, 1), a2 + hstep, voffA);
            PG8_WAIT_L(8); PG8_BAR; PG8_WAIT_L(0); PG8_MMA(0, 0, At, B0); PG8_BAR; PG8_SCHED;
            PG8_LDB(B1, 1, 1); PG8_STAGE(PG8_SB(1, 0), b3, voffB);
            PG8_BAR; PG8_WAIT_L(0); PG8_MMA(0, 1, At, B1); PG8_BAR;
            PG8_LDA(At, 1, 1); PG8_STAGE(PG8_SA(1, 0), a3, voffA);
            PG8_BAR; PG8_WAIT_L(0); PG8_MMA(1, 0, At, B0); PG8_BAR; PG8_SCHED;
            PG8_STAGE(PG8_SB(1, 1), b3 + hstep, voffB);
            PG8_WAIT_V(6); PG8_BAR; PG8_MMA(1, 1, At, B1); PG8_BAR;
            }
        }
        if constexpr (ALIGN_EPI) { if (wr == 0) PG8_BAR; }
        if constexpr (!Epi::AFTER_DRAIN) { E(acc, cur, wr, wc, fr, fq); S.done(cur); }
        if (!has_next) break;
#pragma unroll
        for (int a = 0; a < 2; ++a)
#pragma unroll
            for (int b = 0; b < 2; ++b)
#pragma unroll
                for (int m = 0; m < 4; ++m)
#pragma unroll
                    for (int n = 0; n < 2; ++n) acc[a][b][m][n] = (f32x4){0.f, 0.f, 0.f, 0.f};
        cur = nxt; cA = nA; cB = nB; ++ui;
        if constexpr (ALIGN_EPI) { if (wr == 1) PG8_BAR; }
    }
    PG8_WAIT_V(0);
    if constexpr (!ALIGN_EPI) { if (wr == 0) PG8_BAR; }
    PG8_BAR;
    if constexpr (Epi::AFTER_DRAIN) { E.fused(acc, cur, wr, wc, fr, fq, lds, wid, lane); S.done(cur); }
#undef PG8_SA
#undef PG8_SB
#undef PG8_STAGE
#undef PG8_LDA
#undef PG8_LDB
#undef PG8_MMA
#undef PG8_WAIT_V
#undef PG8_WAIT_L
#undef PG8_BAR
#undef PG8_SCHED
}
}
namespace attn_body {
typedef unsigned short bf16;
using bf16x8=__attribute__((ext_vector_type(8)))short;
using s16x4=__attribute__((ext_vector_type(4)))short;
using f32x16=__attribute__((ext_vector_type(16)))float;
using u32x4=__attribute__((ext_vector_type(4)))unsigned;
constexpr int D=64,QP=1024,KVP=256,OP=1024;
constexpr int NW=8,QBLK=32,QB=QBLK*NW,KVBLK=64;
constexpr float NEGB=-1.0e30f;
__device__ __forceinline__ int crow(int r,int hi){return (r&3)+8*(r>>2)+4*hi;}
#define SBAR() __builtin_amdgcn_sched_barrier(0)
__device__ __forceinline__ void cmask(f32x16&p0,f32x16&p1,int jb,int qrel,int hi){
  const float NEG=-INFINITY; int kb=64*jb+4*hi;
  #pragma unroll
  for(int r=0;r<16;++r){int kv=kb+(r&3)+8*(r>>2); if(kv>qrel)p0[r]=NEG; if(kv+32>qrel)p1[r]=NEG;}
}

constexpr int NSLOT=3, SLOTB=8192;
constexpr int LDS_K=0, LDS_V=NSLOT*SLOTB, LDS_WS=2*NSLOT*SLOTB, LDS_OST=LDS_WS+NW*64*4, LDS_BYTES=LDS_OST+NW*4096;
constexpr float C2=0.125f*1.4426950408889634f;
__device__ __forceinline__ void glds16(const void*sbase,unsigned voff,unsigned lds_dst){unsigned keep;
  const unsigned long long sb0=(unsigned long long)sbase; const unsigned long long sb=((unsigned long long)(unsigned)__builtin_amdgcn_readfirstlane((unsigned)(sb0>>32))<<32)|(unsigned)__builtin_amdgcn_readfirstlane((unsigned)sb0);
  asm volatile("s_mov_b32 %0, m0\n\ts_mov_b32 m0, %3\n\ts_nop 0\n\tglobal_load_lds_dwordx4 %1, %2\n\ts_mov_b32 m0, %0":"=&s"(keep):"v"(voff),"s"(sb),"s"(lds_dst):"memory");}
__device__ __forceinline__ float max3f(float a,float b,float c){float r;asm("v_max3_f32 %0, %1, %2, %3":"=v"(r):"v"(a),"v"(b),"v"(c));return r;}
__device__ __forceinline__ float max2f(float a,float b){float r;asm("v_max_f32_e32 %0, %1, %2":"=v"(r):"v"(a),"v"(b));return r;}
__device__ __forceinline__ float fadd_s(float a,float b){float r;asm("v_add_f32_e32 %0, %1, %2":"=v"(r):"v"(a),"v"(b));return r;}
__device__ __forceinline__ float fsub_s(float a,float b){float r;asm("v_sub_f32_e32 %0, %1, %2":"=v"(r):"v"(a),"v"(b));return r;}
typedef float f32x2_t __attribute__((ext_vector_type(2))); typedef float f32x4_t __attribute__((ext_vector_type(4))); typedef __bf16 bf16x2_t __attribute__((ext_vector_type(2)));
__device__ __forceinline__ unsigned cvtpk_s(float lo,float hi){f32x2_t v={lo,hi};bf16x2_t b=__builtin_convertvector(v,bf16x2_t);return __builtin_bit_cast(unsigned,b);}
#define WAIT_BAR(N) asm volatile("s_waitcnt vmcnt(" #N ") lgkmcnt(0)\n\ts_barrier":::"memory")

__device__ __forceinline__ void qkt(f32x16&p0,f32x16&p1,const char*Kslot,const bf16x8*qr,const f32x16&negm,int r32,int hi){
  const char*kb=Kslot+hi*1024+r32*16;
  #pragma unroll
  for(int d0=0;d0<4;++d0){
    const bf16x8 b0=*reinterpret_cast<const bf16x8*>(kb+d0*2048);
    const bf16x8 b1=*reinterpret_cast<const bf16x8*>(kb+d0*2048+512);
    if(d0==0){p0=__builtin_amdgcn_mfma_f32_32x32x16_bf16(b0,qr[0],negm,0,0,0);p1=__builtin_amdgcn_mfma_f32_32x32x16_bf16(b1,qr[0],negm,0,0,0);}
    else{p0=__builtin_amdgcn_mfma_f32_32x32x16_bf16(b0,qr[d0],p0,0,0,0);p1=__builtin_amdgcn_mfma_f32_32x32x16_bf16(b1,qr[d0],p1,0,0,0);}}
}
typedef __attribute__((address_space(3))) const char* lds_cptr;
typedef short v4i16_t __attribute__((ext_vector_type(4)));
__device__ __forceinline__ void kload8(bf16x8*kf,lds_cptr kp){
  kf[0]=*(const __attribute__((address_space(3))) bf16x8*)(kp);      kf[1]=*(const __attribute__((address_space(3))) bf16x8*)(kp+512);
  kf[2]=*(const __attribute__((address_space(3))) bf16x8*)(kp+2048); kf[3]=*(const __attribute__((address_space(3))) bf16x8*)(kp+2560);
  kf[4]=*(const __attribute__((address_space(3))) bf16x8*)(kp+4096); kf[5]=*(const __attribute__((address_space(3))) bf16x8*)(kp+4608);
  kf[6]=*(const __attribute__((address_space(3))) bf16x8*)(kp+6144); kf[7]=*(const __attribute__((address_space(3))) bf16x8*)(kp+6656);
}
__device__ __forceinline__ void kload2(bf16x8*kf,lds_cptr kp,int j){ kf[2*j]=*(const __attribute__((address_space(3))) bf16x8*)(kp+j*2048); kf[2*j+1]=*(const __attribute__((address_space(3))) bf16x8*)(kp+j*2048+512); }
__device__ __forceinline__ s16x4 vtr(lds_cptr p){ return __builtin_bit_cast(s16x4,__builtin_amdgcn_ds_read_tr16_b64_v4i16((__attribute__((address_space(3))) v4i16_t*)p)); }
__device__ __forceinline__ float rowmax(const f32x16&p0,const f32x16&p1){
  float a=max3f(p0[0],p0[1],p1[0]),b=max3f(p0[2],p0[3],p1[1]);a=max3f(a,p1[2],p1[3]);
  #pragma unroll
  for(int r=4;r<16;r+=4){a=max3f(a,p0[r],p0[r+1]);b=max3f(b,p0[r+2],p0[r+3]);a=max3f(a,p1[r],p1[r+1]);b=max3f(b,p1[r+2],p1[r+3]);}
  const float m=max2f(a,b);
  auto rr=__builtin_amdgcn_permlane32_swap(__float_as_uint(m),__float_as_uint(m),false,false);
  return max2f(__uint_as_float(rr[0]),__uint_as_float(rr[1]));
}
__device__ __forceinline__ void pv(f32x16*o,int vb,bf16x8 pa0,bf16x8 pa1,bf16x8 pa2,bf16x8 pa3){
  #pragma unroll
  for(int d0=0;d0<2;++d0){s16x4 lo[4],hi[4];
    #pragma unroll
    for(int ks=0;ks<4;++ks){
      asm volatile("ds_read_b64_tr_b16 %0,%1 offset:%c2":"=&v"(lo[ks]):"v"(vb),"i"(d0*4096+ks*1024):"memory");
      asm volatile("ds_read_b64_tr_b16 %0,%1 offset:%c2":"=&v"(hi[ks]):"v"(vb),"i"(d0*4096+ks*1024+512):"memory");}
    asm volatile("s_waitcnt lgkmcnt(0)":::"memory");SBAR();
    #define PK(k) (bf16x8){lo[k][0],lo[k][1],lo[k][2],lo[k][3],hi[k][0],hi[k][1],hi[k][2],hi[k][3]}
    o[d0]=__builtin_amdgcn_mfma_f32_32x32x16_bf16(pa0,PK(0),o[d0],0,0,0);
    o[d0]=__builtin_amdgcn_mfma_f32_32x32x16_bf16(pa1,PK(1),o[d0],0,0,0);
    o[d0]=__builtin_amdgcn_mfma_f32_32x32x16_bf16(pa2,PK(2),o[d0],0,0,0);
    o[d0]=__builtin_amdgcn_mfma_f32_32x32x16_bf16(pa3,PK(3),o[d0],0,0,0);
    #undef PK
  }
}

#ifndef ATTN_STORE16
#define ATTN_STORE16(p,v) (*(u32x4*)(p)=(v))
#endif
template<int MODE,int THRL> __device__ __forceinline__ void attn_unit(int qb,const bf16*Qu,const bf16*__restrict__ Kh,const bf16*__restrict__ Vh,bf16*Ou,const float*__restrict__ gq,const bf16*__restrict__ kmean,char*shm){
  int tid_=threadIdx.x; asm volatile("":"+v"(tid_));   const int tid=tid_,lane=tid&63,r32=lane&31,hi=lane>>5; const int wid=__builtin_amdgcn_readfirstlane(tid>>6);
  const bf16*Qw=Qu+(long)(wid*QBLK)*QP;
  const unsigned lds0=(unsigned)(uintptr_t)shm;
  float*wsf=(float*)(shm+LDS_WS)+wid*64;
  const int NT=(MODE==1)?4*(qb+1):4;
  const unsigned kvoff=(unsigned)(lane*KVP+wid*8)*2u;
  const unsigned vvoff=(unsigned)((16*(wid&3)+(lane>>2))*KVP+(wid>>2)*32+(lane&3)*8)*2u;
  const unsigned kdst=lds0+LDS_K+wid*1024, vdst=lds0+LDS_V+wid*1024;
  #define TMAP(t) ((MODE==1)?(((t)<4)?(NT-4+(t)):((t)-4)):(t))
  #define DMA_K(t,slot) glds16(Kh+(long)TMAP(t)*KVBLK*KVP,kvoff,(unsigned)__builtin_amdgcn_readfirstlane(kdst+(slot)))
  #define DMA_V(t,slot) glds16(Vh+(long)TMAP(t)*KVBLK*KVP,vvoff,(unsigned)__builtin_amdgcn_readfirstlane(vdst+(slot)))
  const int vb0=(int)(lds0+LDS_V)+((lane>>4)&1)*32+(lane&3)*8+(4*hi+((lane&15)>>2))*64;
  const char*Kbase=shm+LDS_K; bf16x8 kf[8];
  const lds_cptr shm3=(lds_cptr)shm; const lds_cptr kp0=shm3+LDS_K+hi*1024+r32*16; const lds_cptr vp0=shm3+LDS_V+((lane>>4)&1)*32+(lane&3)*8+(4*hi+((lane&15)>>2))*64;
  DMA_K(0,0);DMA_V(0,0);DMA_K(1,SLOTB);
  bf16x8 qr[4]; unsigned sel=0u;
  { bf16x8 qraw[4]; f32x4_t gg[8]; bf16x8 kmf[4];
    #pragma unroll
    for(int d0=0;d0<4;++d0)qraw[d0]=*reinterpret_cast<const bf16x8*>(&Qw[(long)r32*QP+d0*16+hi*8]);
    #pragma unroll
    for(int d0=0;d0<4;++d0){gg[2*d0]=*reinterpret_cast<const f32x4_t*>(gq+d0*16+hi*8);gg[2*d0+1]=*reinterpret_cast<const f32x4_t*>(gq+d0*16+hi*8+4);}
    if(MODE==1){
      #pragma unroll
      for(int d0=0;d0<4;++d0){ kmf[d0]=bf16x8{}; if(r32<16)kmf[d0]=*reinterpret_cast<const bf16x8*>(kmean+(long)r32*KVP+d0*16+hi*8); } }
    float qf[32]; float ss=0.f;
    #pragma unroll
    for(int d0=0;d0<4;++d0){
      #pragma unroll
      for(int e=0;e<8;++e){const float v=__uint_as_float(((unsigned)(unsigned short)qraw[d0][e])<<16); qf[d0*8+e]=v; ss+=v*v;} }
    ss+=__shfl_xor(ss,32);
    const float rs=__builtin_amdgcn_rsqf(ss*(1.0f/64.0f)+1e-6f)*C2;
    #pragma unroll
    for(int d0=0;d0<4;++d0){ u32x4 w;
      w[0]=cvtpk_s(qf[d0*8+0]*rs*gg[2*d0][0],qf[d0*8+1]*rs*gg[2*d0][1]); w[1]=cvtpk_s(qf[d0*8+2]*rs*gg[2*d0][2],qf[d0*8+3]*rs*gg[2*d0][3]);
      w[2]=cvtpk_s(qf[d0*8+4]*rs*gg[2*d0+1][0],qf[d0*8+5]*rs*gg[2*d0+1][1]); w[3]=cvtpk_s(qf[d0*8+6]*rs*gg[2*d0+1][2],qf[d0*8+7]*rs*gg[2*d0+1][3]);
      qr[d0]=__builtin_bit_cast(bf16x8,w); }
    if(MODE==1){ if(qb>0){
      f32x16 ga=f32x16{};
      #pragma unroll
      for(int d0=0;d0<4;++d0)ga=__builtin_amdgcn_mfma_f32_32x32x16_bf16(kmf[d0],qr[d0],ga,0,0,0);
      float gv[8];
      #pragma unroll
      for(int r=0;r<8;++r){const int bi=crow(r,hi); gv[r]=(bi<qb)?ga[r]:-INFINITY;}
      #pragma unroll
      for(int k=0;k<3;++k){
        float best=gv[0]; int bidx=0;
        #pragma unroll
        for(int r=1;r<8;++r){ if(gv[r]>best){best=gv[r];bidx=r;} }
        const int bblk=crow(bidx,hi);
        const float obest=__shfl_xor(best,32); const int oblk=__shfl_xor(bblk,32);
        const bool mine=(best>obest)||(best==obest&&bblk<oblk);
        const float wbest=mine?best:obest; const int wblk=mine?bblk:oblk;
        if(wbest>-INFINITY)sel|=(1u<<wblk);
        #pragma unroll
        for(int r=0;r<8;++r)gv[r]=(mine&&bidx==r)?-INFINITY:gv[r];
      } } }
  }
  float mhat=0.f,l_reg=0.f;f32x16 o[2];o[0]=f32x16{};o[1]=f32x16{};f32x16 negm=f32x16{};asm volatile("":"+v"(negm));
  const int qrel=wid*QBLK+r32;
  #define CMASK(P0,P1,t) do{ if(MODE==1){ const int jb_=(t); if(jb_<4)cmask(P0,P1,jb_,qrel,hi); } }while(0)
  bool resc=false;
  #define START(P0,P1) do{ const float rm=rowmax(P0,P1); resc=false; \
    { const float dl=rm; mhat=fadd_s(mhat,dl); \
      _Pragma("unroll") for(int r=0;r<16;++r){P0[r]=fsub_s(P0[r],dl);P1[r]=fsub_s(P1[r],dl);} \
      _Pragma("unroll") for(int r=0;r<16;++r)negm[r]=-mhat; asm volatile("":"+v"(negm)); } \
    _Pragma("unroll") for(int r=0;r<16;++r)P0[r]=__builtin_amdgcn_exp2f(P0[r]); }while(0)
  #define RESC() do{ if(resc){ asm volatile("s_waitcnt lgkmcnt(0)":::"memory"); \
      _Pragma("unroll") for(int d_=0;d_<2;++d_) _Pragma("unroll") for(int r=0;r<16;++r)o[d_][r]*=wsf[crow(r,hi)]; } }while(0)
  f32x16 pA0,pA1,pB0,pB1;
  int sl_prev=0,sl_cur=0,sl_next=SLOTB;
  #define ROT() do{sl_prev=sl_cur;sl_cur=sl_next;sl_next=(sl_next==(NSLOT-1)*SLOTB)?0:sl_next+SLOTB;}while(0)
  DMA_K(2,2*SLOTB);
  WAIT_BAR(3);
  qkt(pA0,pA1,Kbase,qr,negm,r32,hi);asm volatile("s_nop 15\n\ts_nop 7":"+v"(pA0),"+v"(pA1));CMASK(pA0,pA1,0);
  START(pA0,pA1);
  _Pragma("unroll") for(int r=0;r<16;++r)pA1[r]=__builtin_amdgcn_exp2f(pA1[r]);
  WAIT_BAR(0);
  DMA_K(3,0);DMA_V(1,SLOTB);
  ROT();
  kload8(kf,kp0+sl_cur);
  WAIT_BAR(2);
  s16x4 vlo[8],vhi[8]; u32x4 pw0,pw1,pw2,pw3;
  #define PKW(P,B) cvtpk_s(P[B],P[B+1])
  #define PAF(k) __builtin_bit_cast(bf16x8,pw##k)
  #define VFR(i) (bf16x8){vlo[i][0],vlo[i][1],vlo[i][2],vlo[i][3],vhi[i][0],vhi[i][1],vhi[i][2],vhi[i][3]}
  #define PIN(x) asm volatile("":"+v"(x))
  #define MX3(a,b,c) __builtin_fmaxf(__builtin_fmaxf((a),(b)),(c))
  #define GAPA(MF,A0,A1,A2,A3,W0,W1,PW) do{ MF; sacc+=A0; sacc+=A1; sacc+=A2; sacc+=A3; PIN(sacc); W0; W1; PIN(PW); SBAR(); }while(0)
  #define EX(v) __builtin_amdgcn_exp2f(v)
  #define GAPB(MF,X,B) do{ MF; X[B]=EX(X[B]); X[B+1]=EX(X[B+1]); X[B+2]=EX(X[B+2]); X[B+3]=EX(X[B+3]); PIN(X); SBAR(); }while(0)
  #define VRD(i) do{ vlo[i]=vtr(vp_+(((i)>>2)*4096+((i)&3)*1024)); vhi[i]=vtr(vp_+(((i)>>2)*4096+((i)&3)*1024+512)); }while(0)
  #define KRD(G,j) do{ if(G){ kload2(kf,kp0+sl_next,j); SBAR(); } }while(0)
  #define STEP(C0,C1,P0,P1,t,GK,GV,GL) do{ SBAR(); \
    const lds_cptr vp_=vp0+sl_prev; \
    VRD(0); SBAR(); float sacc=(P0[0]+P0[1]); \
    GAPA(C0=__builtin_amdgcn_mfma_f32_32x32x16_bf16(kf[0],qr[0],negm,0,0,0), P0[2],P0[3],P0[4],P0[5],     pw0[0]=PKW(P0,0), pw0[1]=PKW(P0,2), pw0); \
    VRD(4); SBAR(); GAPA(C1=__builtin_amdgcn_mfma_f32_32x32x16_bf16(kf[1],qr[0],negm,0,0,0), P0[6],P0[7],P0[8],P0[9],     pw0[2]=PKW(P0,4), pw0[3]=PKW(P0,6), pw0); \
    VRD(1); SBAR(); GAPA(C0=__builtin_amdgcn_mfma_f32_32x32x16_bf16(kf[2],qr[1],C0,0,0,0),   P0[10],P0[11],P0[12],P0[13], pw1[0]=PKW(P0,8), pw1[1]=PKW(P0,10), pw1); \
    VRD(5); SBAR(); GAPA(C1=__builtin_amdgcn_mfma_f32_32x32x16_bf16(kf[3],qr[1],C1,0,0,0),   P0[14],P0[15],P1[0],P1[1],   pw1[2]=PKW(P0,12),pw1[3]=PKW(P0,14), pw1); \
    VRD(2); SBAR(); GAPA(C0=__builtin_amdgcn_mfma_f32_32x32x16_bf16(kf[4],qr[2],C0,0,0,0),   P1[2],P1[3],P1[4],P1[5],     pw2[0]=PKW(P1,0), pw2[1]=PKW(P1,2), pw2); \
    VRD(6); SBAR(); GAPA(C1=__builtin_amdgcn_mfma_f32_32x32x16_bf16(kf[5],qr[2],C1,0,0,0),   P1[6],P1[7],P1[8],P1[9],     pw2[2]=PKW(P1,4), pw2[3]=PKW(P1,6), pw2); \
    VRD(3); SBAR(); GAPA(C0=__builtin_amdgcn_mfma_f32_32x32x16_bf16(kf[6],qr[3],C0,0,0,0),   P1[10],P1[11],P1[12],P1[13], pw3[0]=PKW(P1,8), pw3[1]=PKW(P1,10), pw3); \
    VRD(7); SBAR(); GAPA(C1=__builtin_amdgcn_mfma_f32_32x32x16_bf16(kf[7],qr[3],C1,0,0,0),   P1[14],P1[15],0.f,0.f,       pw3[2]=PKW(P1,12),pw3[3]=PKW(P1,14), pw3); \
    l_reg+=sacc; \
    if(GK){DMA_K((t)+3,sl_cur);} if(GV){DMA_V((t)+1,sl_next);} \
    CMASK(C0,C1,t); \
    { float a=MX3(C0[0],C0[1],C1[0]),b=MX3(C0[2],C0[3],C1[1]); a=MX3(a,C1[2],C1[3]); \
      _Pragma("unroll") for(int r=4;r<16;r+=4){a=MX3(a,C0[r],C0[r+1]);b=MX3(b,C0[r+2],C0[r+3]);a=MX3(a,C1[r],C1[r+1]);b=MX3(b,C1[r+2],C1[r+3]);} \
      float rm=__builtin_fmaxf(a,b); { auto rr=__builtin_amdgcn_permlane32_swap(__float_as_uint(rm),__float_as_uint(rm),false,false); rm=__builtin_fmaxf(__uint_as_float(rr[0]),__uint_as_float(rr[1])); } \
      resc=false; \
      if(__builtin_expect(__any(rm>(float)THRL),0)){ const float dl=__builtin_fmaxf(rm,0.f); mhat+=dl; \
        _Pragma("unroll") for(int r=0;r<16;++r){C0[r]-=dl;C1[r]-=dl;} \
        { const bool ro_=(MODE!=1)||((t)<4)||(((sel>>(((t)-4)>>2))&1u)!=0u); const float nm_=ro_?-mhat:NEGB; _Pragma("unroll") for(int r=0;r<16;++r)negm[r]=nm_; } asm volatile("":"+v"(negm)); \
        const float f=__builtin_amdgcn_exp2f(-dl); l_reg*=f; if(hi==0)wsf[r32]=f; resc=true; } } \
    SBAR(); \
    GAPB(o[0]=__builtin_amdgcn_mfma_f32_32x32x16_bf16(PAF(0),VFR(0),o[0],0,0,0), C0,0); \
    GAPB(o[1]=__builtin_amdgcn_mfma_f32_32x32x16_bf16(PAF(0),VFR(4),o[1],0,0,0), C0,4); \
    KRD(GL,0); GAPB(o[0]=__builtin_amdgcn_mfma_f32_32x32x16_bf16(PAF(1),VFR(1),o[0],0,0,0), C0,8); \
    KRD(GL,1); GAPB(o[1]=__builtin_amdgcn_mfma_f32_32x32x16_bf16(PAF(1),VFR(5),o[1],0,0,0), C0,12); \
    KRD(GL,2); GAPB(o[0]=__builtin_amdgcn_mfma_f32_32x32x16_bf16(PAF(2),VFR(2),o[0],0,0,0), C1,0); \
    KRD(GL,3); GAPB(o[1]=__builtin_amdgcn_mfma_f32_32x32x16_bf16(PAF(2),VFR(6),o[1],0,0,0), C1,4); \
    GAPB(o[0]=__builtin_amdgcn_mfma_f32_32x32x16_bf16(PAF(3),VFR(3),o[0],0,0,0), C1,8); \
    GAPB(o[1]=__builtin_amdgcn_mfma_f32_32x32x16_bf16(PAF(3),VFR(7),o[1],0,0,0), C1,12); \
    }while(0)
  int t=1;
  #define PRE(tt) do{ if(MODE==1){ const int t_=(tt); if(t_>=4&&(t_&3)==0){ const bool ro_=((sel>>((t_-4)>>2))&1u)!=0u; const float nm_=ro_?-mhat:NEGB; _Pragma("unroll") for(int r=0;r<16;++r)negm[r]=nm_; asm volatile("":"+v"(negm)); } } }while(0)
  #define ENDW(tt) do{ if((tt)+3<NT){WAIT_BAR(2);} else if((tt)+2<NT){WAIT_BAR(1);} else {WAIT_BAR(0);} }while(0)
  for(;t+1<NT;t+=2){
    PRE(t);   STEP(pB0,pB1,pA0,pA1,t,(t+3<NT),(t+1<NT),(t+1<NT));       ENDW(t);   RESC(); ROT();
    PRE(t+1); STEP(pA0,pA1,pB0,pB1,t+1,(t+4<NT),(t+2<NT),(t+2<NT));     ENDW(t+1); RESC(); ROT();
  }
  PRE(NT-1); STEP(pB0,pB1,pA0,pA1,NT-1,false,false,false); RESC();
  { float sacc=pB0[0]+pB0[1]; _Pragma("unroll") for(int r=2;r<16;++r)sacc+=pB0[r]; _Pragma("unroll") for(int r=0;r<16;++r)sacc+=pB1[r]; l_reg+=sacc;
    pw0=(u32x4){PKW(pB0,0),PKW(pB0,2),PKW(pB0,4),PKW(pB0,6)};pw1=(u32x4){PKW(pB0,8),PKW(pB0,10),PKW(pB0,12),PKW(pB0,14)};pw2=(u32x4){PKW(pB1,0),PKW(pB1,2),PKW(pB1,4),PKW(pB1,6)};pw3=(u32x4){PKW(pB1,8),PKW(pB1,10),PKW(pB1,12),PKW(pB1,14)};
    SBAR(); pv(o,vb0+sl_cur,PAF(0),PAF(1),PAF(2),PAF(3)); }
  #undef PKW
  #undef PAF
  #undef VFR
  #undef PIN
  #undef MX3
  #undef GAPA
  #undef GAPB
  #undef EX
  #undef VRD
  #undef KRD
  #undef STEP
  #undef ENDW
  {auto rr=__builtin_amdgcn_permlane32_swap(__float_as_uint(l_reg),__float_as_uint(l_reg),false,false);l_reg=__uint_as_float(rr[0])+__uint_as_float(rr[1]);}
  if(hi==0)wsf[32+r32]=l_reg;asm volatile("s_waitcnt lgkmcnt(0)":::"memory");
  float rli[16];
  #pragma unroll
  for(int r=0;r<16;++r)rli[r]=__builtin_amdgcn_rcpf(wsf[32+crow(r,hi)]);
  bf16*Ow=Ou+(long)(wid*QBLK)*OP;
  { bf16*stg=(bf16*)(shm+LDS_OST)+wid*2048;
    #pragma unroll
    for(int r=0;r<16;++r){const int orow=crow(r,hi);
      #pragma unroll
      for(int d0=0;d0<2;++d0)stg[orow*64+d0*32+r32]=(bf16)cvtpk_s(o[d0][r]*rli[r],0.f);}
    asm volatile("s_waitcnt lgkmcnt(0)":::"memory");
    #pragma unroll
    for(int i=0;i<4;++i){const int row=i*8+(lane>>3),ch=lane&7; const u32x4 v=*(const u32x4*)(stg+row*64+ch*8); ATTN_STORE16(Ow+(long)row*OP+ch*8,v);} }
  asm volatile("s_waitcnt lgkmcnt(0)\n\ts_barrier":::"memory");
  #undef DMA_K
  #undef TMAP
  #undef PRE
  #undef DMA_V
  #undef CMASK
  #undef START
  #undef RESC
  #undef ROT
}
constexpr int ATTN_LDS_BYTES=LDS_BYTES;
#undef SBAR
#undef WAIT_BAR
}
constexpr int NWAVES = 8;
constexpr int DM = 1024, NBATCH = 4, SEQ = 4096, MP = NBATCH * SEQ, NS = 128, MT = MP + NS, MROWS = 16640, NPT = MROWS / 256, MEMR = 1024, AROWS = MROWS + MEMR;
constexpr int MIXW = 768, NG = 48, NST = 64, DFF = 2816, NKVH = 4, NQH = 12;
constexpr float EPS = 1e-6f;
constexpr float C2 = 0.125f * 1.4426950408889634f;
constexpr size_t OFF_Y = 0, OFF_PSR = 16908288, OFF_PSI = 16932864, OFF_PK = 16957440, OFF_PV = 21151744, OFF_PMK = 25346048, OFF_PMV = 26394624,
                 OFF_SSR = 27443200, OFF_SSI = 28229632, OFF_SK = 29016064, OFF_SV = 29048832, OUT_TOTAL = 29081600;
constexpr size_t MiB = 1u << 20;
constexpr size_t WS_CTL = 0, CTL_ZERO_BYTES = 1 * MiB;
constexpr size_t WS_WCAT0 = 2 * MiB, WS_WCAT1 = 8 * MiB, WS_WCAT2 = 10 * MiB, WS_WCAT3 = 13 * MiB;
constexpr size_t WS_WOUT = 15 * MiB;
constexpr size_t WS_WGLU = 23 * MiB, WGLU_STRIDE = 3 * MiB / 2;
constexpr size_t WS_WGU = 26 * MiB, WGU_STRIDE = 11 * MiB;
constexpr size_t WS_WDOWN = 70 * MiB, WDOWN_STRIDE = 11 * MiB / 2;
constexpr size_t WS_H = 92 * MiB;
constexpr size_t WS_HB = 157 * MiB;
constexpr size_t WS_PROJ = 192 * MiB;
constexpr size_t WS_MIXO = 225 * MiB;
constexpr size_t WS_YBUF = 258 * MiB;
constexpr size_t WS_FFH = 283 * MiB;
constexpr size_t WS_KVRAW = 373 * MiB;
constexpr size_t WS_KBUF = 406 * MiB, WS_VBUF = 415 * MiB;
constexpr size_t WS_MEMKB = 424 * MiB, WS_MEMVB = 426 * MiB;
constexpr size_t WS_SSQA = 428 * MiB, WS_SSQB = 430 * MiB;
constexpr size_t WS_E = 432 * MiB;
constexpr size_t WS_TAB = 434 * MiB;
constexpr size_t WS_KMEANP = 435 * MiB;
constexpr size_t WS_KMEANS = 436 * MiB;
constexpr size_t WS_END = 438 * MiB;
static_assert(WS_WCAT0 + 3072 * 2048 <= WS_WCAT1 && WS_WCAT2 + 1536 * 2048 <= WS_WCAT3 && WS_WGU + 4 * WGU_STRIDE <= WS_WDOWN && WS_WDOWN + 4 * WDOWN_STRIDE <= WS_H, "ws map (weights)");
static_assert(WS_H + (size_t)MROWS * 4096 <= WS_HB && WS_HB + (size_t)AROWS * 2048 <= WS_PROJ && WS_PROJ + (size_t)MROWS * 2048 <= WS_MIXO && WS_MIXO + (size_t)MROWS * 2048 <= WS_YBUF, "ws map (act 1)");
static_assert(WS_YBUF + (size_t)MROWS * 1536 <= WS_FFH && WS_FFH + (size_t)MROWS * 5632 <= WS_KVRAW && WS_KVRAW + (size_t)MROWS * 2048 <= WS_KBUF && WS_KBUF + (size_t)MROWS * 512 <= WS_VBUF && WS_VBUF + (size_t)MROWS * 512 <= WS_MEMKB, "ws map (act 2)");
static_assert(WS_SSQA + (size_t)AROWS * 64 <= WS_SSQB && WS_SSQB + (size_t)AROWS * 64 <= WS_E, "ws map (ssq)");
constexpr int CW_BAR = 4096;
constexpr int RING_BYTES = 131072, LDSCTL_OFF = RING_BYTES, MISC_OFF = LDSCTL_OFF + 320, LDS_BYTES = 147456;

#define GAS __attribute__((address_space(1)))
#define LAS __attribute__((address_space(3)))
typedef unsigned short bf16;
typedef unsigned v4u __attribute__((ext_vector_type(4)));
typedef float f32x4 __attribute__((ext_vector_type(4)));
typedef short bf16x8 __attribute__((ext_vector_type(8)));
typedef GAS unsigned gu32;
typedef GAS unsigned long long gu64;
#define RLX_AGENT __ATOMIC_RELAXED, __HIP_MEMORY_SCOPE_AGENT
#define LDS_WAIT() asm volatile("s_waitcnt lgkmcnt(0)" ::: "memory")
#define VM_WAIT() asm volatile("s_waitcnt vmcnt(0)" ::: "memory")
__device__ __forceinline__ unsigned long long rt() { return __builtin_amdgcn_s_memrealtime(); }
__device__ __forceinline__ unsigned f2bf(float f) { unsigned u = __builtin_bit_cast(unsigned, f); return (u + 0x7fffu + ((u >> 16) & 1u)) >> 16; }
__device__ __forceinline__ unsigned pk2(float lo, float hi) { return f2bf(lo) | (f2bf(hi) << 16); }

#define XB_TMO      128
#define XB_XCNT(j)  (256  + 64 * (j))
#define XB_XSUB(j)  (1280 + 64 * (j))
#define XB_XGEN(j)  (2304 + 64 * (j))
#define XB_TOP      3328
#define XB_TOPGEN   3392
#define XCD_BAR_WORDS 3456
#define XB_SPIN_CAP (1u << 18)

__device__ __forceinline__ unsigned xb_ld(unsigned* p)              { return __hip_atomic_load(p, __ATOMIC_RELAXED, __HIP_MEMORY_SCOPE_AGENT); }
__device__ __forceinline__ unsigned xb_add(unsigned* p, unsigned v) { return __hip_atomic_fetch_add(p, v, __ATOMIC_RELAXED, __HIP_MEMORY_SCOPE_AGENT); }
__device__ __forceinline__ unsigned xb_xcc_id() { return (unsigned)__builtin_amdgcn_s_getreg((3 << 11) | 20) & 0xFu; }
#define XB_SPIN(cond, bar) do { unsigned _sp = 0; while (cond) { __builtin_amdgcn_s_sleep(1); \
    if ((++_sp & 255u) == 0u) { if (xb_ld(&(bar)[XB_TMO])) break; if (_sp > XB_SPIN_CAP) { atomicAdd(&(bar)[XB_TMO], 1u); break; } } } } while (0)

struct XcdBarrier {
    unsigned* bar; unsigned x;
    volatile LAS unsigned* st;
};

__device__ __forceinline__ XcdBarrier xcd_barrier_post(unsigned* bar, volatile LAS unsigned* st) {
    XcdBarrier b; b.bar = bar; b.x = xb_xcc_id(); b.st = st;
    if (threadIdx.x == 0) (void)xb_add(&bar[XB_XCNT(b.x)], 1u);
    return b;
}
__device__ __forceinline__ void xcd_barrier_complete(unsigned* bar, unsigned x, unsigned& nloc, unsigned& nx) {
    const unsigned G = gridDim.x * gridDim.y * gridDim.z;
    unsigned sum, cnt, mine, sp = 0u;
    for (;;) {
        sum = 0u; cnt = 0u; mine = 0u;
#pragma unroll
        for (unsigned j = 0; j < 16; ++j) { const unsigned c = xb_ld(&bar[XB_XCNT(j)]); sum += c; cnt += (c > 0u) ? 1u : 0u; mine = (j == x) ? c : mine; }
        if (sum == G) break;
        __builtin_amdgcn_s_sleep(1);
        if ((++sp & 255u) == 0u) { if (xb_ld(&bar[XB_TMO])) break; if (sp > XB_SPIN_CAP) { atomicAdd(&bar[XB_TMO], 1u); break; } }
    }
    nloc = mine > 0u ? mine : 1u; nx = cnt > 0u ? cnt : 1u;
}

__device__ __forceinline__ void xcd_barrier(const XcdBarrier& b) {
    asm volatile("s_waitcnt vmcnt(0)" ::: "memory");
    __syncthreads();
    if (threadIdx.x == 0) {
        unsigned* bar = b.bar;
        __builtin_amdgcn_s_waitcnt(0);
        unsigned nloc = b.st[0], nx = b.st[1];
        if (nloc == 0u) { xcd_barrier_complete(bar, b.x, nloc, nx); b.st[0] = nloc; b.st[1] = nx; }
        const unsigned old = xb_add(&bar[XB_XSUB(b.x)], 1u);
        const unsigned gen = old / nloc;
        if (old + 1u == (gen + 1u) * nloc) {
            __builtin_amdgcn_fence(__ATOMIC_RELEASE, "agent");
            asm volatile("s_waitcnt vmcnt(0)" ::: "memory");
            const unsigned og = xb_add(&bar[XB_TOP], 1u);
            const unsigned tg = og / nx;
            if (og + 1u == (tg + 1u) * nx) xb_add(&bar[XB_TOPGEN], 1u);
            else XB_SPIN(xb_ld(&bar[XB_TOPGEN]) == tg, bar);
            __builtin_amdgcn_fence(__ATOMIC_ACQUIRE, "agent");
            xb_add(&bar[XB_XGEN(b.x)], 1u);
            asm volatile("s_waitcnt vmcnt(0)" ::: "memory");
        } else {
            XB_SPIN(xb_ld(&bar[XB_XGEN(b.x)]) == gen, bar);
            __builtin_amdgcn_fence(__ATOMIC_ACQUIRE, "agent");
            asm volatile("s_waitcnt vmcnt(0)" ::: "memory");
        }
    }
    __syncthreads();
}

typedef float f32x16 __attribute__((ext_vector_type(16)));
typedef unsigned u32x2 __attribute__((ext_vector_type(2)));
struct Args { const void* in[33]; float* out; unsigned char* ws; int ph_lo, ph_hi, li, pad; };
struct Frame {
    LAS unsigned char* lds; volatile LAS unsigned* MISC; gu32* ctl; const __attribute__((address_space(4))) Args* ap;
    int tid, lane, wave, vcu, G;
    __device__ __forceinline__ int otid() const { int t = threadIdx.x; asm volatile("" : "+v"(t)); return t; }
    __device__ __forceinline__ const __attribute__((address_space(4))) Args* A() const { const __attribute__((address_space(4))) Args* p = ap; asm volatile("" : "+s"(p)); return p; }
    __device__ __forceinline__ unsigned char* wsb() const { return A()->ws; }
    __device__ __forceinline__ float* out() const { return A()->out; }
#define FIN(name, idx, T) __device__ __forceinline__ const T* name() const { return (const T*)A()->in[idx]; }
    FIN(x_prompt, 0, float) FIN(x_sample, 1, float) FIN(mem_prompt, 2, float) FIN(st_re, 3, float) FIN(st_im, 4, float) FIN(cache_k, 5, float) FIN(cache_v, 6, float) FIN(page_table, 7, int) FIN(cache_mem_k, 8, float) FIN(cache_mem_v, 9, float)
    FIN(g_mix, 10, float) FIN(w_in, 11, float) FIN(w_out, 12, float) FIN(g_ffn, 13, float) FIN(w_gu, 14, float) FIN(w_down, 15, float) FIN(ssm_a_re, 16, float) FIN(ssm_a_im, 17, float) FIN(ssm_log_dt, 18, float) FIN(ssm_b_re, 19, float)
    FIN(ssm_b_im, 20, float) FIN(ssm_c_re, 21, float) FIN(ssm_c_im, 22, float) FIN(ssm_d, 23, float) FIN(w_glu, 24, float) FIN(g_q, 25, float) FIN(g_mq, 26, float) FIN(g_mem, 27, float) FIN(w_mem_kv, 28, float) FIN(g_mk, 29, float)
    FIN(g_kv, 30, float) FIN(w_kv, 31, float) FIN(g_k, 32, float)
#undef FIN
#define FWS(name, off, T) __device__ __forceinline__ T* name() const { return (T*)(wsb() + (off)); }
    FWS(h, WS_H, float) FWS(hb, WS_HB, bf16) FWS(proj, WS_PROJ, bf16) FWS(mixo, WS_MIXO, bf16) FWS(ybuf, WS_YBUF, bf16) FWS(ffh, WS_FFH, bf16) FWS(kvraw, WS_KVRAW, float) FWS(kbuf, WS_KBUF, bf16) FWS(vbuf, WS_VBUF, bf16)
    FWS(memkb, WS_MEMKB, bf16) FWS(memvb, WS_MEMVB, bf16) FWS(ssqa, WS_SSQA, float) FWS(ssqb, WS_SSQB, float) FWS(E, WS_E, float) FWS(tab, WS_TAB, f32x4) FWS(kmeanp, WS_KMEANP, bf16) FWS(kmeans, WS_KMEANS, float)
#undef FWS
};
__device__ __forceinline__ bf16* wcat(const Frame& F, int l) { return (bf16*)(F.wsb() + (l == 0 ? WS_WCAT0 : l == 1 ? WS_WCAT1 : l == 2 ? WS_WCAT2 : WS_WCAT3)); }
__device__ __forceinline__ float wave_sum(float v) {
#pragma unroll
    for (int o = 1; o < 64; o <<= 1) v += __shfl_xor(v, o);
    return v;
}
__device__ __forceinline__ float wave_max(float v) {
#pragma unroll
    for (int o = 1; o < 64; o <<= 1) v = fmaxf(v, __shfl_xor(v, o));
    return v;
}
__device__ __forceinline__ float sum16(float v) { v += __shfl_xor(v, 1); v += __shfl_xor(v, 2); v += __shfl_xor(v, 4); v += __shfl_xor(v, 8); return v; }
__device__ __forceinline__ float bflo(unsigned w) { return __builtin_bit_cast(float, w << 16); }
__device__ __forceinline__ float bfhi(unsigned w) { return __builtin_bit_cast(float, w & 0xffff0000u); }
__device__ __forceinline__ unsigned cvtpk(float lo, float hi) { return pg8::cvt_pk_bf16(lo, hi); }
__device__ __forceinline__ float gelu_tanh(float y) {
    const float z = 0.7978845608028654f * (y + 0.044715f * y * y * y);
    return y * __builtin_amdgcn_rcpf(1.0f + __builtin_amdgcn_exp2f(-2.0f * 1.4426950408889634f * z));
}

__device__ __forceinline__ void tr_item(const float* W, int K, int N, const float* gain, bf16* WT, int R0, int k0, int n0, LAS float* scr, int lane) {
#pragma unroll 8
    for (int i = 0; i < 32; ++i) { const int kk = 2 * i + (lane >> 5); const float gsc = gain ? gain[k0 + kk] : 1.0f; scr[kk * 33 + (lane & 31)] = W[(size_t)(k0 + kk) * N + n0 + (lane & 31)] * gsc; }
    LDS_WAIT(); asm volatile("" ::: "memory");
    const int c = lane & 7;
#pragma unroll
    for (int j = 0; j < 4; ++j) { const int n = (lane >> 3) + 8 * j; const LAS float* s = scr + (8 * c) * 33 + n;
        v4u o; o.x = pk2(s[0 * 33], s[1 * 33]); o.y = pk2(s[2 * 33], s[3 * 33]); o.z = pk2(s[4 * 33], s[5 * 33]); o.w = pk2(s[6 * 33], s[7 * 33]);
        *(GAS v4u*)(WT + (size_t)(R0 + n) * K + k0 + 8 * c) = o; }
    LDS_WAIT(); asm volatile("" ::: "memory");
}
__device__ __forceinline__ double dexp_small(double x) {
    const double k = __builtin_rint(x * 1.4426950408889634); const double r = __builtin_fma(-k, 0.6931471805599453, x) - k * 2.3190468138462996e-17;
    double s = 1.0;
#pragma unroll
    for (int n = 14; n >= 1; --n) s = 1.0 + s * r * (1.0 / n);
    const long long ki = (long long)k; return s * __builtin_bit_cast(double, (ki + 1023) << 52);
}
__device__ __forceinline__ void dsincos(double x, double& sn, double& cs) {
    const double k = __builtin_rint(x * 0.15915494309189535); double r = __builtin_fma(-k, 6.283185307179586, x); r = __builtin_fma(-k, 2.4492935982947064e-16, r);
    const double y = 0.25 * r, y2 = y * y;
    double s = 1.0, c = 1.0;
#pragma unroll
    for (int n = 8; n >= 1; --n) { s = 1.0 - s * y2 * (1.0 / ((2 * n) * (2 * n + 1))); c = 1.0 - c * y2 * (1.0 / ((2 * n - 1) * (2 * n))); }
    s *= y;
    const double s2 = 2.0 * s * c, c2 = 1.0 - 2.0 * s * s;
    sn = 2.0 * s2 * c2; cs = 1.0 - 2.0 * s2 * s2;
}
constexpr int IT_IN = 512, IT_OUT = 512, IT_GU = 2816, IT_DN = 1408, IT_L = IT_IN + IT_OUT + IT_GU + IT_DN, IT_GLU = 288, IT_KV = 256, IT_MKV = 256;
constexpr int IT_TOTAL = 4 * IT_L + 2 * IT_GLU + IT_KV + 4 * IT_MKV;
__device__ __forceinline__ void p0_prologue(Frame& F) {
    LAS float* scr = (LAS float*)(F.lds + F.wave * 8448);
    const int gw = F.vcu * NWAVES + F.wave, NGW = F.G * NWAVES, lane = F.otid() & 63;
    for (int it = gw; it < IT_TOTAL; it += NGW) {
        const float* W; const float* gain = nullptr; bf16* WT; int K, N, r, mode = 0;
        if (it < 4 * IT_L) { const int l = it / IT_L; r = it % IT_L;
            if (r < IT_IN) { W = F.w_in() + (size_t)l * 1048576; K = 1024; N = 1024; gain = F.g_mix() + l * 1024; WT = wcat(F, l); }
            else if ((r -= IT_IN) < IT_OUT) { W = F.w_out() + (size_t)l * 1048576; K = 1024; N = 1024; WT = (bf16*)(F.wsb() + WS_WOUT + (size_t)l * 2 * MiB); }
            else if ((r -= IT_OUT) < IT_GU) { W = F.w_gu() + (size_t)l * 1024 * 5632; K = 1024; N = 5632; gain = F.g_ffn() + l * 1024; WT = (bf16*)(F.wsb() + WS_WGU + (size_t)l * WGU_STRIDE); mode = 1; }
            else { r -= IT_GU; W = F.w_down() + (size_t)l * 2816 * 1024; K = 2816; N = 1024; WT = (bf16*)(F.wsb() + WS_WDOWN + (size_t)l * WDOWN_STRIDE); }
        } else { r = it - 4 * IT_L;
            if (r < 2 * IT_GLU) { const int l = r / IT_GLU; r %= IT_GLU; W = F.w_glu() + (size_t)l * 768 * 768; K = 768; N = 768; WT = (bf16*)(F.wsb() + WS_WGLU + (size_t)l * WGLU_STRIDE); }
            else if ((r -= 2 * IT_GLU) < IT_KV) { W = F.w_kv(); K = 1024; N = 512; gain = F.g_kv(); WT = wcat(F, 2) + (size_t)1024 * 1024; }
            else { r -= IT_KV; const int L = r / IT_MKV; r %= IT_MKV; W = F.w_mem_kv() + (size_t)L * 1024 * 512; K = 1024; N = 512; gain = F.g_mem() + L * 1024; WT = wcat(F, 0) + (size_t)(1024 + 512 * L) * 1024; }
        }
        const int nblk = N / 32, kb = r / nblk, nb = r % nblk, k0 = 64 * kb, n0 = 32 * nb;
        int R0 = n0;
        if (mode == 1) { const int j0 = n0 < DFF ? n0 : n0 - DFF; R0 = 256 * (j0 >> 7) + (j0 & 127) + (n0 < DFF ? 0 : 128); }
        tr_item(W, K, N, gain, WT, R0, k0, n0, scr, lane);
    }
    for (int m = gw; m < AROWS; m += NGW) {
        const float* src = m < MP ? F.x_prompt() + (size_t)m * DM : m < MT ? F.x_sample() + (size_t)(m - MP) * DM : m < MROWS ? nullptr : F.mem_prompt() + (size_t)(m - MROWS) * DM;
        f32x4 v[4]; float s = 0.f;
#pragma unroll
        for (int j = 0; j < 4; ++j) { v[j] = src ? *((const GAS f32x4*)src + lane + 64 * j) : (f32x4){0.f, 0.f, 0.f, 0.f}; s += (v[j].x * v[j].x + v[j].y * v[j].y) + (v[j].z * v[j].z + v[j].w * v[j].w); }
        s = wave_sum(s);
#pragma unroll
        for (int j = 0; j < 4; ++j) {
            if (m < MROWS) *((GAS f32x4*)(F.h() + (size_t)m * DM) + lane + 64 * j) = v[j];
            u32x2 w; w.x = pk2(v[j].x, v[j].y); w.y = pk2(v[j].z, v[j].w); *((GAS u32x2*)(F.hb() + (size_t)m * DM) + lane + 64 * j) = w; }
        if (lane < 16) F.ssqa()[(size_t)m * 16 + lane] = lane == 0 ? s : 0.f;
    }
    for (int e = blockIdx.x * (NWAVES * 64) + F.tid; e < 2 * NG * NST; e += F.G * NWAVES * 64) {
        const int lg = e / NST;
        const double dt = dexp_small((double)F.ssm_log_dt()[lg]);
        const double lre = fmin((double)F.ssm_a_re()[e], -1e-4), lim = (double)F.ssm_a_im()[e];
        const double mag = dexp_small(dt * lre); double sn, cs; dsincos(dt * lim, sn, cs);
        const double are = mag * cs, aim = mag * sn, den = lre * lre + lim * lim, nre = are - 1.0;
        const double fre = (nre * lre + aim * lim) / den, fim = (aim * lre - nre * lim) / den;
        F.tab()[e] = (f32x4){(float)are, (float)aim, (float)fre, (float)fim};
    }
    __syncthreads();
    { LAS float* red = (LAS float*)F.lds; const int c4 = F.tid & 63, rgp = F.tid >> 6;
      for (int it = F.vcu; it < NS * 8; it += F.G) { const int s = it >> 3, blk = it & 7;
          const int pg0 = F.page_table()[s * 16 + 2 * blk], pg1 = F.page_table()[s * 16 + 2 * blk + 1];
          f32x4 a = (f32x4){0.f, 0.f, 0.f, 0.f};
#pragma unroll 8
          for (int i = 0; i < 32; ++i) { const int r = rgp + 8 * i; const float* p = F.cache_k() + ((size_t)(r < 128 ? pg0 : pg1) * 128 + (r & 127)) * 256 + 4 * c4; a += *(const f32x4*)p; }
          *(LAS f32x4*)(red + rgp * 256 + 4 * c4) = a;
          __syncthreads();
          if (F.tid < 256) { float t = 0.f;
#pragma unroll
              for (int w = 0; w < 8; ++w) t += red[w * 256 + F.tid];
              F.kmeans()[(size_t)it * 256 + F.tid] = t * (1.0f / 256.0f); }
          __syncthreads(); } }
}

__device__ __forceinline__ bf16x8 pack8(const float (&v)[8]) { v4u w; w.x = cvtpk(v[0], v[1]); w.y = cvtpk(v[2], v[3]); w.z = cvtpk(v[4], v[5]); w.w = cvtpk(v[6], v[7]); return __builtin_bit_cast(bf16x8, w); }
constexpr int XS_ROW = 272, XS_CH = 16 * XS_ROW, XS_WAVE = 2 * XS_CH;
template <bool PC>
__device__ __forceinline__ void s5_item(const Frame& F, int l, int b, int g, int cp, LAS unsigned char* xs) {
    const int lane = F.otid() & 63, j = lane & 31, hi = lane >> 5, lg = l * NG + g;
    const f32x4 t0 = F.tab()[lg * NST + j], t1 = F.tab()[lg * NST + j + 32];
    bf16x8 Bop[4];
#pragma unroll
    for (int s = 0; s < 2; ++s) { const f32x4 tt = s ? t1 : t0; const int p = j + 32 * s;
        const float* br = F.ssm_b_re() + ((size_t)lg * NST + p) * 16 + 8 * hi; const float* bi = F.ssm_b_im() + ((size_t)lg * NST + p) * 16 + 8 * hi;
        const f32x4 r0 = *(const f32x4*)br, r1 = *(const f32x4*)(br + 4), i0 = *(const f32x4*)bi, i1 = *(const f32x4*)(bi + 4);
        float re[8], im[8];
#pragma unroll
        for (int e = 0; e < 4; ++e) { re[e] = tt[2] * r0[e] - tt[3] * i0[e]; im[e] = tt[2] * i0[e] + tt[3] * r0[e]; re[4 + e] = tt[2] * r1[e] - tt[3] * i1[e]; im[4 + e] = tt[2] * i1[e] + tt[3] * r1[e]; }
        Bop[2 * s] = pack8(re); Bop[2 * s + 1] = pack8(im); }
    const int hh = (j >> 2) & 1, rr0 = (j & 3) + 4 * (j >> 3);
    const bf16* ap = F.proj() + ((size_t)(b * SEQ + (cp + 8 * hh) * 256 + rr0)) * DM + 16 * g + 8 * hi;
    const float a0r = t0[0], a0i = t0[1], a1r = t1[0], a1i = t1[1];
    float x0r = 0.f, x0i = 0.f, x1r = 0.f, x1i = 0.f;
    const int c = cp + 8 * hi;
    bf16x8 Cop[4]; f32x4 dsk; const int hq = lane >> 4, tk = lane & 15;
    if (PC) {
        float p0r = a0r, p0i = a0i, p1r = a1r, p1i = a1i;
#pragma unroll
        for (int q = 0; q < 8; ++q) { const float n0r = p0r * p0r - p0i * p0i, n0i = 2.f * p0r * p0i, n1r = p1r * p1r - p1i * p1i, n1i = 2.f * p1r * p1i; p0r = n0r; p0i = n0i; p1r = n1r; p1i = n1i; }
        for (int cc = 0; cc < cp + 8; ++cc) { if (cc < c) {
            const float* e = F.E() + (((size_t)(b * 16 + cc) * NG + g) * NST) * 2; const float e0r = e[2 * j], e0i = e[2 * j + 1], e1r = e[2 * (j + 32)], e1i = e[2 * (j + 32) + 1];
            const float n0r = p0r * x0r - p0i * x0i + e0r, n0i = p0r * x0i + p0i * x0r + e0i, n1r = p1r * x1r - p1i * x1i + e1r, n1i = p1r * x1i + p1i * x1r + e1i; x0r = n0r; x0i = n0i; x1r = n1r; x1i = n1i; } }
#pragma unroll
        for (int kk = 0; kk < 4; ++kk) { const f32x4 cr = *(const f32x4*)(F.ssm_c_re() + ((size_t)lg * 16 + tk) * NST + 16 * kk + 4 * hq), ci = *(const f32x4*)(F.ssm_c_im() + ((size_t)lg * 16 + tk) * NST + 16 * kk + 4 * hq);
            const float cv[8] = {cr[0], -ci[0], cr[1], -ci[1], cr[2], -ci[2], cr[3], -ci[3]}; Cop[kk] = pack8(cv); }
        dsk = *(const f32x4*)(F.ssm_d() + (size_t)lg * 16 + 4 * hq);
    }
    bf16x8 a_nx = *(const bf16x8*)ap;
    for (int st = 0; st < 16; ++st) {
        const bf16x8 a = a_nx; if (st < 15) a_nx = *(const bf16x8*)(ap + (size_t)(st + 1) * 16 * DM);
        const f32x16 z = {};
        const f32x16 br0 = __builtin_amdgcn_mfma_f32_32x32x16_bf16(a, Bop[0], z, 0, 0, 0), bi0 = __builtin_amdgcn_mfma_f32_32x32x16_bf16(a, Bop[1], z, 0, 0, 0);
        const f32x16 br1 = __builtin_amdgcn_mfma_f32_32x32x16_bf16(a, Bop[2], z, 0, 0, 0), bi1 = __builtin_amdgcn_mfma_f32_32x32x16_bf16(a, Bop[3], z, 0, 0, 0);
#pragma unroll
        for (int r = 0; r < 16; ++r) {
            const float n0r = a0r * x0r - a0i * x0i + br0[r], n0i = a0r * x0i + a0i * x0r + bi0[r], n1r = a1r * x1r - a1i * x1i + br1[r], n1i = a1r * x1i + a1i * x1r + bi1[r];
            x0r = n0r; x0i = n0i; x1r = n1r; x1i = n1i;
            if (PC) { LAS unsigned* xr = (LAS unsigned*)(xs + hi * XS_CH + r * XS_ROW); xr[j] = cvtpk(x0r, x0i); xr[j + 32] = cvtpk(x1r, x1i); }
        }
        if (PC) {
#pragma unroll
            for (int h2 = 0; h2 < 2; ++h2) {
                f32x4 ya = (f32x4){0.f, 0.f, 0.f, 0.f};
#pragma unroll
                for (int kk = 0; kk < 4; ++kk) { const bf16x8 xb = *(const LAS bf16x8*)(xs + h2 * XS_CH + tk * XS_ROW + kk * 64 + hq * 16); ya = __builtin_amdgcn_mfma_f32_16x16x32_bf16(Cop[kk], xb, ya, 0, 0, 0); }
                const size_t tok = (size_t)(b * SEQ + (cp + 8 * h2) * 256 + st * 16 + tk);
                const u32x2 uw = *(const u32x2*)(F.proj() + tok * DM + 16 * g + 4 * hq);
                const float y0 = gelu_tanh(ya[0] + dsk[0] * bflo(uw.x)), y1 = gelu_tanh(ya[1] + dsk[1] * bfhi(uw.x)), y2 = gelu_tanh(ya[2] + dsk[2] * bflo(uw.y)), y3 = gelu_tanh(ya[3] + dsk[3] * bfhi(uw.y));
                u32x2 ow; ow.x = cvtpk(y0, y1); ow.y = cvtpk(y2, y3); *(u32x2*)(F.ybuf() + tok * MIXW + 16 * g + 4 * hq) = ow;
            }
        }
    }
    if (!PC) { float* e = F.E() + (((size_t)(b * 16 + c) * NG + g) * NST) * 2; e[2 * j] = x0r; e[2 * j + 1] = x0i; e[2 * (j + 32)] = x1r; e[2 * (j + 32) + 1] = x1i; }
    else if (c == 15) { const size_t o = ((size_t)(l * NBATCH + b) * NG + g) * NST; F.out()[OFF_PSR + o + j] = x0r; F.out()[OFF_PSI + o + j] = x0i; F.out()[OFF_PSR + o + j + 32] = x1r; F.out()[OFF_PSI + o + j + 32] = x1i; }
}
__device__ __forceinline__ void s5_sample(const Frame& F, int l, int s, int g) {
    const int p = F.otid() & 63, lg = l * NG + g; const size_t row = MP + s;
    const f32x4 tt = F.tab()[lg * NST + p];
    const v4u ua = *(const v4u*)(F.proj() + row * DM + 16 * g), ub = *(const v4u*)(F.proj() + row * DM + 16 * g + 8);
    const float u[16] = {bflo(ua.x), bfhi(ua.x), bflo(ua.y), bfhi(ua.y), bflo(ua.z), bfhi(ua.z), bflo(ua.w), bfhi(ua.w), bflo(ub.x), bfhi(ub.x), bflo(ub.y), bfhi(ub.y), bflo(ub.z), bfhi(ub.z), bflo(ub.w), bfhi(ub.w)};
    const float* br = F.ssm_b_re() + ((size_t)lg * NST + p) * 16; const float* bi = F.ssm_b_im() + ((size_t)lg * NST + p) * 16;
    float sr = 0.f, si = 0.f;
#pragma unroll
    for (int q = 0; q < 4; ++q) { const f32x4 r4 = *(const f32x4*)(br + 4 * q), i4 = *(const f32x4*)(bi + 4 * q);
#pragma unroll
        for (int e = 0; e < 4; ++e) { sr += r4[e] * u[4 * q + e]; si += i4[e] * u[4 * q + e]; } }
    const float bur = tt[2] * sr - tt[3] * si, bui = tt[2] * si + tt[3] * sr;
    const size_t so = ((size_t)(l * NS + s) * NG + g) * NST + p;
    const float h0r = F.st_re()[so], h0i = F.st_im()[so];
    const float xr = tt[0] * h0r - tt[1] * h0i + bur, xi = tt[0] * h0i + tt[1] * h0r + bui;
    F.out()[OFF_SSR + so] = xr; F.out()[OFF_SSI + so] = xi;
    float my = 0.f;
#pragma unroll
    for (int hh = 0; hh < 16; ++hh) { float tv = F.ssm_c_re()[((size_t)lg * 16 + hh) * NST + p] * xr - F.ssm_c_im()[((size_t)lg * 16 + hh) * NST + p] * xi; tv = wave_sum(tv); if (p == hh) my = tv + F.ssm_d()[lg * 16 + hh] * u[hh]; }
    if (p < 16) F.ybuf()[row * MIXW + 16 * g + p] = (bf16)cvtpk(gelu_tanh(my), 0.f);
}

__device__ __forceinline__ void memkv_norm(const Frame& F) {
    const int gw = F.vcu * NWAVES + F.wave, NGW = F.G * NWAVES, lane = F.otid() & 63;
    for (int it = gw; it < 4 * MEMR; it += NGW) { const int L = it / MEMR;
        float* kp = F.out() + OFF_PMK + (size_t)it * 256 + 4 * lane; const float* vp = F.out() + OFF_PMV + (size_t)it * 256 + 4 * lane;
        f32x4 k = *(const f32x4*)kp; const f32x4 v = *(const f32x4*)vp;
        const float ss = sum16((k[0] * k[0] + k[1] * k[1]) + (k[2] * k[2] + k[3] * k[3])); const float rs = __builtin_amdgcn_rsqf(ss * (1.0f / 64.0f) + EPS);
        const f32x4 gk = *(const f32x4*)(F.g_mk() + L * 64 + ((4 * lane) & 63)); k = k * rs * gk; *(f32x4*)kp = k;
        u32x2 w; w.x = cvtpk(k[0], k[1]); w.y = cvtpk(k[2], k[3]); *(u32x2*)(F.memkb() + (size_t)it * 256 + 4 * lane) = w;
        w.x = cvtpk(v[0], v[1]); w.y = cvtpk(v[2], v[3]); *(u32x2*)(F.memvb() + (size_t)it * 256 + 4 * lane) = w; }
}
__device__ __forceinline__ void kv_norm(const Frame& F) {
    LAS float* red = (LAS float*)F.lds; const int lane = F.otid() & 63, wave = F.wave;
    for (int it = F.vcu; it < 65; it += F.G) {
        const int nrow = it < 64 ? 32 : 16; f32x4 acc = (f32x4){0.f, 0.f, 0.f, 0.f};
        const f32x4 gk = *(const f32x4*)(F.g_k() + ((4 * lane) & 63));
        for (int i = 0; i < nrow; ++i) { const size_t row = (size_t)it * 256 + wave * nrow + i;
            f32x4 k = *(const f32x4*)(F.kvraw() + row * 512 + 4 * lane); const f32x4 v = *(const f32x4*)(F.kvraw() + row * 512 + 256 + 4 * lane);
            const float ss = sum16((k[0] * k[0] + k[1] * k[1]) + (k[2] * k[2] + k[3] * k[3])); const float rs = __builtin_amdgcn_rsqf(ss * (1.0f / 64.0f) + EPS);
            k = k * rs * gk; acc += k;
            float* ko = row < MP ? F.out() + OFF_PK + row * 256 : F.out() + OFF_SK + (row - MP) * 256; float* vo = row < MP ? F.out() + OFF_PV + row * 256 : F.out() + OFF_SV + (row - MP) * 256;
            *(f32x4*)(ko + 4 * lane) = k; *(f32x4*)(vo + 4 * lane) = v;
            u32x2 w; w.x = cvtpk(k[0], k[1]); w.y = cvtpk(k[2], k[3]); *(u32x2*)(F.kbuf() + row * 256 + 4 * lane) = w;
            w.x = cvtpk(v[0], v[1]); w.y = cvtpk(v[2], v[3]); *(u32x2*)(F.vbuf() + row * 256 + 4 * lane) = w; }
        *(LAS f32x4*)(red + wave * 256 + 4 * lane) = acc;
        __syncthreads();
        if (it < 64 && F.tid < 256) { float t = 0.f;
#pragma unroll
            for (int w = 0; w < 8; ++w) t += red[w * 256 + F.tid];
            F.kmeanp()[(size_t)it * 256 + F.tid] = (bf16)cvtpk(t * (1.0f / 256.0f), 0.f); }
        __syncthreads(); }
}

template <bool MOBA>
__device__ __forceinline__ void decode_item(const Frame& F, int l, int s, int hd) {
    LAS float* sc = (LAS float*)F.lds; LAS float* red = (LAS float*)(F.lds + 4096); LAS float* misc = (LAS float*)(F.lds + 12288); LAS int* segs = (LAS int*)(F.lds + 12288 + 256);
    const int t = F.otid(), rg = t >> 4, lq = t & 15, wave = F.wave;
    const size_t row = MP + s; const int qcol = MOBA ? hd * 64 : MIXW + hd * 64, kvh = MOBA ? hd / 3 : hd;
    const float* gq = MOBA ? F.g_q() + (l - 2) * 64 : F.g_mq() + l * 64;
    const u32x2 qw = *(const u32x2*)(F.proj() + row * DM + qcol + 4 * lq);
    float q0 = bflo(qw.x), q1 = bfhi(qw.x), q2 = bflo(qw.y), q3 = bfhi(qw.y);
    { const float ss = sum16((q0 * q0 + q1 * q1) + (q2 * q2 + q3 * q3)); const float rs = __builtin_amdgcn_rsqf(ss * (1.0f / 64.0f) + EPS) * C2; const f32x4 g4 = *(const f32x4*)(gq + 4 * lq);
      q0 *= rs * g4[0]; q1 *= rs * g4[1]; q2 *= rs * g4[2]; q3 *= rs * g4[3]; }
    __syncthreads();
    if (MOBA) {
        if (rg < 8) { const f32x4 km = *(const f32x4*)(F.kmeans() + ((size_t)(s * 8 + rg)) * 256 + kvh * 64 + 4 * lq); const float d = sum16((q0 * km[0] + q1 * km[1]) + (q2 * km[2] + q3 * km[3])); if (lq == 0) misc[rg] = d; }
        __syncthreads();
        if (t == 0) { float g0 = misc[0], g1 = misc[1], g2 = misc[2], g3 = misc[3], g4 = misc[4], g5 = misc[5], g6 = misc[6], g7 = misc[7]; unsigned selm = 0u;
#pragma unroll
            for (int k = 0; k < 3; ++k) { float best = g0; int bi = 0;
                if (g1 > best) { best = g1; bi = 1; } if (g2 > best) { best = g2; bi = 2; } if (g3 > best) { best = g3; bi = 3; } if (g4 > best) { best = g4; bi = 4; } if (g5 > best) { best = g5; bi = 5; } if (g6 > best) { best = g6; bi = 6; } if (g7 > best) { best = g7; bi = 7; }
                selm |= 1u << bi; const float NI = -INFINITY;
                g0 = bi == 0 ? NI : g0; g1 = bi == 1 ? NI : g1; g2 = bi == 2 ? NI : g2; g3 = bi == 3 ? NI : g3; g4 = bi == 4 ? NI : g4; g5 = bi == 5 ? NI : g5; g6 = bi == 6 ? NI : g6; g7 = bi == 7 ? NI : g7; }
            int n = 0;
            for (int jb = 0; jb < 8; ++jb) if ((selm >> jb) & 1u) { segs[n++] = F.page_table()[s * 16 + 2 * jb]; segs[n++] = F.page_table()[s * 16 + 2 * jb + 1]; } }
        __syncthreads();
    }
    constexpr int NSEG = MOBA ? 6 : 2;
#pragma unroll
    for (int sg = 0; sg < NSEG; ++sg) {
        const float* kb = MOBA ? F.cache_k() + (size_t)segs[sg] * 32768 + kvh * 64 : F.cache_mem_k() + ((size_t)((l * NS + s) * 256 + sg * 128)) * 256 + hd * 64;
        f32x4 kv[4];
#pragma unroll
        for (int i = 0; i < 4; ++i) kv[i] = *(const f32x4*)(kb + (size_t)(i * 32 + rg) * 256 + 4 * lq);
#pragma unroll
        for (int i = 0; i < 4; ++i) { const float d = sum16((q0 * kv[i][0] + q1 * kv[i][1]) + (q2 * kv[i][2] + q3 * kv[i][3])); if (lq == 0) sc[sg * 128 + i * 32 + rg] = d; }
    }
    constexpr int NKEY = NSEG * 128 + (MOBA ? 1 : 0);
    if (MOBA && rg == 0) { const f32x4 kn = *(const f32x4*)(F.out() + OFF_SK + (size_t)s * 256 + kvh * 64 + 4 * lq); const float d = sum16((q0 * kn[0] + q1 * kn[1]) + (q2 * kn[2] + q3 * kn[3])); if (lq == 0) sc[NSEG * 128] = d; }
    __syncthreads();
    float m = -INFINITY;
    for (int i = t; i < NKEY; i += NWAVES * 64) m = fmaxf(m, sc[i]);
    m = wave_max(m); if (F.lane == 0) misc[16 + wave] = m;
    __syncthreads();
    m = fmaxf(fmaxf(fmaxf(misc[16], misc[17]), fmaxf(misc[18], misc[19])), fmaxf(fmaxf(misc[20], misc[21]), fmaxf(misc[22], misc[23])));
    float sm = 0.f;
    for (int i = t; i < NKEY; i += NWAVES * 64) { const float p = __builtin_amdgcn_exp2f(sc[i] - m); sc[i] = p; sm += p; }
    sm = wave_sum(sm); if (F.lane == 0) misc[24 + wave] = sm;
    __syncthreads();
    const float tot = ((misc[24] + misc[25]) + (misc[26] + misc[27])) + ((misc[28] + misc[29]) + (misc[30] + misc[31]));
    f32x4 acc = (f32x4){0.f, 0.f, 0.f, 0.f};
#pragma unroll
    for (int sg = 0; sg < NSEG; ++sg) {
        const float* vb = MOBA ? F.cache_v() + (size_t)segs[sg] * 32768 + kvh * 64 : F.cache_mem_v() + ((size_t)((l * NS + s) * 256 + sg * 128)) * 256 + hd * 64;
        f32x4 vv[4];
#pragma unroll
        for (int i = 0; i < 4; ++i) vv[i] = *(const f32x4*)(vb + (size_t)(i * 32 + rg) * 256 + 4 * lq);
#pragma unroll
        for (int i = 0; i < 4; ++i) acc += vv[i] * sc[sg * 128 + i * 32 + rg];
    }
    if (MOBA && rg == 0) { const f32x4 vn = *(const f32x4*)(F.out() + OFF_SV + (size_t)s * 256 + kvh * 64 + 4 * lq); acc += vn * sc[NSEG * 128]; }
    *(LAS f32x4*)(red + rg * 64 + 4 * lq) = acc;
    __syncthreads();
    if (t < 64) { float o = 0.f;
#pragma unroll 8
        for (int r = 0; r < 32; ++r) o += red[r * 64 + t];
        F.mixo()[row * DM + qcol + t] = (bf16)cvtpk(o * __builtin_amdgcn_rcpf(tot), 0.f); }
}

constexpr int N_PHASES = 29;
__host__ __device__ constexpr bool phase_exists(int p) { if (p == 0) return true; const int l = (p - 1) / 7, k = (p - 1) % 7; if (k == 1) return l <= 2; if (k == 3) return l < 2; return true; }

__global__ void __launch_bounds__(NWAVES * 64, 2) fwd(Args args) {
    extern __shared__ __attribute__((aligned(16))) unsigned char lds[];
    Frame F;
    F.lds = (LAS unsigned char*)lds; F.MISC = (volatile LAS unsigned*)(F.lds + MISC_OFF);
    F.tid = threadIdx.x; F.lane = F.tid & 63; F.wave = __builtin_amdgcn_readfirstlane(F.tid >> 6);
    F.G = gridDim.x; { const int bx = blockIdx.x; F.vcu = (F.G % 8 == 0) ? (bx % 8) * (F.G / 8) + bx / 8 : bx; }
    F.ap = (const __attribute__((address_space(4))) Args*)__builtin_amdgcn_kernarg_segment_ptr(); F.ctl = (gu32*)(args.ws + WS_CTL);
    for (int u = F.tid; u < (LDS_BYTES - LDSCTL_OFF) / 4; u += NWAVES * 64) ((LAS unsigned*)(F.lds + LDSCTL_OFF))[u] = 0u;
    __syncthreads();
    XcdBarrier bar = xcd_barrier_post((unsigned*)(F.ctl + CW_BAR) + args.li * XCD_BAR_WORDS, F.MISC + 8);
    const int lo = args.ph_lo, hi = args.ph_hi;
#define IN(p) (lo <= (p) && (p) < hi)
#define SEAM(p) do { if ((p) + 1 < hi) xcd_barrier(bar); } while (0)

    if (IN(0)) {
#ifndef DBG_NOINITBAR
        if (hi - lo > 1) xcd_barrier(bar);
#endif
        p0_prologue(F); SEAM(0); }

    for (int l = 0; l < 4; ++l) {
        const int pb = 1 + 7 * l;
        if (IN(pb)) {
            pg8::Gemm g{F.hb(), wcat(F, l), AROWS, 0, DM};
            pg8::ListSched S; S.init(NPT, l == 2 ? 6 : 4, NPT, l == 0 ? 4 : 0, 4, 8, F.G, (int)blockIdx.x);
            pg8::EpiProj E{F.ssqa(), F.proj(), F.kvraw(), F.out() + OFF_PMK, F.out() + OFF_PMV, NPT};
            pg8::gemm_phase<pg8::EpiProj, pg8::ListSched, true, true>(F.lds, g, S, E);
            SEAM(pb);
        }
        if (l < 2) {
            if (IN(pb + 1)) {
                if (F.wave < 6) { const int item = F.vcu * 6 + F.wave; if (item < NBATCH * NG * 8) s5_item<false>(F, l, item / (NG * 8), (item % (NG * 8)) / 8, item % 8, nullptr); }
                if (l == 0) memkv_norm(F);
                SEAM(pb + 1);
            }
            if (IN(pb + 2)) {
                if (F.wave < 6) { const int item = F.vcu * 6 + F.wave; if (item < NBATCH * NG * 8) s5_item<true>(F, l, item / (NG * 8), (item % (NG * 8)) / 8, item % 8, F.lds + F.wave * XS_WAVE); }
                { const int gw = F.vcu * NWAVES + F.wave; for (int it = gw; it < NS * NG; it += F.G * NWAVES) s5_sample(F, l, it / NG, it % NG); }
                __syncthreads();
                for (int u = F.vcu; u < 256; u += F.G) { const int b = u >> 6, mh = (u >> 4) & 3, qb = u & 15; const size_t row0 = (size_t)b * SEQ + qb * 256;
                    attn_body::attn_unit<0, 8>(qb, F.proj() + row0 * DM + MIXW + mh * 64, F.memkb() + ((size_t)(l * MEMR + b * 256)) * 256 + mh * 64, F.memvb() + ((size_t)(l * MEMR + b * 256)) * 256 + mh * 64,
                                               F.mixo() + row0 * DM + MIXW + mh * 64, F.g_mq() + l * 64, nullptr, (char*)lds); }
                __syncthreads();
                for (int it = F.vcu; it < NS * 4; it += F.G) decode_item<false>(F, l, it >> 2, it & 3);
                SEAM(pb + 2);
            }
            if (IN(pb + 3)) {
                pg8::Gemm g{F.ybuf(), (const bf16*)(F.wsb() + WS_WGLU + (size_t)l * WGLU_STRIDE), MROWS, MIXW, MIXW};
                pg8::ListSched S; S.init(NPT, 3, 0, 0, 0, 0, F.G, (int)blockIdx.x);
                pg8::EpiGlu E{F.ybuf(), F.mixo()};
                pg8::gemm_phase<pg8::EpiGlu, pg8::ListSched, true, true>(F.lds, g, S, E);
                SEAM(pb + 3);
            }
        } else {
            if (l == 2 && IN(pb + 1)) { kv_norm(F); SEAM(pb + 1); }
            if (IN(pb + 2)) {
                if (F.G == 256) { const int grp = F.vcu >> 4, k = F.vcu & 15;
                    for (int i = 0; i < 3; ++i) { const int bh = 3 * grp + i, b = bh / NQH, hq = bh % NQH, kvh = hq / 3;
                        const int qb = i == 0 ? k : i == 1 ? ((k + 8) & 15) : (k < 8 ? 15 - 2 * k : 30 - 2 * k); const size_t row0 = (size_t)b * SEQ + qb * 256;
                        attn_body::attn_unit<1, 8>(qb, F.proj() + row0 * DM + hq * 64, F.kbuf() + ((size_t)b * SEQ) * 256 + kvh * 64, F.vbuf() + ((size_t)b * SEQ) * 256 + kvh * 64,
                                                   F.mixo() + row0 * DM + hq * 64, F.g_q() + (l - 2) * 64, F.kmeanp() + ((size_t)b * 16) * 256 + kvh * 64, (char*)lds); } }
                else { for (int u = F.vcu; u < NBATCH * NQH * 16; u += F.G) { const int bh = u >> 4, qb = u & 15, b = bh / NQH, hq = bh % NQH, kvh = hq / 3; const size_t row0 = (size_t)b * SEQ + qb * 256;
                        attn_body::attn_unit<1, 8>(qb, F.proj() + row0 * DM + hq * 64, F.kbuf() + ((size_t)b * SEQ) * 256 + kvh * 64, F.vbuf() + ((size_t)b * SEQ) * 256 + kvh * 64,
                                                   F.mixo() + row0 * DM + hq * 64, F.g_q() + (l - 2) * 64, F.kmeanp() + ((size_t)b * 16) * 256 + kvh * 64, (char*)lds); } }
                for (int u = F.vcu; u < 256; u += F.G) { const int b = u >> 6, mh = (u >> 4) & 3, qb = u & 15; const size_t row0 = (size_t)b * SEQ + qb * 256;
                    attn_body::attn_unit<0, 8>(qb, F.proj() + row0 * DM + MIXW + mh * 64, F.memkb() + ((size_t)(l * MEMR + b * 256)) * 256 + mh * 64, F.memvb() + ((size_t)(l * MEMR + b * 256)) * 256 + mh * 64,
                                               F.mixo() + row0 * DM + MIXW + mh * 64, F.g_mq() + l * 64, nullptr, (char*)lds); }
                __syncthreads();
                for (int it = F.vcu; it < NS * NQH; it += F.G) decode_item<true>(F, l, it / NQH, it % NQH);
                for (int it = F.vcu; it < NS * 4; it += F.G) decode_item<false>(F, l, it >> 2, it & 3);
                SEAM(pb + 2);
            }
        }
        if (IN(pb + 4)) {
            pg8::Gemm g{F.mixo(), (const bf16*)(F.wsb() + WS_WOUT + (size_t)l * 2 * MiB), MROWS, DM, DM};
            pg8::ListSched S; S.init(NPT, 4, 0, 0, 0, 0, F.G, (int)blockIdx.x);
            pg8::EpiResid E{F.h(), F.hb(), F.ssqb(), nullptr, 0};
            pg8::gemm_phase<pg8::EpiResid, pg8::ListSched, true, true>(F.lds, g, S, E);
            SEAM(pb + 4);
        }
        if (IN(pb + 5)) {
            pg8::Gemm g{F.hb(), (const bf16*)(F.wsb() + WS_WGU + (size_t)l * WGU_STRIDE), MROWS, 2 * DFF, DM};
            pg8::ListSched S; S.init(NPT, 22, 0, 0, 0, 0, F.G, (int)blockIdx.x);
            pg8::EpiSwiglu E{F.ssqb(), F.ffh()};
            pg8::gemm_phase<pg8::EpiSwiglu, pg8::ListSched, true, true>(F.lds, g, S, E);
            SEAM(pb + 5);
        }
        if (IN(pb + 6)) {
            pg8::Gemm g{F.ffh(), (const bf16*)(F.wsb() + WS_WDOWN + (size_t)l * WDOWN_STRIDE), MROWS, DM, DFF};
            pg8::ListSched S; S.init(NPT, 4, 0, 0, 0, 0, F.G, (int)blockIdx.x);
            pg8::EpiResid E{F.h(), F.hb(), F.ssqa(), l == 3 ? F.out() + OFF_Y : nullptr, MT};
            pg8::gemm_phase<pg8::EpiResid, pg8::ListSched, true, true>(F.lds, g, S, E);
            SEAM(pb + 6);
        }
    }
    if (hi - lo > 1) xcd_barrier(bar);
#undef IN
#undef SEAM
}

#ifndef MK_ONE_LAUNCH
#define MK_ONE_LAUNCH 0
#endif
extern "C" void kernel_launch(void* const* d_in, const int* in_sizes, int n_in, void* d_out, int out_size, void* d_ws, size_t ws_size, hipStream_t stream) {
    static int grid = 0;
    if (grid == 0) {
        if (n_in != 33 || out_size != (int)OUT_TOTAL || ws_size < WS_END) { fprintf(stderr, "kernel_launch: unexpected shapes: n_in %d out %d ws %zu; nothing launched\n", n_in, out_size, ws_size); grid = -1; return; }
        int dev = 0, cus = 0, per_cu = 0;
        if (hipGetDevice(&dev) != hipSuccess || hipDeviceGetAttribute(&cus, hipDeviceAttributeMultiprocessorCount, dev) != hipSuccess) { fprintf(stderr, "kernel_launch: device query failed\n"); grid = -1; return; }
        if (hipFuncSetAttribute((const void*)fwd, hipFuncAttributeMaxDynamicSharedMemorySize, LDS_BYTES) != hipSuccess) { fprintf(stderr, "kernel_launch: hipFuncSetAttribute failed\n"); grid = -1; return; }
        if (hipOccupancyMaxActiveBlocksPerMultiprocessor(&per_cu, (const void*)fwd, NWAVES * 64, LDS_BYTES) != hipSuccess || per_cu < 1) fprintf(stderr, "kernel_launch: note: occupancy query reports %d workgroups per CU\n", per_cu);
        (void)hipGetLastError();
        grid = cus;
    }
    if (grid < 0) return;
    if (hipMemsetAsync((char*)d_ws + WS_CTL, 0, CTL_ZERO_BYTES, stream) != hipSuccess) { fprintf(stderr, "kernel_launch: memset failed\n"); return; }
    Args a{};
    for (int i = 0; i < 33; ++i) a.in[i] = d_in[i];
    a.out = (float*)d_out; a.ws = (unsigned char*)d_ws; a.pad = 0;
    if (MK_ONE_LAUNCH) {
#ifdef DBG_MAXPH
        a.ph_lo = 0; a.ph_hi = DBG_MAXPH; a.li = 0;
#else
        a.ph_lo = 0; a.ph_hi = N_PHASES; a.li = 0;
#endif
        hipLaunchKernelGGL(fwd, dim3(grid), dim3(NWAVES * 64), LDS_BYTES, stream, a);
        const hipError_t le = hipPeekAtLastError(); if (le != hipSuccess) fprintf(stderr, "kernel_launch: launch failed: %s\n", hipGetErrorName(le));
    } else {
        int li = 0;
        for (int p = 0; p < N_PHASES; ++p) { if (!phase_exists(p)) continue;
            a.ph_lo = p; a.ph_hi = p + 1; a.li = li++;
            hipLaunchKernelGGL(fwd, dim3(grid), dim3(NWAVES * 64), LDS_BYTES, stream, a);
            const hipError_t le = hipPeekAtLastError(); if (le != hipSuccess) { fprintf(stderr, "kernel_launch: launch %d failed: %s\n", p, hipGetErrorName(le)); break; } }
    }
}
```

```cpp
#include <hip/hip_runtime.h>
#include <cstdio>
#include <cstdint>
#include <cmath>
#define MK_ONE_LAUNCH 1
namespace pg8 {
#define PG8_LAS __attribute__((address_space(3)))
typedef unsigned short bf16_t;
typedef short bf16x8 __attribute__((ext_vector_type(8)));
typedef float f32x4 __attribute__((ext_vector_type(4)));
typedef unsigned u32x4 __attribute__((ext_vector_type(4)));
constexpr int BM = 256, BK = 64, HALF = 128, HTB = HALF * BK * 2  , STAGE_BYTES = 8 * HTB, NXCD = 8, WGM = 8;

__host__ __device__ __forceinline__ int lds_byte(int r, int c) { const int st = (r >> 4) * 2 + (c >> 5), rr = r & 15, cc = c & 31, ob = rr * 64 + cc * 2; return st * 1024 + (ob ^ (((ob >> 9) & 1) << 5)); }
__host__ __device__ __forceinline__ void stage_rc(int b, int& R, int& C) { const int st = b / 1024, sb = b % 1024, swz = sb ^ (((sb >> 9) & 1) << 5); R = (st >> 1) * 16 + swz / 64; C = (st & 1) * 32 + (swz % 64) / 2; }
__host__ __device__ __forceinline__ int perm32(int rho) { const int n = rho >> 4, i = rho & 15; return 8 * (i >> 2) + 4 * n + (i & 3); }

struct Unit { int pm, pn; };
struct Gemm { const bf16_t* A; const bf16_t* Bt; int M, N, K; };

struct StaticOrder {
    int nM, nN, nwg, G, c;
    __host__ __device__ void init(int M, int N, int G_, int c_) { nM = M / BM; nN = N / BM; nwg = nM * nN; G = G_; c = c_; }
    __host__ __device__ bool next(int i, Unit& u) const {
        const long L = (long)i * G + c; if (L >= nwg) return false;
        int wgid = (int)L; { const int q = nwg / NXCD, r = nwg % NXCD, xcd = wgid % NXCD, off = wgid / NXCD; wgid = (xcd < r ? xcd * (q + 1) : r * (q + 1) + (xcd - r) * q) + off; }
        const int nig = WGM * nN, gid = wgid / nig, fm = gid * WGM, gsz = (nM - fm) < WGM ? (nM - fm) : WGM;
        u.pm = fm + ((wgid % nig) % gsz); u.pn = (wgid % nig) / gsz; return true;
    }
    __device__ __forceinline__ void a_ready(const Unit&) const {}
    __device__ __forceinline__ void done(const Unit&) const {}
};

struct ListSched {
    int nM0, nN0, m1, nM1, n1, nN1, n0, ntot, G, c;
    __device__ void init(int nM0_, int nN0_, int m1_, int nM1_, int n1_, int nN1_, int G_, int c_) { nM0 = nM0_; nN0 = nN0_; m1 = m1_; nM1 = nM1_; n1 = n1_; nN1 = nN1_; n0 = nM0_ * nN0_; ntot = n0 + nM1_ * nN1_; G = G_; c = c_; }
    __device__ bool next(int i, Unit& u) const {
        const long L = (long)i * G + c; if (L >= ntot) return false;
        if (L < n0) {
            int wgid = (int)L; const int nwg = n0; { const int q = nwg / NXCD, r = nwg % NXCD, xcd = wgid % NXCD, off = wgid / NXCD; wgid = (xcd < r ? xcd * (q + 1) : r * (q + 1) + (xcd - r) * q) + off; }
            const int nig = WGM * nN0, gid = wgid / nig, fm = gid * WGM, gsz = (nM0 - fm) < WGM ? (nM0 - fm) : WGM;
            u.pm = fm + ((wgid % nig) % gsz); u.pn = (wgid % nig) / gsz;
        } else { const int r = (int)L - n0; u.pm = m1 + r % nM1; u.pn = n1 + r / nM1; }
        return true;
    }
    __device__ __forceinline__ void a_ready(const Unit&) const {}
    __device__ __forceinline__ void done(const Unit&) const {}
};
__device__ __forceinline__ unsigned cvt_pk_bf16(float lo, float hi) { unsigned r; asm volatile("v_cvt_pk_bf16_f32 %0, %1, %2" : "=v"(r) : "v"(lo), "v"(hi)); return r; }
__device__ __forceinline__ float bf_lo(unsigned w) { return __builtin_bit_cast(float, w << 16); }
__device__ __forceinline__ float bf_hi(unsigned w) { return __builtin_bit_cast(float, w & 0xffff0000u); }
constexpr float RMS_EPS = 1e-6f;
__device__ __forceinline__ float row_rstd(const float* ssq, int row, int fq) {
    const f32x4 p = *(const f32x4*)(ssq + (size_t)row * 16 + 4 * fq);
    float s = (p[0] + p[1]) + (p[2] + p[3]); s += __shfl_xor(s, 16); s += __shfl_xor(s, 32);
    return __builtin_amdgcn_rsqf(s * (1.0f / 1024.0f) + RMS_EPS);
}
__device__ __forceinline__ float sigm(float x) { return __builtin_amdgcn_rcpf(1.0f + __builtin_amdgcn_exp2f(-1.4426950408889634f * x)); }
typedef float f32x2p __attribute__((ext_vector_type(2)));
__device__ __forceinline__ f32x2p sigm2_of_t(f32x2p t2) { f32x2p a; a.x = __builtin_amdgcn_exp2f(t2.x); a.y = __builtin_amdgcn_exp2f(t2.y); a = a + 1.0f; f32x2p s; s.x = __builtin_amdgcn_rcpf(a.x); s.y = __builtin_amdgcn_rcpf(a.y); return s; }

struct EpiProj {
    static constexpr bool PERM = true, AFTER_DRAIN = false;
    const float* ssq; bf16_t* proj; float* kvraw; float* pmk; float* pmv; int npt;
    __device__ __forceinline__ void operator()(const f32x4 (&acc)[2][2][4][2], const Unit& u, int wr, int wc, int fr, int fq) const {
        const int row0 = u.pm * BM + wr * 64 + fr, cl = wc * 32 + 8 * fq;
#pragma unroll
        for (int ai = 0; ai < 2; ++ai)
#pragma unroll
            for (int m = 0; m < 4; ++m) {
                const int row = row0 + ai * HALF + m * 16; const float rs = row_rstd(ssq, row, fq);
                if (u.pm < npt) {
                    if (u.pn < 4) { bf16_t* rowp = proj + (size_t)row * 1024 + u.pn * BM + cl;
#pragma unroll
                        for (int bj = 0; bj < 2; ++bj) { const f32x4 v0 = acc[ai][bj][m][0] * rs, v1 = acc[ai][bj][m][1] * rs; u32x4 w; w.x = cvt_pk_bf16(v0[0], v0[1]); w.y = cvt_pk_bf16(v0[2], v0[3]); w.z = cvt_pk_bf16(v1[0], v1[1]); w.w = cvt_pk_bf16(v1[2], v1[3]); *(u32x4*)(rowp + bj * HALF) = w; }
                    } else { float* rowp = kvraw + (size_t)row * 512 + (u.pn - 4) * BM + cl;
#pragma unroll
                        for (int bj = 0; bj < 2; ++bj) { *(f32x4*)(rowp + bj * HALF) = acc[ai][bj][m][0] * rs; *(f32x4*)(rowp + bj * HALF + 4) = acc[ai][bj][m][1] * rs; }
                    }
                } else { const int t = u.pn - 4; float* rowp = ((t & 1) ? pmv : pmk) + (size_t)(t >> 1) * 262144 + (size_t)(row - npt * BM) * 256 + cl;
#pragma unroll
                    for (int bj = 0; bj < 2; ++bj) { *(f32x4*)(rowp + bj * HALF) = acc[ai][bj][m][0] * rs; *(f32x4*)(rowp + bj * HALF + 4) = acc[ai][bj][m][1] * rs; }
                }
            }
    }
};
struct EpiGlu {
    static constexpr bool PERM = true, AFTER_DRAIN = false;
    const bf16_t* y; bf16_t* out;
    __device__ __forceinline__ void operator()(const f32x4 (&acc)[2][2][4][2], const Unit& u, int wr, int wc, int fr, int fq) const {
        const int row0 = u.pm * BM + wr * 64 + fr, col0 = u.pn * BM + wc * 32 + 8 * fq;
#pragma unroll
        for (int ai = 0; ai < 2; ++ai)
#pragma unroll
            for (int m = 0; m < 4; ++m) { const int row = row0 + ai * HALF + m * 16;
#pragma unroll
                for (int bj = 0; bj < 2; ++bj) { const u32x4 yw = *(const u32x4*)(y + (size_t)row * 768 + col0 + bj * HALF); const f32x4 z0 = acc[ai][bj][m][0], z1 = acc[ai][bj][m][1]; u32x4 w;
                    { const float nl = -1.4426950408889634f;
                      const f32x2p s0 = sigm2_of_t((f32x2p){z0[0], z0[1]} * nl), s1 = sigm2_of_t((f32x2p){z0[2], z0[3]} * nl), s2 = sigm2_of_t((f32x2p){z1[0], z1[1]} * nl), s3 = sigm2_of_t((f32x2p){z1[2], z1[3]} * nl);
                      const f32x2p p0 = (f32x2p){bf_lo(yw.x), bf_hi(yw.x)} * s0, p1 = (f32x2p){bf_lo(yw.y), bf_hi(yw.y)} * s1, p2 = (f32x2p){bf_lo(yw.z), bf_hi(yw.z)} * s2, p3 = (f32x2p){bf_lo(yw.w), bf_hi(yw.w)} * s3;
                      w.x = cvt_pk_bf16(p0.x, p0.y); w.y = cvt_pk_bf16(p1.x, p1.y); w.z = cvt_pk_bf16(p2.x, p2.y); w.w = cvt_pk_bf16(p3.x, p3.y); }
                    *(u32x4*)(out + (size_t)row * 1024 + col0 + bj * HALF) = w; } }
    }
};
struct EpiSwiglu {
    static constexpr bool PERM = true, AFTER_DRAIN = false;
    const float* ssq; bf16_t* out;
    __device__ __forceinline__ void operator()(const f32x4 (&acc)[2][2][4][2], const Unit& u, int wr, int wc, int fr, int fq) const {
        const int row0 = u.pm * BM + wr * 64 + fr, col0 = u.pn * HALF + wc * 32 + 8 * fq;
#pragma unroll
        for (int ai = 0; ai < 2; ++ai)
#pragma unroll
            for (int m = 0; m < 4; ++m) { const int row = row0 + ai * HALF + m * 16;
                const float rs = row_rstd(ssq, row, fq);
                const float c1 = -1.4426950408889634f * rs, rs2 = rs * rs;
                f32x2p o2[4];
#pragma unroll
                for (int n = 0; n < 2; ++n)
#pragma unroll
                    for (int h = 0; h < 2; ++h) { const f32x2p g2 = {acc[ai][0][m][n][2 * h], acc[ai][0][m][n][2 * h + 1]}, u2 = {acc[ai][1][m][n][2 * h], acc[ai][1][m][n][2 * h + 1]};
                        o2[2 * n + h] = ((g2 * u2) * rs2) * sigm2_of_t(g2 * c1); }
                u32x4 w; w.x = cvt_pk_bf16(o2[0].x, o2[0].y); w.y = cvt_pk_bf16(o2[1].x, o2[1].y); w.z = cvt_pk_bf16(o2[2].x, o2[2].y); w.w = cvt_pk_bf16(o2[3].x, o2[3].y);
                *(u32x4*)(out + (size_t)row * 2816 + col0) = w; }
    }
};
struct EpiResid {
    static constexpr bool PERM = true, AFTER_DRAIN = false;
    const float* xin; const bf16_t* hin; bf16_t* hb; float* ssq_out; float* yout;
    template <bool XIN>
    __device__ __forceinline__ void body(const f32x4 (&acc)[2][2][4][2], const Unit& u, int wr, int wc, int fr, int fq) const {
        const int row0 = u.pm * BM + wr * 64 + fr, col0 = u.pn * BM + wc * 32 + 8 * fq;
#pragma unroll
        for (int ai = 0; ai < 2; ++ai) {
            u32x4 hw[4][2];
            if (!XIN) {
#pragma unroll
                for (int m = 0; m < 4; ++m)
#pragma unroll
                    for (int bj = 0; bj < 2; ++bj) hw[m][bj] = *(const u32x4*)(hin + (size_t)(row0 + ai * HALF + m * 16) * 1024 + col0 + bj * HALF);
            }
#pragma unroll
            for (int mh = 0; mh < 2; ++mh) {
                f32x4 xv[2][2][2];
                if (XIN) {
#pragma unroll
                    for (int ml = 0; ml < 2; ++ml)
#pragma unroll
                        for (int bj = 0; bj < 2; ++bj) { const float* xp = xin + (size_t)(row0 + ai * HALF + (2 * mh + ml) * 16) * 1024 + col0 + bj * HALF; xv[ml][bj][0] = *(const f32x4*)xp; xv[ml][bj][1] = *(const f32x4*)(xp + 4); }
                }
#pragma unroll
                for (int ml = 0; ml < 2; ++ml) { const int m = 2 * mh + ml, row = row0 + ai * HALF + m * 16; f32x2p ss2 = {0.f, 0.f};
#pragma unroll
                    for (int bj = 0; bj < 2; ++bj) { const size_t off = (size_t)row * 1024 + col0 + bj * HALF; f32x4 v0, v1;
                        if (XIN) { v0 = xv[ml][bj][0]; v1 = xv[ml][bj][1]; }
                        else { const u32x4 h = hw[m][bj]; v0 = (f32x4){bf_lo(h.x), bf_hi(h.x), bf_lo(h.y), bf_hi(h.y)}; v1 = (f32x4){bf_lo(h.z), bf_hi(h.z), bf_lo(h.w), bf_hi(h.w)}; }
                        v0 += acc[ai][bj][m][0]; v1 += acc[ai][bj][m][1];
                        if (yout) { *(f32x4*)(yout + off) = v0; *(f32x4*)(yout + off + 4) = v1; }
                        u32x4 w; w.x = cvt_pk_bf16(v0[0], v0[1]); w.y = cvt_pk_bf16(v0[2], v0[3]); w.z = cvt_pk_bf16(v1[0], v1[1]); w.w = cvt_pk_bf16(v1[2], v1[3]);
                        *(u32x4*)(hb + off) = w;
                        { const f32x2p a0 = {v0[0], v0[1]}, a1 = {v0[2], v0[3]}, a2 = {v1[0], v1[1]}, a3 = {v1[2], v1[3]}; ss2 = a0 * a0 + ss2; ss2 = a1 * a1 + ss2; ss2 = a2 * a2 + ss2; ss2 = a3 * a3 + ss2; } }
                    float ss = ss2.x + ss2.y; ss += __shfl_xor(ss, 16); ss += __shfl_xor(ss, 32);
                    if (fq == 0) ssq_out[(size_t)row * 16 + 4 * u.pn + wc] = ss; }
            }
        }
    }
    __device__ __forceinline__ void operator()(const f32x4 (&acc)[2][2][4][2], const Unit& u, int wr, int wc, int fr, int fq) const {
        if (xin) body<true>(acc, u, wr, wc, fr, fq); else body<false>(acc, u, wr, wc, fr, fq);
    }
};

template <class Epi, class Sched, bool ALIGN_EPI = false, bool SP2 = false>
__device__ __forceinline__ void gemm_phase(PG8_LAS unsigned char* lds, const Gemm g, const Sched& S, const Epi& E) {
    int tid_ = threadIdx.x; asm volatile("" : "+v"(tid_)); const int tid = tid_, wid = __builtin_amdgcn_readfirstlane(tid >> 6), lane = tid & 63, wr = wid >> 2, wc = wid & 3, fr = lane & 15, fq = lane >> 4;
    const int K = g.K, nt = K / BK;
    unsigned voffA[2], voffB[2];
#pragma unroll
    for (int i = 0; i < 2; ++i) { int R, C; stage_rc(tid * 16 + i * 8192, R, C); const int Rb = Epi::PERM ? ((R & ~31) + perm32(R & 31)) : R;
        voffA[i] = (unsigned)(R * K + C) * 2u; voffB[i] = (unsigned)(Rb * K + C) * 2u; }
    const size_t kstep = (size_t)(BK * 2);
    const size_t hstep = (size_t)HALF * K * 2;
    const size_t tstep = 2 * hstep;
    const unsigned ldsw = (unsigned)wid * 1024u;
    const int aoff = lds_byte(wr * 64 + fr, fq * 8), boff = lds_byte(wc * 32 + fr, fq * 8);
#define PG8_SA(b, h) (((b) * 2 + (h)) * HTB)
#define PG8_SB(b, h) ((4 + (b) * 2 + (h)) * HTB)
#define PG8_STAGE(bufoff, gbase, voff) do { _Pragma("unroll") for (int _i = 0; _i < 2; ++_i) \
        __builtin_amdgcn_global_load_lds((const unsigned*)((const char*)(gbase) + (voff)[_i]), (PG8_LAS unsigned*)(lds + (bufoff) + ldsw + _i * 8192), 16, 0, 0); } while (0)
#define PG8_LDA(dst, b, h) do { _Pragma("unroll") for (int m = 0; m < 4; ++m) _Pragma("unroll") for (int k = 0; k < 2; ++k) dst[m][k] = *(const PG8_LAS bf16x8*)(lds + PG8_SA(b, h) + aoff + m * 2048 + k * 1024); } while (0)
#define PG8_LDB(dst, b, h) do { _Pragma("unroll") for (int n = 0; n < 2; ++n) _Pragma("unroll") for (int k = 0; k < 2; ++k) dst[n][k] = *(const PG8_LAS bf16x8*)(lds + PG8_SB(b, h) + boff + n * 2048 + k * 1024); } while (0)
#define PG8_MMA(ai, bj, At, Bt) do { __builtin_amdgcn_s_setprio(1); _Pragma("unroll") for (int m = 0; m < 4; ++m) _Pragma("unroll") for (int n = 0; n < 2; ++n) _Pragma("unroll") for (int k = 0; k < 2; ++k) \
        acc[ai][bj][m][n] = __builtin_amdgcn_mfma_f32_16x16x32_bf16(Bt[n][k], At[m][k], acc[ai][bj][m][n], 0, 0, 0); __builtin_amdgcn_s_setprio(0); } while (0)
#define PG8_WAIT_V(n) asm volatile("s_waitcnt vmcnt(" #n ")" ::: "memory")
#define PG8_WAIT_L(n) asm volatile("s_waitcnt lgkmcnt(" #n ")" ::: "memory")
#define PG8_BAR __builtin_amdgcn_s_barrier()
#define PG8_SCHED __builtin_amdgcn_sched_barrier(0)
    Unit cur, nxt; int ui = 0;
    if (!S.next(0, cur)) return;
    f32x4 acc[2][2][4][2];
#pragma unroll
    for (int a = 0; a < 2; ++a)
#pragma unroll
        for (int b = 0; b < 2; ++b)
#pragma unroll
            for (int m = 0; m < 4; ++m)
#pragma unroll
                for (int n = 0; n < 2; ++n) acc[a][b][m][n] = (f32x4){0.f, 0.f, 0.f, 0.f};
    bf16x8 At[4][2], B0[2][2], B1[2][2];
    const char* cA = (const char*)g.A + (size_t)cur.pm * tstep; const char* cB = (const char*)g.Bt + (size_t)cur.pn * tstep;
    S.a_ready(cur);
    if constexpr (SP2) {
        PG8_STAGE(PG8_SB(0, 0), cB, voffB); PG8_STAGE(PG8_SB(0, 1), cB + hstep, voffB); PG8_STAGE(PG8_SA(0, 0), cA, voffA); PG8_STAGE(PG8_SA(0, 1), cA + hstep, voffA);
        if (wr == 1) PG8_BAR;
        PG8_WAIT_V(2); PG8_BAR;
        PG8_STAGE(PG8_SB(1, 0), cB + kstep, voffB); PG8_STAGE(PG8_SA(1, 0), cA + kstep, voffA); PG8_STAGE(PG8_SB(1, 1), cB + hstep + kstep, voffB);
        PG8_WAIT_V(6); PG8_BAR;
    } else {
        PG8_STAGE(PG8_SB(0, 0), cB, voffB); PG8_STAGE(PG8_SA(0, 0), cA, voffA); PG8_STAGE(PG8_SB(0, 1), cB + hstep, voffB); PG8_STAGE(PG8_SA(0, 1), cA + hstep, voffA);
        if (wr == 1) PG8_BAR;
        PG8_WAIT_V(4); PG8_BAR;
        PG8_STAGE(PG8_SB(1, 0), cB + kstep, voffB); PG8_STAGE(PG8_SA(1, 0), cA + kstep, voffA); PG8_STAGE(PG8_SB(1, 1), cB + hstep + kstep, voffB);
        PG8_WAIT_V(6); PG8_BAR;
    }
    for (;;) {
        const bool has_next = S.next(ui + 1, nxt);
        const char* nA = has_next ? (const char*)g.A + (size_t)nxt.pm * tstep : cA; const char* nB = has_next ? (const char*)g.Bt + (size_t)nxt.pn * tstep : cB;
        for (int t = 0; t < nt; t += 2) {
            const bool last = (t == nt - 2);
            const char* a1 = cA + (size_t)(t + 1) * kstep;
            const char* a2 = last ? nA : cA + (size_t)(t + 2) * kstep; const char* b2 = last ? nB : cB + (size_t)(t + 2) * kstep;
            const char* a3 = a2 + kstep; const char* b3 = b2 + kstep;
            if (last && has_next) S.a_ready(nxt);
            if constexpr (SP2) {
            PG8_LDB(B0, 0, 0); PG8_LDB(B1, 0, 1); PG8_SCHED; PG8_LDA(At, 0, 0); PG8_STAGE(PG8_SA(1, 1), a1 + hstep, voffA);
            PG8_WAIT_V(8); PG8_WAIT_L(0); PG8_BAR; PG8_MMA(0, 0, At, B0); PG8_MMA(0, 1, At, B1); PG8_BAR; PG8_SCHED;
            PG8_LDA(At, 0, 1); PG8_STAGE(PG8_SB(0, 0), b2, voffB); PG8_STAGE(PG8_SB(0, 1), b2 + hstep, voffB); PG8_STAGE(PG8_SA(0, 0), a2, voffA);
            PG8_WAIT_V(8); PG8_WAIT_L(0); PG8_BAR; PG8_MMA(1, 0, At, B0); PG8_MMA(1, 1, At, B1); PG8_BAR; PG8_SCHED;
            PG8_LDB(B0, 1, 0); PG8_LDB(B1, 1, 1); PG8_SCHED; PG8_LDA(At, 1, 0); PG8_STAGE(PG8_SA(0, 1), a2 + hstep, voffA);
            PG8_WAIT_V(8); PG8_WAIT_L(0); PG8_BAR; PG8_MMA(0, 0, At, B0); PG8_MMA(0, 1, At, B1); PG8_BAR; PG8_SCHED;
            PG8_LDA(At, 1, 1); PG8_STAGE(PG8_SB(1, 0), b3, voffB); PG8_STAGE(PG8_SB(1, 1), b3 + hstep, voffB); PG8_STAGE(PG8_SA(1, 0), a3, voffA);
            PG8_WAIT_V(8); PG8_WAIT_L(0); PG8_BAR; PG8_MMA(1, 0, At, B0); PG8_MMA(1, 1, At, B1); PG8_BAR; PG8_SCHED;
            } else {
            PG8_LDB(B0, 0, 0); PG8_SCHED; PG8_LDA(At, 0, 0); PG8_STAGE(PG8_SA(1, 1), a1 + hstep, voffA);
            PG8_WAIT_L(8); PG8_BAR; PG8_WAIT_L(0); PG8_MMA(0, 0, At, B0); PG8_BAR; PG8_SCHED;
            PG8_LDB(B1, 0, 1); PG8_STAGE(PG8_SB(0, 0), b2, voffB);
            PG8_BAR; PG8_WAIT_L(0); PG8_MMA(0, 1, At, B1); PG8_BAR;
            PG8_LDA(At, 0, 1); PG8_STAGE(PG8_SA(0, 0), a2, voffA);
            PG8_BAR; PG8_WAIT_L(0); PG8_MMA(1, 0, At, B0); PG8_BAR; PG8_SCHED;
            PG8_STAGE(PG8_SB(0, 1), b2 + hstep, voffB);
            PG8_WAIT_V(6); PG8_BAR; PG8_MMA(1, 1, At, B1); PG8_BAR;
            PG8_LDB(B0, 1, 0); PG8_SCHED; PG8_LDA(At, 1, 0); PG8_STAGE(PG8_SA(0, 1), a2 + hstep, voffA);
            PG8_WAIT_L(8); PG8_BAR; PG8_WAIT_L(0); PG8_MMA(0, 0, At, B0); PG8_BAR; PG8_SCHED;
            PG8_LDB(B1, 1, 1); PG8_STAGE(PG8_SB(1, 0), b3, voffB);
            PG8_BAR; PG8_WAIT_L(0); PG8_MMA(0, 1, At, B1); PG8_BAR;
            PG8_LDA(At, 1, 1); PG8_STAGE(PG8_SA(1, 0), a3, voffA);
            PG8_BAR; PG8_WAIT_L(0); PG8_MMA(1, 0, At, B0); PG8_BAR; PG8_SCHED;
            PG8_STAGE(PG8_SB(1, 1), b3 + hstep, voffB);
            PG8_WAIT_V(6); PG8_BAR; PG8_MMA(1, 1, At, B1); PG8_BAR;
            }
        }
        if constexpr (ALIGN_EPI) { if (wr == 0) PG8_BAR; }
        if constexpr (!Epi::AFTER_DRAIN) { E(acc, cur, wr, wc, fr, fq); S.done(cur); }
        if (!has_next) break;
#pragma unroll
        for (int a = 0; a < 2; ++a)
#pragma unroll
            for (int b = 0; b < 2; ++b)
#pragma unroll
                for (int m = 0; m < 4; ++m)
#pragma unroll
                    for (int n = 0; n < 2; ++n) acc[a][b][m][n] = (f32x4){0.f, 0.f, 0.f, 0.f};
        cur = nxt; cA = nA; cB = nB; ++ui;
        if constexpr (ALIGN_EPI) { if (wr == 1) PG8_BAR; }
    }
    PG8_WAIT_V(0);
    if constexpr (!ALIGN_EPI) { if (wr == 0) PG8_BAR; }
    PG8_BAR;
    if constexpr (Epi::AFTER_DRAIN) { E.fused(acc, cur, wr, wc, fr, fq, lds, wid, lane); S.done(cur); }
#undef PG8_SA
#undef PG8_SB
#undef PG8_STAGE
#undef PG8_LDA
#undef PG8_LDB
#undef PG8_MMA
#undef PG8_WAIT_V
#undef PG8_WAIT_L
#undef PG8_BAR
#undef PG8_SCHED
}
}
namespace attn_body {
typedef unsigned short bf16;
using bf16x8=__attribute__((ext_vector_type(8)))short;
using s16x4=__attribute__((ext_vector_type(4)))short;
using f32x16=__attribute__((ext_vector_type(16)))float;
using u32x4=__attribute__((ext_vector_type(4)))unsigned;
constexpr int D=64,QP=1024,KVP=256,OP=1024;
constexpr int NW=8,QBLK=32,QB=QBLK*NW,KVBLK=64;
constexpr float NEGB=-1.0e30f;
__device__ __forceinline__ int crow(int r,int hi){return (r&3)+8*(r>>2)+4*hi;}
#define SBAR() __builtin_amdgcn_sched_barrier(0)
__device__ __forceinline__ void cmask(f32x16&p0,f32x16&p1,int jb,int qrel,int hi){
  const float NEG=-INFINITY; int kb=64*jb+4*hi;
  #pragma unroll
  for(int r=0;r<16;++r){int kv=kb+(r&3)+8*(r>>2); if(kv>qrel)p0[r]=NEG; if(kv+32>qrel)p1[r]=NEG;}
}

constexpr int NSLOT=3, SLOTB=8192;
constexpr int LDS_K=0, LDS_V=NSLOT*SLOTB, LDS_WS=2*NSLOT*SLOTB, LDS_OST=LDS_WS+NW*64*4, LDS_BYTES=LDS_OST+NW*4096;
constexpr float C2=0.125f*1.4426950408889634f;
__device__ __forceinline__ void glds16(const void*sbase,unsigned voff,unsigned lds_dst){unsigned keep;
  const unsigned long long sb0=(unsigned long long)sbase; const unsigned long long sb=((unsigned long long)(unsigned)__builtin_amdgcn_readfirstlane((unsigned)(sb0>>32))<<32)|(unsigned)__builtin_amdgcn_readfirstlane((unsigned)sb0);
  asm volatile("s_mov_b32 %0, m0\n\ts_mov_b32 m0, %3\n\ts_nop 0\n\tglobal_load_lds_dwordx4 %1, %2\n\ts_mov_b32 m0, %0":"=&s"(keep):"v"(voff),"s"(sb),"s"(lds_dst):"memory");}
__device__ __forceinline__ float max3f(float a,float b,float c){float r;asm("v_max3_f32 %0, %1, %2, %3":"=v"(r):"v"(a),"v"(b),"v"(c));return r;}
__device__ __forceinline__ float max2f(float a,float b){float r;asm("v_max_f32_e32 %0, %1, %2":"=v"(r):"v"(a),"v"(b));return r;}
__device__ __forceinline__ float fadd_s(float a,float b){float r;asm("v_add_f32_e32 %0, %1, %2":"=v"(r):"v"(a),"v"(b));return r;}
__device__ __forceinline__ float fsub_s(float a,float b){float r;asm("v_sub_f32_e32 %0, %1, %2":"=v"(r):"v"(a),"v"(b));return r;}
typedef float f32x2_t __attribute__((ext_vector_type(2))); typedef float f32x4_t __attribute__((ext_vector_type(4))); typedef __bf16 bf16x2_t __attribute__((ext_vector_type(2)));
__device__ __forceinline__ unsigned cvtpk_s(float lo,float hi){f32x2_t v={lo,hi};bf16x2_t b=__builtin_convertvector(v,bf16x2_t);return __builtin_bit_cast(unsigned,b);}
#define WAIT_BAR(N) asm volatile("s_waitcnt vmcnt(" #N ") lgkmcnt(0)\n\ts_barrier":::"memory")

__device__ __forceinline__ void qkt(f32x16&p0,f32x16&p1,const char*Kslot,const bf16x8*qr,const f32x16&negm,int r32,int hi){
  const char*kb=Kslot+hi*1024+r32*16;
  #pragma unroll
  for(int d0=0;d0<4;++d0){
    const bf16x8 b0=*reinterpret_cast<const bf16x8*>(kb+d0*2048);
    const bf16x8 b1=*reinterpret_cast<const bf16x8*>(kb+d0*2048+512);
    if(d0==0){p0=__builtin_amdgcn_mfma_f32_32x32x16_bf16(b0,qr[0],negm,0,0,0);p1=__builtin_amdgcn_mfma_f32_32x32x16_bf16(b1,qr[0],negm,0,0,0);}
    else{p0=__builtin_amdgcn_mfma_f32_32x32x16_bf16(b0,qr[d0],p0,0,0,0);p1=__builtin_amdgcn_mfma_f32_32x32x16_bf16(b1,qr[d0],p1,0,0,0);}}
}
typedef __attribute__((address_space(3))) const char* lds_cptr;
typedef short v4i16_t __attribute__((ext_vector_type(4)));
__device__ __forceinline__ void kload8(bf16x8*kf,lds_cptr kp){
  kf[0]=*(const __attribute__((address_space(3))) bf16x8*)(kp);      kf[1]=*(const __attribute__((address_space(3))) bf16x8*)(kp+512);
  kf[2]=*(const __attribute__((address_space(3))) bf16x8*)(kp+2048); kf[3]=*(const __attribute__((address_space(3))) bf16x8*)(kp+2560);
  kf[4]=*(const __attribute__((address_space(3))) bf16x8*)(kp+4096); kf[5]=*(const __attribute__((address_space(3))) bf16x8*)(kp+4608);
  kf[6]=*(const __attribute__((address_space(3))) bf16x8*)(kp+6144); kf[7]=*(const __attribute__((address_space(3))) bf16x8*)(kp+6656);
}
__device__ __forceinline__ void kload2(bf16x8*kf,lds_cptr kp,int j){ kf[2*j]=*(const __attribute__((address_space(3))) bf16x8*)(kp+j*2048); kf[2*j+1]=*(const __attribute__((address_space(3))) bf16x8*)(kp+j*2048+512); }
__device__ __forceinline__ s16x4 vtr(lds_cptr p){ return __builtin_bit_cast(s16x4,__builtin_amdgcn_ds_read_tr16_b64_v4i16((__attribute__((address_space(3))) v4i16_t*)p)); }
__device__ __forceinline__ float rowmax(const f32x16&p0,const f32x16&p1){
  float a=max3f(p0[0],p0[1],p1[0]),b=max3f(p0[2],p0[3],p1[1]);a=max3f(a,p1[2],p1[3]);
  #pragma unroll
  for(int r=4;r<16;r+=4){a=max3f(a,p0[r],p0[r+1]);b=max3f(b,p0[r+2],p0[r+3]);a=max3f(a,p1[r],p1[r+1]);b=max3f(b,p1[r+2],p1[r+3]);}
  const float m=max2f(a,b);
  auto rr=__builtin_amdgcn_permlane32_swap(__float_as_uint(m),__float_as_uint(m),false,false);
  return max2f(__uint_as_float(rr[0]),__uint_as_float(rr[1]));
}
__device__ __forceinline__ void pv(f32x16*o,int vb,bf16x8 pa0,bf16x8 pa1,bf16x8 pa2,bf16x8 pa3){
  #pragma unroll
  for(int d0=0;d0<2;++d0){s16x4 lo[4],hi[4];
    #pragma unroll
    for(int ks=0;ks<4;++ks){
      asm volatile("ds_read_b64_tr_b16 %0,%1 offset:%c2":"=&v"(lo[ks]):"v"(vb),"i"(d0*4096+ks*1024):"memory");
      asm volatile("ds_read_b64_tr_b16 %0,%1 offset:%c2":"=&v"(hi[ks]):"v"(vb),"i"(d0*4096+ks*1024+512):"memory");}
    asm volatile("s_waitcnt lgkmcnt(0)":::"memory");SBAR();
    #define PK(k) (bf16x8){lo[k][0],lo[k][1],lo[k][2],lo[k][3],hi[k][0],hi[k][1],hi[k][2],hi[k][3]}
    o[d0]=__builtin_amdgcn_mfma_f32_32x32x16_bf16(pa0,PK(0),o[d0],0,0,0);
    o[d0]=__builtin_amdgcn_mfma_f32_32x32x16_bf16(pa1,PK(1),o[d0],0,0,0);
    o[d0]=__builtin_amdgcn_mfma_f32_32x32x16_bf16(pa2,PK(2),o[d0],0,0,0);
    o[d0]=__builtin_amdgcn_mfma_f32_32x32x16_bf16(pa3,PK(3),o[d0],0,0,0);
    #undef PK
  }
}

#ifndef ATTN_STORE16
#define ATTN_STORE16(p,v) (*(u32x4*)(p)=(v))
#endif
template<int MODE,int THRL> __device__ __forceinline__ void attn_unit(int qb,const bf16*Qu,const bf16*__restrict__ Kh,const bf16*__restrict__ Vh,bf16*Ou,const float*__restrict__ gq,const bf16*__restrict__ kmean,char*shm){
  int tid_=threadIdx.x; asm volatile("":"+v"(tid_));   const int tid=tid_,lane=tid&63,r32=lane&31,hi=lane>>5; const int wid=__builtin_amdgcn_readfirstlane(tid>>6);
  const bf16*Qw=Qu+(long)(wid*QBLK)*QP;
  const unsigned lds0=(unsigned)(uintptr_t)shm;
  float*wsf=(float*)(shm+LDS_WS)+wid*64;
  const int NT=(MODE==1)?4*(qb+1):4;
  const unsigned kvoff=(unsigned)(lane*KVP+wid*8)*2u;
  const unsigned vvoff=(unsigned)((16*(wid&3)+(lane>>2))*KVP+(wid>>2)*32+(lane&3)*8)*2u;
  const unsigned kdst=lds0+LDS_K+wid*1024, vdst=lds0+LDS_V+wid*1024;
  #define TMAP(t) ((MODE==1)?(((t)<4)?(NT-4+(t)):((t)-4)):(t))
  #define DMA_K(t,slot) glds16(Kh+(long)TMAP(t)*KVBLK*KVP,kvoff,(unsigned)__builtin_amdgcn_readfirstlane(kdst+(slot)))
  #define DMA_V(t,slot) glds16(Vh+(long)TMAP(t)*KVBLK*KVP,vvoff,(unsigned)__builtin_amdgcn_readfirstlane(vdst+(slot)))
  const int vb0=(int)(lds0+LDS_V)+((lane>>4)&1)*32+(lane&3)*8+(4*hi+((lane&15)>>2))*64;
  const char*Kbase=shm+LDS_K; bf16x8 kf[8];
  const lds_cptr shm3=(lds_cptr)shm; const lds_cptr kp0=shm3+LDS_K+hi*1024+r32*16; const lds_cptr vp0=shm3+LDS_V+((lane>>4)&1)*32+(lane&3)*8+(4*hi+((lane&15)>>2))*64;
  DMA_K(0,0);DMA_V(0,0);DMA_K(1,SLOTB);
  bf16x8 qr[4]; unsigned sel=0u;
  { bf16x8 qraw[4]; f32x4_t gg[8]; bf16x8 kmf[4];
    #pragma unroll
    for(int d0=0;d0<4;++d0)qraw[d0]=*reinterpret_cast<const bf16x8*>(&Qw[(long)r32*QP+d0*16+hi*8]);
    #pragma unroll
    for(int d0=0;d0<4;++d0){gg[2*d0]=*reinterpret_cast<const f32x4_t*>(gq+d0*16+hi*8);gg[2*d0+1]=*reinterpret_cast<const f32x4_t*>(gq+d0*16+hi*8+4);}
    if(MODE==1){
      #pragma unroll
      for(int d0=0;d0<4;++d0){ kmf[d0]=bf16x8{}; if(r32<16)kmf[d0]=*reinterpret_cast<const bf16x8*>(kmean+(long)r32*KVP+d0*16+hi*8); } }
    float qf[32]; float ss=0.f;
    #pragma unroll
    for(int d0=0;d0<4;++d0){
      #pragma unroll
      for(int e=0;e<8;++e){const float v=__uint_as_float(((unsigned)(unsigned short)qraw[d0][e])<<16); qf[d0*8+e]=v; ss+=v*v;} }
    ss+=__shfl_xor(ss,32);
    const float rs=__builtin_amdgcn_rsqf(ss*(1.0f/64.0f)+1e-6f)*C2;
    #pragma unroll
    for(int d0=0;d0<4;++d0){ u32x4 w;
      w[0]=cvtpk_s(qf[d0*8+0]*rs*gg[2*d0][0],qf[d0*8+1]*rs*gg[2*d0][1]); w[1]=cvtpk_s(qf[d0*8+2]*rs*gg[2*d0][2],qf[d0*8+3]*rs*gg[2*d0][3]);
      w[2]=cvtpk_s(qf[d0*8+4]*rs*gg[2*d0+1][0],qf[d0*8+5]*rs*gg[2*d0+1][1]); w[3]=cvtpk_s(qf[d0*8+6]*rs*gg[2*d0+1][2],qf[d0*8+7]*rs*gg[2*d0+1][3]);
      qr[d0]=__builtin_bit_cast(bf16x8,w); }
    if(MODE==1){ if(qb>0){
      f32x16 ga=f32x16{};
      #pragma unroll
      for(int d0=0;d0<4;++d0)ga=__builtin_amdgcn_mfma_f32_32x32x16_bf16(kmf[d0],qr[d0],ga,0,0,0);
      float gv[8];
      #pragma unroll
      for(int r=0;r<8;++r){const int bi=crow(r,hi); gv[r]=(bi<qb)?ga[r]:-INFINITY;}
      #pragma unroll
      for(int k=0;k<3;++k){
        float best=gv[0]; int bidx=0;
        #pragma unroll
        for(int r=1;r<8;++r){ if(gv[r]>best){best=gv[r];bidx=r;} }
        const int bblk=crow(bidx,hi);
        const float obest=__shfl_xor(best,32); const int oblk=__shfl_xor(bblk,32);
        const bool mine=(best>obest)||(best==obest&&bblk<oblk);
        const float wbest=mine?best:obest; const int wblk=mine?bblk:oblk;
        if(wbest>-INFINITY)sel|=(1u<<wblk);
        #pragma unroll
        for(int r=0;r<8;++r)gv[r]=(mine&&bidx==r)?-INFINITY:gv[r];
      } } }
  }
  float mhat=0.f,l_reg=0.f;f32x16 o[2];o[0]=f32x16{};o[1]=f32x16{};f32x16 negm=f32x16{};asm volatile("":"+v"(negm));
  const int qrel=wid*QBLK+r32;
  #define CMASK(P0,P1,t) do{ if(MODE==1){ const int jb_=(t); if(jb_<4)cmask(P0,P1,jb_,qrel,hi); } }while(0)
  bool resc=false;
  #define START(P0,P1) do{ const float rm=rowmax(P0,P1); resc=false; \
    { const float dl=rm; mhat=fadd_s(mhat,dl); \
      _Pragma("unroll") for(int r=0;r<16;++r){P0[r]=fsub_s(P0[r],dl);P1[r]=fsub_s(P1[r],dl);} \
      _Pragma("unroll") for(int r=0;r<16;++r)negm[r]=-mhat; asm volatile("":"+v"(negm)); } \
    _Pragma("unroll") for(int r=0;r<16;++r)P0[r]=__builtin_amdgcn_exp2f(P0[r]); }while(0)
  #define RESC() do{ if(resc){ asm volatile("s_waitcnt lgkmcnt(0)":::"memory"); \
      _Pragma("unroll") for(int d_=0;d_<2;++d_) _Pragma("unroll") for(int r=0;r<16;++r)o[d_][r]*=wsf[crow(r,hi)]; } }while(0)
  f32x16 pA0,pA1,pB0,pB1;
  int sl_prev=0,sl_cur=0,sl_next=SLOTB;
  #define ROT() do{sl_prev=sl_cur;sl_cur=sl_next;sl_next=(sl_next==(NSLOT-1)*SLOTB)?0:sl_next+SLOTB;}while(0)
  DMA_K(2,2*SLOTB);
  WAIT_BAR(3);
  qkt(pA0,pA1,Kbase,qr,negm,r32,hi);asm volatile("s_nop 15\n\ts_nop 7":"+v"(pA0),"+v"(pA1));CMASK(pA0,pA1,0);
  START(pA0,pA1);
  _Pragma("unroll") for(int r=0;r<16;++r)pA1[r]=__builtin_amdgcn_exp2f(pA1[r]);
  WAIT_BAR(0);
  DMA_K(3,0);DMA_V(1,SLOTB);
  ROT();
  kload8(kf,kp0+sl_cur);
  WAIT_BAR(2);
  s16x4 vlo[8],vhi[8]; u32x4 pw0,pw1,pw2,pw3;
  #define PKW(P,B) cvtpk_s(P[B],P[B+1])
  #define PAF(k) __builtin_bit_cast(bf16x8,pw##k)
  #define VFR(i) (bf16x8){vlo[i][0],vlo[i][1],vlo[i][2],vlo[i][3],vhi[i][0],vhi[i][1],vhi[i][2],vhi[i][3]}
  #define PIN(x) asm volatile("":"+v"(x))
  #define MX3(a,b,c) __builtin_fmaxf(__builtin_fmaxf((a),(b)),(c))
  #define GAPA(MF,A0,A1,A2,A3,W0,W1,PW) do{ MF; sacc+=A0; sacc+=A1; sacc+=A2; sacc+=A3; PIN(sacc); W0; W1; PIN(PW); SBAR(); }while(0)
  #define EX(v) __builtin_amdgcn_exp2f(v)
  #define GAPB(MF,X,B) do{ MF; X[B]=EX(X[B]); X[B+1]=EX(X[B+1]); X[B+2]=EX(X[B+2]); X[B+3]=EX(X[B+3]); PIN(X); SBAR(); }while(0)
  #define VRD(i) do{ vlo[i]=vtr(vp_+(((i)>>2)*4096+((i)&3)*1024)); vhi[i]=vtr(vp_+(((i)>>2)*4096+((i)&3)*1024+512)); }while(0)
  #define KRD(G,j) do{ if(G){ kload2(kf,kp0+sl_next,j); SBAR(); } }while(0)
  #define STEP(C0,C1,P0,P1,t,GK,GV,GL) do{ SBAR(); \
    const lds_cptr vp_=vp0+sl_prev; \
    VRD(0); SBAR(); float sacc=(P0[0]+P0[1]); \
    GAPA(C0=__builtin_amdgcn_mfma_f32_32x32x16_bf16(kf[0],qr[0],negm,0,0,0), P0[2],P0[3],P0[4],P0[5],     pw0[0]=PKW(P0,0), pw0[1]=PKW(P0,2), pw0); \
    VRD(4); SBAR(); GAPA(C1=__builtin_amdgcn_mfma_f32_32x32x16_bf16(kf[1],qr[0],negm,0,0,0), P0[6],P0[7],P0[8],P0[9],     pw0[2]=PKW(P0,4), pw0[3]=PKW(P0,6), pw0); \
    VRD(1); SBAR(); GAPA(C0=__builtin_amdgcn_mfma_f32_32x32x16_bf16(kf[2],qr[1],C0,0,0,0),   P0[10],P0[11],P0[12],P0[13], pw1[0]=PKW(P0,8), pw1[1]=PKW(P0,10), pw1); \
    VRD(5); SBAR(); GAPA(C1=__builtin_amdgcn_mfma_f32_32x32x16_bf16(kf[3],qr[1],C1,0,0,0),   P0[14],P0[15],P1[0],P1[1],   pw1[2]=PKW(P0,12),pw1[3]=PKW(P0,14), pw1); \
    VRD(2); SBAR(); GAPA(C0=__builtin_amdgcn_mfma_f32_32x32x16_bf16(kf[4],qr[2],C0,0,0,0),   P1[2],P1[3],P1[4],P1[5],     pw2[0]=PKW(P1,0), pw2[1]=PKW(P1,2), pw2); \
    VRD(6); SBAR(); GAPA(C1=__builtin_amdgcn_mfma_f32_32x32x16_bf16(kf[5],qr[2],C1,0,0,0),   P1[6],P1[7],P1[8],P1[9],     pw2[2]=PKW(P1,4), pw2[3]=PKW(P1,6), pw2); \
    VRD(3); SBAR(); GAPA(C0=__builtin_amdgcn_mfma_f32_32x32x16_bf16(kf[6],qr[3],C0,0,0,0),   P1[10],P1[11],P1[12],P1[13], pw3[0]=PKW(P1,8), pw3[1]=PKW(P1,10), pw3); \
    VRD(7); SBAR(); GAPA(C1=__builtin_amdgcn_mfma_f32_32x32x16_bf16(kf[7],qr[3],C1,0,0,0),   P1[14],P1[15],0.f,0.f,       pw3[2]=PKW(P1,12),pw3[3]=PKW(P1,14), pw3); \
    l_reg+=sacc; \
    if(GK){DMA_K((t)+3,sl_cur);} if(GV){DMA_V((t)+1,sl_next);} \
    CMASK(C0,C1,t); \
    { float a=MX3(C0[0],C0[1],C1[0]),b=MX3(C0[2],C0[3],C1[1]); a=MX3(a,C1[2],C1[3]); \
      _Pragma("unroll") for(int r=4;r<16;r+=4){a=MX3(a,C0[r],C0[r+1]);b=MX3(b,C0[r+2],C0[r+3]);a=MX3(a,C1[r],C1[r+1]);b=MX3(b,C1[r+2],C1[r+3]);} \
      float rm=__builtin_fmaxf(a,b); { auto rr=__builtin_amdgcn_permlane32_swap(__float_as_uint(rm),__float_as_uint(rm),false,false); rm=__builtin_fmaxf(__uint_as_float(rr[0]),__uint_as_float(rr[1])); } \
      resc=false; \
      if(__builtin_expect(__any(rm>(float)THRL),0)){ const float dl=__builtin_fmaxf(rm,0.f); mhat+=dl; \
        _Pragma("unroll") for(int r=0;r<16;++r){C0[r]-=dl;C1[r]-=dl;} \
        { const bool ro_=(MODE!=1)||((t)<4)||(((sel>>(((t)-4)>>2))&1u)!=0u); const float nm_=ro_?-mhat:NEGB; _Pragma("unroll") for(int r=0;r<16;++r)negm[r]=nm_; } asm volatile("":"+v"(negm)); \
        const float f=__builtin_amdgcn_exp2f(-dl); l_reg*=f; if(hi==0)wsf[r32]=f; resc=true; } } \
    SBAR(); \
    GAPB(o[0]=__builtin_amdgcn_mfma_f32_32x32x16_bf16(PAF(0),VFR(0),o[0],0,0,0), C0,0); \
    GAPB(o[1]=__builtin_amdgcn_mfma_f32_32x32x16_bf16(PAF(0),VFR(4),o[1],0,0,0), C0,4); \
    KRD(GL,0); GAPB(o[0]=__builtin_amdgcn_mfma_f32_32x32x16_bf16(PAF(1),VFR(1),o[0],0,0,0), C0,8); \
    KRD(GL,1); GAPB(o[1]=__builtin_amdgcn_mfma_f32_32x32x16_bf16(PAF(1),VFR(5),o[1],0,0,0), C0,12); \
    KRD(GL,2); GAPB(o[0]=__builtin_amdgcn_mfma_f32_32x32x16_bf16(PAF(2),VFR(2),o[0],0,0,0), C1,0); \
    KRD(GL,3); GAPB(o[1]=__builtin_amdgcn_mfma_f32_32x32x16_bf16(PAF(2),VFR(6),o[1],0,0,0), C1,4); \
    GAPB(o[0]=__builtin_amdgcn_mfma_f32_32x32x16_bf16(PAF(3),VFR(3),o[0],0,0,0), C1,8); \
    GAPB(o[1]=__builtin_amdgcn_mfma_f32_32x32x16_bf16(PAF(3),VFR(7),o[1],0,0,0), C1,12); \
    }while(0)
  int t=1;
  #define PRE(tt) do{ if(MODE==1){ const int t_=(tt); if(t_>=4&&(t_&3)==0){ const bool ro_=((sel>>((t_-4)>>2))&1u)!=0u; const float nm_=ro_?-mhat:NEGB; _Pragma("unroll") for(int r=0;r<16;++r)negm[r]=nm_; asm volatile("":"+v"(negm)); } } }while(0)
  #define ENDW(tt) do{ if((tt)+3<NT){WAIT_BAR(2);} else if((tt)+2<NT){WAIT_BAR(1);} else {WAIT_BAR(0);} }while(0)
  for(;t+1<NT;t+=2){
    PRE(t);   STEP(pB0,pB1,pA0,pA1,t,(t+3<NT),(t+1<NT),(t+1<NT));       ENDW(t);   RESC(); ROT();
    PRE(t+1); STEP(pA0,pA1,pB0,pB1,t+1,(t+4<NT),(t+2<NT),(t+2<NT));     ENDW(t+1); RESC(); ROT();
  }
  PRE(NT-1); STEP(pB0,pB1,pA0,pA1,NT-1,false,false,false); RESC();
  { float sacc=pB0[0]+pB0[1]; _Pragma("unroll") for(int r=2;r<16;++r)sacc+=pB0[r]; _Pragma("unroll") for(int r=0;r<16;++r)sacc+=pB1[r]; l_reg+=sacc;
    pw0=(u32x4){PKW(pB0,0),PKW(pB0,2),PKW(pB0,4),PKW(pB0,6)};pw1=(u32x4){PKW(pB0,8),PKW(pB0,10),PKW(pB0,12),PKW(pB0,14)};pw2=(u32x4){PKW(pB1,0),PKW(pB1,2),PKW(pB1,4),PKW(pB1,6)};pw3=(u32x4){PKW(pB1,8),PKW(pB1,10),PKW(pB1,12),PKW(pB1,14)};
    SBAR(); pv(o,vb0+sl_cur,PAF(0),PAF(1),PAF(2),PAF(3)); }
  #undef PKW
  #undef PAF
  #undef VFR
  #undef PIN
  #undef MX3
  #undef GAPA
  #undef GAPB
  #undef EX
  #undef VRD
  #undef KRD
  #undef STEP
  #undef ENDW
  {auto rr=__builtin_amdgcn_permlane32_swap(__float_as_uint(l_reg),__float_as_uint(l_reg),false,false);l_reg=__uint_as_float(rr[0])+__uint_as_float(rr[1]);}
  if(hi==0)wsf[32+r32]=l_reg;asm volatile("s_waitcnt lgkmcnt(0)":::"memory");
  float rli[16];
  #pragma unroll
  for(int r=0;r<16;++r)rli[r]=__builtin_amdgcn_rcpf(wsf[32+crow(r,hi)]);
  bf16*Ow=Ou+(long)(wid*QBLK)*OP;
  { bf16*stg=(bf16*)(shm+LDS_OST)+wid*2048;
    #pragma unroll
    for(int r=0;r<16;++r){const int orow=crow(r,hi);
      #pragma unroll
      for(int d0=0;d0<2;++d0)stg[orow*64+d0*32+r32]=(bf16)cvtpk_s(o[d0][r]*rli[r],0.f);}
    asm volatile("s_waitcnt lgkmcnt(0)":::"memory");
    #pragma unroll
    for(int i=0;i<4;++i){const int row=i*8+(lane>>3),ch=lane&7; const u32x4 v=*(const u32x4*)(stg+row*64+ch*8); ATTN_STORE16(Ow+(long)row*OP+ch*8,v);} }
  asm volatile("s_waitcnt lgkmcnt(0)\n\ts_barrier":::"memory");
  #undef DMA_K
  #undef TMAP
  #undef PRE
  #undef DMA_V
  #undef CMASK
  #undef START
  #undef RESC
  #undef ROT
}
constexpr int ATTN_LDS_BYTES=LDS_BYTES;
#undef SBAR
#undef WAIT_BAR
}
constexpr int NWAVES = 8;
constexpr int DM = 1024, NBATCH = 4, SEQ = 4096, MP = NBATCH * SEQ, NS = 128, MT = MP + NS, MROWS = 16640, NPT = MROWS / 256, NPP = MP / 256, MEMR = 1024, AROWS = MROWS + MEMR;
constexpr int MIXW = 768, NG = 48, NST = 64, DFF = 2816, NKVH = 4, NQH = 12;
constexpr float EPS = 1e-6f;
constexpr float C2 = 0.125f * 1.4426950408889634f;
constexpr size_t OFF_Y = 0, OFF_PSR = 16908288, OFF_PSI = 16932864, OFF_PK = 16957440, OFF_PV = 21151744, OFF_PMK = 25346048, OFF_PMV = 26394624,
                 OFF_SSR = 27443200, OFF_SSI = 28229632, OFF_SK = 29016064, OFF_SV = 29048832, OUT_TOTAL = 29081600;
constexpr size_t MiB = 1u << 20;
constexpr size_t WS_CTL = 0, CTL_ZERO_BYTES = 1 * MiB;
constexpr size_t WS_WCAT0 = 2 * MiB, WS_WCAT1 = 8 * MiB, WS_WCAT2 = 10 * MiB, WS_WCAT3 = 13 * MiB;
constexpr size_t WS_WOUT = 15 * MiB;
constexpr size_t WS_WGLU = 23 * MiB, WGLU_STRIDE = 3 * MiB / 2;
constexpr size_t WS_WGU = 26 * MiB, WGU_STRIDE = 11 * MiB;
constexpr size_t WS_WDOWN = 70 * MiB, WDOWN_STRIDE = 11 * MiB / 2;
constexpr size_t WS_HB0 = 92 * MiB;
constexpr size_t WS_SSQ0 = 127 * MiB;
constexpr size_t WS_LAYER = 130 * MiB, LSTRIDE = 226 * MiB;
constexpr size_t LO_PROJ = 0, LO_MIXO = 33 * MiB, LO_HBA = 66 * MiB, LO_HBB = 99 * MiB, LO_FFH = 132 * MiB, LO_SSQA = 222 * MiB, LO_SSQB = 224 * MiB;
constexpr size_t WS_YBUF = 1034 * MiB, YBUF_STRIDE = 25 * MiB;
constexpr size_t WS_KVRAW = 1084 * MiB;
constexpr size_t WS_KBUF = 1117 * MiB, WS_VBUF = 1126 * MiB;
constexpr size_t WS_MEMKB = 1135 * MiB, WS_MEMVB = 1137 * MiB;
constexpr size_t WS_E = 1139 * MiB;
constexpr size_t WS_TAB = 1142 * MiB;
constexpr size_t WS_KMEANP = 1143 * MiB;
constexpr size_t WS_KMEANS = 1144 * MiB;
constexpr size_t WS_KMRAW = 1146 * MiB;
constexpr size_t WS_END = 1150 * MiB;
static_assert(WS_WCAT0 + 3072 * 2048 <= WS_WCAT1 && WS_WCAT2 + 1536 * 2048 <= WS_WCAT3 && WS_WGU + 4 * WGU_STRIDE <= WS_WDOWN && WS_WDOWN + 4 * WDOWN_STRIDE <= WS_HB0, "ws map (weights)");
static_assert(WS_HB0 + (size_t)AROWS * 2048 <= WS_SSQ0 && WS_SSQ0 + (size_t)AROWS * 64 <= WS_LAYER && WS_LAYER + 4 * LSTRIDE <= WS_YBUF && WS_YBUF + 2 * YBUF_STRIDE <= WS_KVRAW, "ws map (1)");
static_assert((size_t)MROWS * 2048 <= 33 * MiB && LO_FFH + (size_t)MROWS * 5632 <= LO_SSQA && LO_SSQA + (size_t)MROWS * 64 <= LO_SSQB && LO_SSQB + (size_t)MROWS * 64 <= LSTRIDE && (size_t)MROWS * 1536 <= YBUF_STRIDE, "ws map (layer)");
static_assert(WS_KVRAW + (size_t)MROWS * 2048 <= WS_KBUF && WS_KBUF + (size_t)MROWS * 512 <= WS_VBUF && WS_VBUF + (size_t)MROWS * 512 <= WS_MEMKB && WS_KMRAW + 4u * 1024 * 256 * 4 <= WS_END, "ws map (2)");
constexpr int CW_QUEUE = 131072;
#ifndef ND_FIRST
#define ND_FIRST 96
#endif
constexpr int CW_BAR = 4096;
constexpr int RING_BYTES = 131072, LDSCTL_OFF = RING_BYTES, MISC_OFF = LDSCTL_OFF + 320, LDS_BYTES = 147456;

#define GAS __attribute__((address_space(1)))
#define LAS __attribute__((address_space(3)))
typedef unsigned short bf16;
typedef unsigned v4u __attribute__((ext_vector_type(4)));
typedef float f32x4 __attribute__((ext_vector_type(4)));
typedef short bf16x8 __attribute__((ext_vector_type(8)));
typedef GAS unsigned gu32;
typedef GAS unsigned long long gu64;
#define RLX_AGENT __ATOMIC_RELAXED, __HIP_MEMORY_SCOPE_AGENT
#define LDS_WAIT() asm volatile("s_waitcnt lgkmcnt(0)" ::: "memory")
#define VM_WAIT() asm volatile("s_waitcnt vmcnt(0)" ::: "memory")
__device__ __forceinline__ unsigned long long rt() { return __builtin_amdgcn_s_memrealtime(); }
__device__ __forceinline__ unsigned f2bf(float f) { unsigned u = __builtin_bit_cast(unsigned, f); return (u + 0x7fffu + ((u >> 16) & 1u)) >> 16; }
__device__ __forceinline__ unsigned pk2(float lo, float hi) { return f2bf(lo) | (f2bf(hi) << 16); }

#define XB_TMO      128
#define XB_XCNT(j)  (256  + 64 * (j))
#define XB_XSUB(j)  (1280 + 64 * (j))
#define XB_XGEN(j)  (2304 + 64 * (j))
#define XB_TOP      3328
#define XB_TOPGEN   3392
#define XCD_BAR_WORDS 3456
#define XB_SPIN_CAP (1u << 18)

__device__ __forceinline__ unsigned xb_ld(unsigned* p)              { return __hip_atomic_load(p, __ATOMIC_RELAXED, __HIP_MEMORY_SCOPE_AGENT); }
__device__ __forceinline__ unsigned xb_add(unsigned* p, unsigned v) { return __hip_atomic_fetch_add(p, v, __ATOMIC_RELAXED, __HIP_MEMORY_SCOPE_AGENT); }
__device__ __forceinline__ unsigned xb_xcc_id() { return (unsigned)__builtin_amdgcn_s_getreg((3 << 11) | 20) & 0xFu; }
#define XB_SPIN(cond, bar) do { unsigned _sp = 0; while (cond) { __builtin_amdgcn_s_sleep(1); \
    if ((++_sp & 255u) == 0u) { if (xb_ld(&(bar)[XB_TMO])) break; if (_sp > XB_SPIN_CAP) { atomicAdd(&(bar)[XB_TMO], 1u); break; } } } } while (0)

struct XcdBarrier {
    unsigned* bar; unsigned x;
    volatile LAS unsigned* st;
};

__device__ __forceinline__ XcdBarrier xcd_barrier_post(unsigned* bar, volatile LAS unsigned* st) {
    XcdBarrier b; b.bar = bar; b.x = xb_xcc_id(); b.st = st;
    if (threadIdx.x == 0) (void)xb_add(&bar[XB_XCNT(b.x)], 1u);
    return b;
}
__device__ __forceinline__ void xcd_barrier_complete(unsigned* bar, unsigned x, unsigned& nloc, unsigned& nx) {
    const unsigned G = gridDim.x * gridDim.y * gridDim.z;
    unsigned sum, cnt, mine, sp = 0u;
    for (;;) {
        sum = 0u; cnt = 0u; mine = 0u;
#pragma unroll
        for (unsigned j = 0; j < 16; ++j) { const unsigned c = xb_ld(&bar[XB_XCNT(j)]); sum += c; cnt += (c > 0u) ? 1u : 0u; mine = (j == x) ? c : mine; }
        if (sum == G) break;
        __builtin_amdgcn_s_sleep(1);
        if ((++sp & 255u) == 0u) { if (xb_ld(&bar[XB_TMO])) break; if (sp > XB_SPIN_CAP) { atomicAdd(&bar[XB_TMO], 1u); break; } }
    }
    nloc = mine > 0u ? mine : 1u; nx = cnt > 0u ? cnt : 1u;
}

__device__ __forceinline__ void xcd_barrier(const XcdBarrier& b) {
    asm volatile("s_waitcnt vmcnt(0)" ::: "memory");
    __syncthreads();
    if (threadIdx.x == 0) {
        unsigned* bar = b.bar;
        __builtin_amdgcn_s_waitcnt(0);
        unsigned nloc = b.st[0], nx = b.st[1];
        if (nloc == 0u) { xcd_barrier_complete(bar, b.x, nloc, nx); b.st[0] = nloc; b.st[1] = nx; }
        const unsigned old = xb_add(&bar[XB_XSUB(b.x)], 1u);
        const unsigned gen = old / nloc;
        if (old + 1u == (gen + 1u) * nloc) {
            __builtin_amdgcn_fence(__ATOMIC_RELEASE, "agent");
            asm volatile("s_waitcnt vmcnt(0)" ::: "memory");
            const unsigned og = xb_add(&bar[XB_TOP], 1u);
            const unsigned tg = og / nx;
            __builtin_amdgcn_fence(__ATOMIC_ACQUIRE, "agent");
            if (og + 1u == (tg + 1u) * nx) xb_add(&bar[XB_TOPGEN], 1u);
            else XB_SPIN(xb_ld(&bar[XB_TOPGEN]) == tg, bar);
            xb_add(&bar[XB_XGEN(b.x)], 1u);
            asm volatile("s_waitcnt vmcnt(0)" ::: "memory");
        } else {
            __builtin_amdgcn_fence(__ATOMIC_ACQUIRE, "agent");
            XB_SPIN(xb_ld(&bar[XB_XGEN(b.x)]) == gen, bar);
            asm volatile("s_waitcnt vmcnt(0)" ::: "memory");
        }
    }
    __syncthreads();
}

typedef float f32x16 __attribute__((ext_vector_type(16)));
typedef unsigned u32x2 __attribute__((ext_vector_type(2)));
struct Args { const void* in[33]; float* out; unsigned char* ws; int ph_lo, ph_hi, li, pad; };
struct Frame {
    LAS unsigned char* lds; volatile LAS unsigned* MISC; gu32* ctl; const __attribute__((address_space(4))) Args* ap;
    int tid, lane, wave, vcu, G;
    __device__ __forceinline__ int otid() const { int t = threadIdx.x; asm volatile("" : "+v"(t)); return t; }
    __device__ __forceinline__ const __attribute__((address_space(4))) Args* A() const { const __attribute__((address_space(4))) Args* p = ap; asm volatile("" : "+s"(p)); return p; }
    __device__ __forceinline__ unsigned char* wsb() const { return A()->ws; }
    __device__ __forceinline__ float* out() const { return A()->out; }
#define FIN(name, idx, T) __device__ __forceinline__ const T* name() const { return (const T*)A()->in[idx]; }
    FIN(x_prompt, 0, float) FIN(x_sample, 1, float) FIN(mem_prompt, 2, float) FIN(st_re, 3, float) FIN(st_im, 4, float) FIN(cache_k, 5, float) FIN(cache_v, 6, float) FIN(page_table, 7, int) FIN(cache_mem_k, 8, float) FIN(cache_mem_v, 9, float)
    FIN(g_mix, 10, float) FIN(w_in, 11, float) FIN(w_out, 12, float) FIN(g_ffn, 13, float) FIN(w_gu, 14, float) FIN(w_down, 15, float) FIN(ssm_a_re, 16, float) FIN(ssm_a_im, 17, float) FIN(ssm_log_dt, 18, float) FIN(ssm_b_re, 19, float)
    FIN(ssm_b_im, 20, float) FIN(ssm_c_re, 21, float) FIN(ssm_c_im, 22, float) FIN(ssm_d, 23, float) FIN(w_glu, 24, float) FIN(g_q, 25, float) FIN(g_mq, 26, float) FIN(g_mem, 27, float) FIN(w_mem_kv, 28, float) FIN(g_mk, 29, float)
    FIN(g_kv, 30, float) FIN(w_kv, 31, float) FIN(g_k, 32, float)
#undef FIN
#define FWS(name, off, T) __device__ __forceinline__ T* name() const { return (T*)(wsb() + (off)); }
    FWS(hb0, WS_HB0, bf16) FWS(ssq0, WS_SSQ0, float) FWS(kvraw, WS_KVRAW, float) FWS(kbuf, WS_KBUF, bf16) FWS(vbuf, WS_VBUF, bf16)
    FWS(memkb, WS_MEMKB, bf16) FWS(memvb, WS_MEMVB, bf16) FWS(tab, WS_TAB, f32x4) FWS(kmeanp, WS_KMEANP, bf16) FWS(kmeans, WS_KMEANS, float) FWS(kmraw, WS_KMRAW, float)
#define FWL(name, off, T) __device__ __forceinline__ T* name(int l) const { return (T*)(wsb() + WS_LAYER + (size_t)l * LSTRIDE + (off)); }
    FWL(proj, LO_PROJ, bf16) FWL(mixo, LO_MIXO, bf16) FWL(hba, LO_HBA, bf16) FWL(hbb, LO_HBB, bf16) FWL(ffh, LO_FFH, bf16) FWL(ssqa, LO_SSQA, float) FWL(ssqb, LO_SSQB, float)
#undef FWL
    __device__ __forceinline__ bf16* ybuf(int l) const { return (bf16*)(wsb() + WS_YBUF + (size_t)l * YBUF_STRIDE); }
#undef FWS
};
__device__ __forceinline__ bf16* wcat(const Frame& F, int l) { return (bf16*)(F.wsb() + (l == 0 ? WS_WCAT0 : l == 1 ? WS_WCAT1 : l == 2 ? WS_WCAT2 : WS_WCAT3)); }
__device__ __forceinline__ float wave_sum(float v) {
#pragma unroll
    for (int o = 1; o < 64; o <<= 1) v += __shfl_xor(v, o);
    return v;
}
__device__ __forceinline__ float wave_max(float v) {
#pragma unroll
    for (int o = 1; o < 64; o <<= 1) v = fmaxf(v, __shfl_xor(v, o));
    return v;
}
__device__ __forceinline__ float sum16(float v) { v += __shfl_xor(v, 1); v += __shfl_xor(v, 2); v += __shfl_xor(v, 4); v += __shfl_xor(v, 8); return v; }
__device__ __forceinline__ float wave_sum_dpp(float v) {
    v += __builtin_bit_cast(float, __builtin_amdgcn_update_dpp(0, __builtin_bit_cast(int, v), 0x111, 0xf, 0xf, true));
    v += __builtin_bit_cast(float, __builtin_amdgcn_update_dpp(0, __builtin_bit_cast(int, v), 0x112, 0xf, 0xf, true));
    v += __builtin_bit_cast(float, __builtin_amdgcn_update_dpp(0, __builtin_bit_cast(int, v), 0x114, 0xf, 0xf, true));
    v += __builtin_bit_cast(float, __builtin_amdgcn_update_dpp(0, __builtin_bit_cast(int, v), 0x118, 0xf, 0xf, true));
    v += __builtin_bit_cast(float, __builtin_amdgcn_update_dpp(0, __builtin_bit_cast(int, v), 0x142, 0xa, 0xf, false));
    v += __builtin_bit_cast(float, __builtin_amdgcn_update_dpp(0, __builtin_bit_cast(int, v), 0x143, 0xc, 0xf, false));
    return __builtin_bit_cast(float, __builtin_amdgcn_readlane(__builtin_bit_cast(int, v), 63));
}
__device__ __forceinline__ float bflo(unsigned w) { return __builtin_bit_cast(float, w << 16); }
__device__ __forceinline__ float bfhi(unsigned w) { return __builtin_bit_cast(float, w & 0xffff0000u); }
__device__ __forceinline__ unsigned cvtpk(float lo, float hi) { return pg8::cvt_pk_bf16(lo, hi); }
typedef float f32x2q __attribute__((ext_vector_type(2)));
__device__ __forceinline__ f32x2q gelu_tanh2(f32x2q y) {
    const float k0 = -2.0f * 1.4426950408889634f * 0.7978845608028654f, k1 = k0 * 0.044715f;
    const f32x2q t = y * ((y * y) * k1 + k0); f32x2q a; a.x = __builtin_amdgcn_exp2f(t.x); a.y = __builtin_amdgcn_exp2f(t.y); a = a + 1.0f;
    f32x2q s; s.x = __builtin_amdgcn_rcpf(a.x); s.y = __builtin_amdgcn_rcpf(a.y); return y * s;
}
__device__ __forceinline__ float gelu_tanh(float y) {
    const float z = 0.7978845608028654f * (y + 0.044715f * y * y * y);
    return y * __builtin_amdgcn_rcpf(1.0f + __builtin_amdgcn_exp2f(-2.0f * 1.4426950408889634f * z));
}

__device__ __forceinline__ void tr_item(const float* W, int K, int N, const float* gain, bf16* WT, int R0, int k0, int n0, LAS float* scr, int lane) {
    float wv[32];
#pragma unroll
    for (int i = 0; i < 32; ++i) wv[i] = W[(size_t)(k0 + 2 * i + (lane >> 5)) * N + n0 + (lane & 31)];
    if (gain) {
#pragma unroll
        for (int i = 0; i < 32; ++i) wv[i] *= gain[k0 + 2 * i + (lane >> 5)]; }
#pragma unroll
    for (int i = 0; i < 32; ++i) scr[(2 * i + (lane >> 5)) * 33 + (lane & 31)] = wv[i];
    LDS_WAIT(); asm volatile("" ::: "memory");
    const int c = lane & 7;
#pragma unroll
    for (int j = 0; j < 4; ++j) { const int n = (lane >> 3) + 8 * j; const LAS float* s = scr + (8 * c) * 33 + n;
        v4u o; o.x = pk2(s[0 * 33], s[1 * 33]); o.y = pk2(s[2 * 33], s[3 * 33]); o.z = pk2(s[4 * 33], s[5 * 33]); o.w = pk2(s[6 * 33], s[7 * 33]);
        *(GAS v4u*)(WT + (size_t)(R0 + n) * K + k0 + 8 * c) = o; }
    LDS_WAIT(); asm volatile("" ::: "memory");
}
__device__ __forceinline__ double dexp_small(double x) {
    const double k = __builtin_rint(x * 1.4426950408889634); const double r = __builtin_fma(-k, 0.6931471805599453, x) - k * 2.3190468138462996e-17;
    double s = 1.0;
#pragma unroll
    for (int n = 14; n >= 1; --n) s = 1.0 + s * r * (1.0 / n);
    const long long ki = (long long)k; return s * __builtin_bit_cast(double, (ki + 1023) << 52);
}
__device__ __forceinline__ void dsincos(double x, double& sn, double& cs) {
    const double k = __builtin_rint(x * 0.15915494309189535); double r = __builtin_fma(-k, 6.283185307179586, x); r = __builtin_fma(-k, 2.4492935982947064e-16, r);
    const double y = 0.25 * r, y2 = y * y;
    double s = 1.0, c = 1.0;
#pragma unroll
    for (int n = 8; n >= 1; --n) { s = 1.0 - s * y2 * (1.0 / ((2 * n) * (2 * n + 1))); c = 1.0 - c * y2 * (1.0 / ((2 * n - 1) * (2 * n))); }
    s *= y;
    const double s2 = 2.0 * s * c, c2 = 1.0 - 2.0 * s * s;
    sn = 2.0 * s2 * c2; cs = 1.0 - 2.0 * s2 * s2;
}
constexpr int IT_IN = 512, IT_OUT = 512, IT_GU = 2816, IT_DN = 1408, IT_L = IT_IN + IT_OUT + IT_GU + IT_DN, IT_GLU = 288, IT_KV = 256, IT_MKV = 256;
constexpr int IT_TOTAL = 4 * IT_L + 2 * IT_GLU + IT_KV + 4 * IT_MKV;
constexpr int IT_FIRST_LO = 4 * IT_L + 2 * IT_GLU + IT_KV;
__device__ __forceinline__ void convert_items(const Frame& F, int it_lo, int it_hi, int widx, int nw) {
    LAS float* scr = (LAS float*)(F.lds + F.wave * 8448); const int lane = F.otid() & 63;
    for (int it = it_lo + widx; it < it_hi; it += nw) {
        const float* W; const float* gain = nullptr; bf16* WT; int K, N, r, mode = 0;
        if (it < 4 * IT_L) { const int l = it / IT_L; r = it % IT_L;
            if (r < IT_IN) { W = F.w_in() + (size_t)l * 1048576; K = 1024; N = 1024; gain = F.g_mix() + l * 1024; WT = wcat(F, l); }
            else if ((r -= IT_IN) < IT_OUT) { W = F.w_out() + (size_t)l * 1048576; K = 1024; N = 1024; WT = (bf16*)(F.wsb() + WS_WOUT + (size_t)l * 2 * MiB); }
            else if ((r -= IT_OUT) < IT_GU) { W = F.w_gu() + (size_t)l * 1024 * 5632; K = 1024; N = 5632; gain = F.g_ffn() + l * 1024; WT = (bf16*)(F.wsb() + WS_WGU + (size_t)l * WGU_STRIDE); mode = 1; }
            else { r -= IT_GU; W = F.w_down() + (size_t)l * 2816 * 1024; K = 2816; N = 1024; WT = (bf16*)(F.wsb() + WS_WDOWN + (size_t)l * WDOWN_STRIDE); }
        } else { r = it - 4 * IT_L;
            if (r < 2 * IT_GLU) { const int l = r / IT_GLU; r %= IT_GLU; W = F.w_glu() + (size_t)l * 768 * 768; K = 768; N = 768; WT = (bf16*)(F.wsb() + WS_WGLU + (size_t)l * WGLU_STRIDE); }
            else if ((r -= 2 * IT_GLU) < IT_KV) { W = F.w_kv(); K = 1024; N = 512; gain = F.g_kv(); WT = wcat(F, 2) + (size_t)1024 * 1024; }
            else { r -= IT_KV; const int L = r / IT_MKV; r %= IT_MKV; W = F.w_mem_kv() + (size_t)L * 1024 * 512; K = 1024; N = 512; gain = F.g_mem() + L * 1024; WT = wcat(F, 0) + (size_t)(1024 + 512 * L) * 1024; }
        }
        const int nblk = N / 32, kb = r / nblk, nb = r % nblk, k0 = 64 * kb, n0 = 32 * nb;
        int R0 = n0;
        if (mode == 1) { const int j0 = n0 < DFF ? n0 : n0 - DFF; R0 = 256 * (j0 >> 7) + (j0 & 127) + (n0 < DFF ? 0 : 128); }
        tr_item(W, K, N, gain, WT, R0, k0, n0, scr, lane);
    }
}
__device__ __forceinline__ void p0_prologue(Frame& F) {
    const int gw = F.vcu * NWAVES + F.wave, NGW = F.G * NWAVES, lane = F.otid() & 63;
    convert_items(F, 0, IT_TOTAL, gw, NGW);
    for (int m = gw; m < AROWS; m += NGW) {
        const float* src = m < MP ? F.x_prompt() + (size_t)m * DM : m < MT ? F.x_sample() + (size_t)(m - MP) * DM : m < MROWS ? nullptr : F.mem_prompt() + (size_t)(m - MROWS) * DM;
        f32x4 v[4]; float s = 0.f;
#pragma unroll
        for (int j = 0; j < 4; ++j) { v[j] = src ? *((const GAS f32x4*)src + lane + 64 * j) : (f32x4){0.f, 0.f, 0.f, 0.f}; s += (v[j].x * v[j].x + v[j].y * v[j].y) + (v[j].z * v[j].z + v[j].w * v[j].w); }
        s = wave_sum(s);
#pragma unroll
        for (int j = 0; j < 4; ++j) {
            u32x2 w; w.x = pk2(v[j].x, v[j].y); w.y = pk2(v[j].z, v[j].w); *((GAS u32x2*)(F.hb0() + (size_t)m * DM) + lane + 64 * j) = w; }
        if (lane < 16) F.ssq0()[(size_t)m * 16 + lane] = lane == 0 ? s : 0.f;
    }
    for (int e = blockIdx.x * (NWAVES * 64) + F.tid; e < 2 * NG * NST; e += F.G * NWAVES * 64) {
        const int lg = e / NST;
        const double dt = dexp_small((double)F.ssm_log_dt()[lg]);
        const double lre = fmin((double)F.ssm_a_re()[e], -1e-4), lim = (double)F.ssm_a_im()[e];
        const double mag = dexp_small(dt * lre); double sn, cs; dsincos(dt * lim, sn, cs);
        const double are = mag * cs, aim = mag * sn, den = lre * lre + lim * lim, nre = are - 1.0;
        const double fre = (nre * lre + aim * lim) / den, fim = (aim * lre - nre * lim) / den;
        F.tab()[e] = (f32x4){(float)are, (float)aim, (float)fre, (float)fim};
    }
}
__device__ __forceinline__ void sample_kmeans(const Frame& F, int it0, int it1, int sh, int nsh) {
    LAS float* red = (LAS float*)F.lds; const int tid = F.otid(), c4 = tid & 63, rgp = tid >> 6;
    for (int it = it0 + sh; it < it1; it += nsh) { const int s = it >> 3, blk = it & 7;
        const int pg0 = F.page_table()[s * 16 + 2 * blk], pg1 = F.page_table()[s * 16 + 2 * blk + 1];
        const float* p0 = F.cache_k() + ((size_t)pg0 * 128 + rgp) * 256 + 4 * c4; const float* p1 = F.cache_k() + ((size_t)pg1 * 128 + rgp) * 256 + 4 * c4;
        f32x4 va[16], vb[16];
#pragma unroll
        for (int i = 0; i < 16; ++i) { va[i] = *(const f32x4*)(p0 + (size_t)i * 8 * 256); vb[i] = *(const f32x4*)(p1 + (size_t)i * 8 * 256); }
        f32x4 a = (f32x4){0.f, 0.f, 0.f, 0.f};
#pragma unroll
        for (int i = 0; i < 16; ++i) a += va[i] + vb[i];
        __syncthreads();
        *(LAS f32x4*)(red + rgp * 256 + 4 * c4) = a;
        __syncthreads();
        if (tid < 256) { float t = 0.f;
#pragma unroll
            for (int w = 0; w < 8; ++w) t += red[w * 256 + tid];
            F.kmeans()[(size_t)it * 256 + tid] = t * (1.0f / 256.0f); } }
    __syncthreads();
}

__device__ __forceinline__ bf16x8 pack8(const float (&v)[8]) { v4u w; w.x = cvtpk(v[0], v[1]); w.y = cvtpk(v[2], v[3]); w.z = cvtpk(v[4], v[5]); w.w = cvtpk(v[6], v[7]); return __builtin_bit_cast(bf16x8, w); }
constexpr int XS_ROW = 272, XS_CH = 16 * XS_ROW, XS_WAVE = 2 * XS_CH;
template <bool PC>
__device__ __forceinline__ void s5_item(const Frame& F, int l, int b, int g, int cp, LAS unsigned char* xs, LAS float* elds) {
    const int lane = F.otid() & 63, j = lane & 31, hi = lane >> 5, lg = l * NG + g;
    const f32x4 t0 = F.tab()[lg * NST + j], t1 = F.tab()[lg * NST + j + 32];
    bf16x8 Bop[4];
#pragma unroll
    for (int s = 0; s < 2; ++s) { const f32x4 tt = s ? t1 : t0; const int p = j + 32 * s;
        const float* br = F.ssm_b_re() + ((size_t)lg * NST + p) * 16 + 8 * hi; const float* bi = F.ssm_b_im() + ((size_t)lg * NST + p) * 16 + 8 * hi;
        const f32x4 r0 = *(const f32x4*)br, r1 = *(const f32x4*)(br + 4), i0 = *(const f32x4*)bi, i1 = *(const f32x4*)(bi + 4);
        float re[8], im[8];
#pragma unroll
        for (int e = 0; e < 4; ++e) { re[e] = tt[2] * r0[e] - tt[3] * i0[e]; im[e] = tt[2] * i0[e] + tt[3] * r0[e]; re[4 + e] = tt[2] * r1[e] - tt[3] * i1[e]; im[4 + e] = tt[2] * i1[e] + tt[3] * r1[e]; }
        Bop[2 * s] = pack8(re); Bop[2 * s + 1] = pack8(im); }
    const int hh = (j >> 2) & 1, rr0 = (j & 3) + 4 * (j >> 3);
    const bf16* ap = F.proj(l) + ((size_t)(b * SEQ + (cp + 8 * hh) * 256 + rr0)) * DM + 16 * g + 8 * hi;
    const float a0r = t0[0], a0i = t0[1], a1r = t1[0], a1i = t1[1];
    float x0r = 0.f, x0i = 0.f, x1r = 0.f, x1i = 0.f;
    const int c = cp + 8 * hi;
    bf16x8 Cop[4]; f32x4 dsk; const int hq = lane >> 4, tk = lane & 15;
    if (PC) {
        float p0r = a0r, p0i = a0i, p1r = a1r, p1i = a1i;
#pragma unroll
        for (int q = 0; q < 8; ++q) { const float n0r = p0r * p0r - p0i * p0i, n0i = 2.f * p0r * p0i, n1r = p1r * p1r - p1i * p1i, n1i = 2.f * p1r * p1i; p0r = n0r; p0i = n0i; p1r = n1r; p1i = n1i; }
        { typedef float f32x2e __attribute__((ext_vector_type(2))); f32x2e ea[15], eb[15];
          const LAS f32x2e* e = (const LAS f32x2e*)elds;
#pragma unroll
          for (int cc = 0; cc < 15; ++cc) { ea[cc] = (f32x2e){0.f, 0.f}; eb[cc] = (f32x2e){0.f, 0.f}; if (cc < c) { ea[cc] = e[cc * NST + j]; eb[cc] = e[cc * NST + j + 32]; } }
#pragma unroll
          for (int cc = 0; cc < 15; ++cc) { if (cc < c) {
            const float n0r = p0r * x0r - p0i * x0i + ea[cc].x, n0i = p0r * x0i + p0i * x0r + ea[cc].y, n1r = p1r * x1r - p1i * x1i + eb[cc].x, n1i = p1r * x1i + p1i * x1r + eb[cc].y; x0r = n0r; x0i = n0i; x1r = n1r; x1i = n1i; } } }
#pragma unroll
        for (int kk = 0; kk < 4; ++kk) { const f32x4 cr = *(const f32x4*)(F.ssm_c_re() + ((size_t)lg * 16 + tk) * NST + 16 * kk + 4 * hq), ci = *(const f32x4*)(F.ssm_c_im() + ((size_t)lg * 16 + tk) * NST + 16 * kk + 4 * hq);
            const float cv[8] = {cr[0], -ci[0], cr[1], -ci[1], cr[2], -ci[2], cr[3], -ci[3]}; Cop[kk] = pack8(cv); }
        dsk = *(const f32x4*)(F.ssm_d() + (size_t)lg * 16 + 4 * hq);
    }
    constexpr int PD = 3;
    bf16x8 a_q[PD];
#pragma unroll
    for (int d = 0; d < PD; ++d) a_q[d] = *(const bf16x8*)(ap + (size_t)d * 16 * DM);
    const bf16* up0 = F.proj(l) + ((size_t)(b * SEQ + cp * 256 + tk)) * DM + 16 * g + 4 * hq;
    u32x2 u_q[PD][2];
    if (PC) {
#pragma unroll
        for (int d = 0; d < PD; ++d) { u_q[d][0] = *(const u32x2*)(up0 + (size_t)d * 16 * DM); u_q[d][1] = *(const u32x2*)(up0 + (size_t)(8 * 256 + d * 16) * DM); } }
    for (int st = 0; st < 16; ++st) {
        const bf16x8 a = a_q[0]; const int sp = (st + PD < 16) ? st + PD : 15;
#pragma unroll
        for (int d = 0; d + 1 < PD; ++d) a_q[d] = a_q[d + 1];
        a_q[PD - 1] = *(const bf16x8*)(ap + (size_t)sp * 16 * DM);
        u32x2 u_cur[2];
        if (PC) { u_cur[0] = u_q[0][0]; u_cur[1] = u_q[0][1];
#pragma unroll
            for (int d = 0; d + 1 < PD; ++d) { u_q[d][0] = u_q[d + 1][0]; u_q[d][1] = u_q[d + 1][1]; }
            u_q[PD - 1][0] = *(const u32x2*)(up0 + (size_t)sp * 16 * DM); u_q[PD - 1][1] = *(const u32x2*)(up0 + (size_t)(8 * 256 + sp * 16) * DM); }
        const f32x16 z = {};
        const f32x16 br0 = __builtin_amdgcn_mfma_f32_32x32x16_bf16(a, Bop[0], z, 0, 0, 0), bi0 = __builtin_amdgcn_mfma_f32_32x32x16_bf16(a, Bop[1], z, 0, 0, 0);
        const f32x16 br1 = __builtin_amdgcn_mfma_f32_32x32x16_bf16(a, Bop[2], z, 0, 0, 0), bi1 = __builtin_amdgcn_mfma_f32_32x32x16_bf16(a, Bop[3], z, 0, 0, 0);
#pragma unroll
        for (int r = 0; r < 16; ++r) {
            const float n0r = __builtin_fmaf(a0r, x0r, __builtin_fmaf(-a0i, x0i, br0[r])), n0i = __builtin_fmaf(a0r, x0i, __builtin_fmaf(a0i, x0r, bi0[r]));
            const float n1r = __builtin_fmaf(a1r, x1r, __builtin_fmaf(-a1i, x1i, br1[r])), n1i = __builtin_fmaf(a1r, x1i, __builtin_fmaf(a1i, x1r, bi1[r]));
            x0r = n0r; x0i = n0i; x1r = n1r; x1i = n1i;
            if (PC) { LAS unsigned* xr = (LAS unsigned*)(xs + hi * XS_CH + r * XS_ROW); xr[j] = cvtpk(x0r, x0i); xr[j + 32] = cvtpk(x1r, x1i); }
        }
        if (PC) {
#pragma unroll
            for (int h2 = 0; h2 < 2; ++h2) {
                f32x4 ya = (f32x4){0.f, 0.f, 0.f, 0.f};
#pragma unroll
                for (int kk = 0; kk < 4; ++kk) { const bf16x8 xb = *(const LAS bf16x8*)(xs + h2 * XS_CH + tk * XS_ROW + kk * 64 + hq * 16); ya = __builtin_amdgcn_mfma_f32_16x16x32_bf16(Cop[kk], xb, ya, 0, 0, 0); }
                const size_t tok = (size_t)(b * SEQ + (cp + 8 * h2) * 256 + st * 16 + tk);
                const u32x2 uw = u_cur[h2];
                const f32x2q g01 = gelu_tanh2((f32x2q){ya[0] + dsk[0] * bflo(uw.x), ya[1] + dsk[1] * bfhi(uw.x)}), g23 = gelu_tanh2((f32x2q){ya[2] + dsk[2] * bflo(uw.y), ya[3] + dsk[3] * bfhi(uw.y)});
                u32x2 ow; ow.x = cvtpk(g01.x, g01.y); ow.y = cvtpk(g23.x, g23.y); *(u32x2*)(F.ybuf(l) + tok * MIXW + 16 * g + 4 * hq) = ow;
            }
        }
    }
    if (!PC) { LAS float* e = elds + (size_t)c * NST * 2; e[2 * j] = x0r; e[2 * j + 1] = x0i; e[2 * (j + 32)] = x1r; e[2 * (j + 32) + 1] = x1i; }
    else if (c == 15) { const size_t o = ((size_t)(l * NBATCH + b) * NG + g) * NST; F.out()[OFF_PSR + o + j] = x0r; F.out()[OFF_PSI + o + j] = x0i; F.out()[OFF_PSR + o + j + 32] = x1r; F.out()[OFF_PSI + o + j + 32] = x1i; }
}
__device__ __forceinline__ void s5_sample(const Frame& F, int l, int s, int g) {
    const int p = F.otid() & 63, lg = l * NG + g; const size_t row = MP + s;
    const f32x4 tt = F.tab()[lg * NST + p];
    const v4u ua = *(const v4u*)(F.proj(l) + row * DM + 16 * g), ub = *(const v4u*)(F.proj(l) + row * DM + 16 * g + 8);
    const float u[16] = {bflo(ua.x), bfhi(ua.x), bflo(ua.y), bfhi(ua.y), bflo(ua.z), bfhi(ua.z), bflo(ua.w), bfhi(ua.w), bflo(ub.x), bfhi(ub.x), bflo(ub.y), bfhi(ub.y), bflo(ub.z), bfhi(ub.z), bflo(ub.w), bfhi(ub.w)};
    const float* br = F.ssm_b_re() + ((size_t)lg * NST + p) * 16; const float* bi = F.ssm_b_im() + ((size_t)lg * NST + p) * 16;
    float sr = 0.f, si = 0.f;
#pragma unroll
    for (int q = 0; q < 4; ++q) { const f32x4 r4 = *(const f32x4*)(br + 4 * q), i4 = *(const f32x4*)(bi + 4 * q);
#pragma unroll
        for (int e = 0; e < 4; ++e) { sr += r4[e] * u[4 * q + e]; si += i4[e] * u[4 * q + e]; } }
    const float bur = tt[2] * sr - tt[3] * si, bui = tt[2] * si + tt[3] * sr;
    const size_t so = ((size_t)(l * NS + s) * NG + g) * NST + p;
    const float h0r = F.st_re()[so], h0i = F.st_im()[so];
    const float xr = tt[0] * h0r - tt[1] * h0i + bur, xi = tt[0] * h0i + tt[1] * h0r + bui;
    F.out()[OFF_SSR + so] = xr; F.out()[OFF_SSI + so] = xi;
    float my = 0.f;
    { float cr[16], ci[16];
#pragma unroll
      for (int hh = 0; hh < 16; ++hh) { cr[hh] = F.ssm_c_re()[((size_t)lg * 16 + hh) * NST + p]; ci[hh] = F.ssm_c_im()[((size_t)lg * 16 + hh) * NST + p]; }
      const float dsk = p < 16 ? F.ssm_d()[lg * 16 + p] : 0.f;
#pragma unroll
      for (int hh = 0; hh < 16; ++hh) { const float tv = wave_sum_dpp(cr[hh] * xr - ci[hh] * xi); if (p == hh) my = tv + dsk * u[hh]; } }
    if (p < 16) F.ybuf(l)[row * MIXW + 16 * g + p] = (bf16)cvtpk(gelu_tanh(my), 0.f);
}
__device__ __forceinline__ void s5_sample3(const Frame& F, int l, int g, int s0) {
    const int p = F.otid() & 63, lg = l * NG + g;
    const f32x4 tt = F.tab()[lg * NST + p];
    const float* br = F.ssm_b_re() + ((size_t)lg * NST + p) * 16; const float* bi = F.ssm_b_im() + ((size_t)lg * NST + p) * 16;
    f32x4 r4[4], i4[4];
#pragma unroll
    for (int q = 0; q < 4; ++q) { r4[q] = *(const f32x4*)(br + 4 * q); i4[q] = *(const f32x4*)(bi + 4 * q); }
    v4u ua[3], ub[3]; float h0r[3], h0i[3];
#pragma unroll
    for (int k = 0; k < 3; ++k) { const int s = s0 + 42 * k; const size_t row = MP + s, so = ((size_t)(l * NS + s) * NG + g) * NST + p;
        ua[k] = *(const v4u*)(F.proj(l) + row * DM + 16 * g); ub[k] = *(const v4u*)(F.proj(l) + row * DM + 16 * g + 8); h0r[k] = F.st_re()[so]; h0i[k] = F.st_im()[so]; }
    float cr[16], ci[16];
#pragma unroll
    for (int hh = 0; hh < 16; ++hh) { cr[hh] = F.ssm_c_re()[((size_t)lg * 16 + hh) * NST + p]; ci[hh] = F.ssm_c_im()[((size_t)lg * 16 + hh) * NST + p]; }
    const float dsk = p < 16 ? F.ssm_d()[lg * 16 + p] : 0.f;
#pragma unroll
    for (int k = 0; k < 3; ++k) { const int s = s0 + 42 * k; const size_t row = MP + s, so = ((size_t)(l * NS + s) * NG + g) * NST + p;
        const float u[16] = {bflo(ua[k].x), bfhi(ua[k].x), bflo(ua[k].y), bfhi(ua[k].y), bflo(ua[k].z), bfhi(ua[k].z), bflo(ua[k].w), bfhi(ua[k].w), bflo(ub[k].x), bfhi(ub[k].x), bflo(ub[k].y), bfhi(ub[k].y), bflo(ub[k].z), bfhi(ub[k].z), bflo(ub[k].w), bfhi(ub[k].w)};
        float sr = 0.f, si = 0.f;
#pragma unroll
        for (int q = 0; q < 4; ++q)
#pragma unroll
            for (int e = 0; e < 4; ++e) { sr += r4[q][e] * u[4 * q + e]; si += i4[q][e] * u[4 * q + e]; }
        const float bur = tt[2] * sr - tt[3] * si, bui = tt[2] * si + tt[3] * sr;
        const float xr = tt[0] * h0r[k] - tt[1] * h0i[k] + bur, xi = tt[0] * h0i[k] + tt[1] * h0r[k] + bui;
        F.out()[OFF_SSR + so] = xr; F.out()[OFF_SSI + so] = xi;
        float my = 0.f;
#pragma unroll
        for (int hh = 0; hh < 16; ++hh) { const float tv = wave_sum_dpp(cr[hh] * xr - ci[hh] * xi); if (p == hh) my = tv + dsk * u[hh]; }
        if (p < 16) F.ybuf(l)[row * MIXW + 16 * g + p] = (bf16)cvtpk(gelu_tanh(my), 0.f); }
}

__device__ __forceinline__ void memkv_norm(const Frame& F) {
    const int gw = F.vcu * NWAVES + F.wave, NGW = F.G * NWAVES, lane = F.otid() & 63;
    for (int it0 = gw; it0 < 4 * MEMR; it0 += 2 * NGW) {
        f32x4 k[2], v[2], gk[2];
#pragma unroll
        for (int r = 0; r < 2; ++r) { const int it = it0 + r * NGW < 4 * MEMR ? it0 + r * NGW : it0, L = it / MEMR;
            k[r] = *(const f32x4*)(F.kmraw() + (size_t)it * 256 + 4 * lane); v[r] = *(const f32x4*)(F.out() + OFF_PMV + (size_t)it * 256 + 4 * lane); gk[r] = *(const f32x4*)(F.g_mk() + L * 64 + ((4 * lane) & 63)); }
#pragma unroll
        for (int r = 0; r < 2; ++r) { const int it = it0 + r * NGW; if (it < 4 * MEMR) {
            const float ss = sum16((k[r][0] * k[r][0] + k[r][1] * k[r][1]) + (k[r][2] * k[r][2] + k[r][3] * k[r][3])); const float rs = __builtin_amdgcn_rsqf(ss * (1.0f / 64.0f) + EPS);
            const f32x4 kn = k[r] * rs * gk[r]; *(f32x4*)(F.out() + OFF_PMK + (size_t)it * 256 + 4 * lane) = kn;
            u32x2 w; w.x = cvtpk(kn[0], kn[1]); w.y = cvtpk(kn[2], kn[3]); *(u32x2*)(F.memkb() + (size_t)it * 256 + 4 * lane) = w;
            w.x = cvtpk(v[r][0], v[r][1]); w.y = cvtpk(v[r][2], v[r][3]); *(u32x2*)(F.memvb() + (size_t)it * 256 + 4 * lane) = w; } }
    }
}
__device__ __forceinline__ void kv_norm(const Frame& F) {
    LAS float* red = (LAS float*)F.lds; const int lane = F.otid() & 63, wave = F.wave;
    const f32x4 gk = *(const f32x4*)(F.g_k() + ((4 * lane) & 63));
    for (int it2 = F.vcu; it2 < 256; it2 += F.G) {
        const int it = (it2 >> 5) * 8 + (it2 & 7), sub = (it2 >> 3) & 3;
        f32x4 acc = (f32x4){0.f, 0.f, 0.f, 0.f};
#pragma unroll
        for (int bt = 0; bt < 4; ++bt) {
            const size_t r0 = (size_t)it * 256 + wave * 32 + bt * 8; f32x4 k[8], v[8];
#pragma unroll
            for (int i = 0; i < 8; ++i) k[i] = *(const f32x4*)(F.kvraw() + (r0 + i) * 512 + 4 * lane);
            if (bt == sub) {
#pragma unroll
                for (int i = 0; i < 8; ++i) v[i] = *(const f32x4*)(F.kvraw() + (r0 + i) * 512 + 256 + 4 * lane); }
#pragma unroll
            for (int i = 0; i < 8; ++i) { const float ss = sum16((k[i][0] * k[i][0] + k[i][1] * k[i][1]) + (k[i][2] * k[i][2] + k[i][3] * k[i][3])); const float rs = __builtin_amdgcn_rsqf(ss * (1.0f / 64.0f) + EPS);
                k[i] = k[i] * rs * gk; acc += k[i]; }
            if (bt == sub) {
#pragma unroll
                for (int i = 0; i < 8; ++i) { const size_t row = r0 + i;
                    *(f32x4*)(F.out() + OFF_PK + row * 256 + 4 * lane) = k[i]; *(f32x4*)(F.out() + OFF_PV + row * 256 + 4 * lane) = v[i];
                    u32x2 w; w.x = cvtpk(k[i][0], k[i][1]); w.y = cvtpk(k[i][2], k[i][3]); *(u32x2*)(F.kbuf() + row * 256 + 4 * lane) = w;
                    w.x = cvtpk(v[i][0], v[i][1]); w.y = cvtpk(v[i][2], v[i][3]); *(u32x2*)(F.vbuf() + row * 256 + 4 * lane) = w; } }
        }
        *(LAS f32x4*)(red + wave * 256 + 4 * lane) = acc;
        __syncthreads();
        if (sub == 0 && F.tid < 256) { float t = 0.f;
#pragma unroll
            for (int w = 0; w < 8; ++w) t += red[w * 256 + F.tid];
            F.kmeanp()[(size_t)it * 256 + F.tid] = (bf16)cvtpk(t * (1.0f / 256.0f), 0.f); }
        __syncthreads(); }
    for (int r = F.vcu * NWAVES + wave; r < NS; r += F.G * NWAVES) {
        const size_t row = (size_t)MP + r;
        f32x4 k = *(const f32x4*)(F.kvraw() + row * 512 + 4 * lane); const f32x4 v = *(const f32x4*)(F.kvraw() + row * 512 + 256 + 4 * lane);
        const float ss = sum16((k[0] * k[0] + k[1] * k[1]) + (k[2] * k[2] + k[3] * k[3])); const float rs = __builtin_amdgcn_rsqf(ss * (1.0f / 64.0f) + EPS);
        k = k * rs * gk;
        *(f32x4*)(F.out() + OFF_SK + (size_t)r * 256 + 4 * lane) = k; *(f32x4*)(F.out() + OFF_SV + (size_t)r * 256 + 4 * lane) = v;
        u32x2 w; w.x = cvtpk(k[0], k[1]); w.y = cvtpk(k[2], k[3]); *(u32x2*)(F.kbuf() + row * 256 + 4 * lane) = w;
        w.x = cvtpk(v[0], v[1]); w.y = cvtpk(v[2], v[3]); *(u32x2*)(F.vbuf() + row * 256 + 4 * lane) = w; }
}

template <bool MOBA>
__device__ __forceinline__ void decode_item(const Frame& F, int l, int s, int hd) {
    LAS float* sc = (LAS float*)F.lds; LAS float* red = (LAS float*)(F.lds + 4096); LAS float* misc = (LAS float*)(F.lds + 12288); LAS int* segs = (LAS int*)(F.lds + 12288 + 256);
    const int t = F.otid(), rg = t >> 4, lq = t & 15, wave = F.wave;
    const size_t row = MP + s; const int qcol = MOBA ? hd * 64 : MIXW + hd * 64, kvh = MOBA ? hd / 3 : hd;
    const float* gq = MOBA ? F.g_q() + (l - 2) * 64 : F.g_mq() + l * 64;
    const u32x2 qw = *(const u32x2*)(F.proj(l) + row * DM + qcol + 4 * lq);
    float q0 = bflo(qw.x), q1 = bfhi(qw.x), q2 = bflo(qw.y), q3 = bfhi(qw.y);
    { const float ss = sum16((q0 * q0 + q1 * q1) + (q2 * q2 + q3 * q3)); const float rs = __builtin_amdgcn_rsqf(ss * (1.0f / 64.0f) + EPS) * C2; const f32x4 g4 = *(const f32x4*)(gq + 4 * lq);
      q0 *= rs * g4[0]; q1 *= rs * g4[1]; q2 *= rs * g4[2]; q3 *= rs * g4[3]; }
    __syncthreads();
    if (MOBA) {
        if (rg < 8) { const f32x4 km = *(const f32x4*)(F.kmeans() + ((size_t)(s * 8 + rg)) * 256 + kvh * 64 + 4 * lq); const float d = sum16((q0 * km[0] + q1 * km[1]) + (q2 * km[2] + q3 * km[3])); if (lq == 0) misc[rg] = d; }
        __syncthreads();
        if (t == 0) { float g0 = misc[0], g1 = misc[1], g2 = misc[2], g3 = misc[3], g4 = misc[4], g5 = misc[5], g6 = misc[6], g7 = misc[7]; unsigned selm = 0u;
#pragma unroll
            for (int k = 0; k < 3; ++k) { float best = g0; int bi = 0;
                if (g1 > best) { best = g1; bi = 1; } if (g2 > best) { best = g2; bi = 2; } if (g3 > best) { best = g3; bi = 3; } if (g4 > best) { best = g4; bi = 4; } if (g5 > best) { best = g5; bi = 5; } if (g6 > best) { best = g6; bi = 6; } if (g7 > best) { best = g7; bi = 7; }
                selm |= 1u << bi; const float NI = -INFINITY;
                g0 = bi == 0 ? NI : g0; g1 = bi == 1 ? NI : g1; g2 = bi == 2 ? NI : g2; g3 = bi == 3 ? NI : g3; g4 = bi == 4 ? NI : g4; g5 = bi == 5 ? NI : g5; g6 = bi == 6 ? NI : g6; g7 = bi == 7 ? NI : g7; }
            int n = 0;
            for (int jb = 0; jb < 8; ++jb) if ((selm >> jb) & 1u) { segs[n++] = F.page_table()[s * 16 + 2 * jb]; segs[n++] = F.page_table()[s * 16 + 2 * jb + 1]; } }
        __syncthreads();
    }
    constexpr int NSEG = MOBA ? 6 : 2;
#pragma unroll
    for (int sg = 0; sg < NSEG; ++sg) {
        const float* kb = MOBA ? F.cache_k() + (size_t)segs[sg] * 32768 + kvh * 64 : F.cache_mem_k() + ((size_t)((l * NS + s) * 256 + sg * 128)) * 256 + hd * 64;
        f32x4 kv[4];
#pragma unroll
        for (int i = 0; i < 4; ++i) kv[i] = *(const f32x4*)(kb + (size_t)(i * 32 + rg) * 256 + 4 * lq);
#pragma unroll
        for (int i = 0; i < 4; ++i) { const float d = sum16((q0 * kv[i][0] + q1 * kv[i][1]) + (q2 * kv[i][2] + q3 * kv[i][3])); if (lq == 0) sc[sg * 128 + i * 32 + rg] = d; }
    }
    constexpr int NKEY = NSEG * 128 + (MOBA ? 1 : 0);
    if (MOBA && rg == 0) { const f32x4 kn = *(const f32x4*)(F.out() + OFF_SK + (size_t)s * 256 + kvh * 64 + 4 * lq); const float d = sum16((q0 * kn[0] + q1 * kn[1]) + (q2 * kn[2] + q3 * kn[3])); if (lq == 0) sc[NSEG * 128] = d; }
    __syncthreads();
    float m = -INFINITY;
    for (int i = t; i < NKEY; i += NWAVES * 64) m = fmaxf(m, sc[i]);
    m = wave_max(m); if (F.lane == 0) misc[16 + wave] = m;
    __syncthreads();
    m = fmaxf(fmaxf(fmaxf(misc[16], misc[17]), fmaxf(misc[18], misc[19])), fmaxf(fmaxf(misc[20], misc[21]), fmaxf(misc[22], misc[23])));
    float sm = 0.f;
    for (int i = t; i < NKEY; i += NWAVES * 64) { const float p = __builtin_amdgcn_exp2f(sc[i] - m); sc[i] = p; sm += p; }
    sm = wave_sum(sm); if (F.lane == 0) misc[24 + wave] = sm;
    __syncthreads();
    const float tot = ((misc[24] + misc[25]) + (misc[26] + misc[27])) + ((misc[28] + misc[29]) + (misc[30] + misc[31]));
    f32x4 acc = (f32x4){0.f, 0.f, 0.f, 0.f};
#pragma unroll
    for (int sg = 0; sg < NSEG; ++sg) {
        const float* vb = MOBA ? F.cache_v() + (size_t)segs[sg] * 32768 + kvh * 64 : F.cache_mem_v() + ((size_t)((l * NS + s) * 256 + sg * 128)) * 256 + hd * 64;
        f32x4 vv[4];
#pragma unroll
        for (int i = 0; i < 4; ++i) vv[i] = *(const f32x4*)(vb + (size_t)(i * 32 + rg) * 256 + 4 * lq);
#pragma unroll
        for (int i = 0; i < 4; ++i) acc += vv[i] * sc[sg * 128 + i * 32 + rg];
    }
    if (MOBA && rg == 0) { const f32x4 vn = *(const f32x4*)(F.out() + OFF_SV + (size_t)s * 256 + kvh * 64 + 4 * lq); acc += vn * sc[NSEG * 128]; }
    *(LAS f32x4*)(red + rg * 64 + 4 * lq) = acc;
    __syncthreads();
    if (t < 64) { float o = 0.f;
#pragma unroll 8
        for (int r = 0; r < 32; ++r) o += red[r * 64 + t];
        F.mixo(l)[row * DM + qcol + t] = (bf16)cvtpk(o * __builtin_amdgcn_rcpf(tot), 0.f); }
}

template <int NQ>
__device__ __forceinline__ f32x4 skinny_tile(const bf16* __restrict__ A, const bf16* __restrict__ Bt, int K, int row0, int n0, LAS unsigned char* lds, int tid) {
    const int lane = tid & 63, wave = __builtin_amdgcn_readfirstlane(tid >> 6), fr = lane & 15, fq = lane >> 4;
    const int kw = K >> 3, nks = kw >> 5;
    const bf16* ap = A + (size_t)(row0 + fr) * K + wave * kw + 8 * fq;
    const bf16* bp = Bt + (size_t)(n0 + fr) * K + wave * kw + 8 * fq;
    f32x4 acc[4];
#pragma unroll
    for (int c = 0; c < 4; ++c) acc[c] = (f32x4){0.f, 0.f, 0.f, 0.f};
    for (int ks0 = 0; ks0 < nks; ks0 += NQ) {
        bf16x8 a[NQ], b[NQ][4];
#pragma unroll
        for (int q = 0; q < NQ; ++q) { const int ks = (ks0 + q < nks) ? ks0 + q : nks - 1; a[q] = *(const bf16x8*)(ap + ks * 32);
#pragma unroll
            for (int c = 0; c < 4; ++c) b[q][c] = *(const bf16x8*)(bp + (size_t)(16 * c) * K + ks * 32); }
#pragma unroll
        for (int q = 0; q < NQ; ++q) { if (ks0 + q < nks) {
#pragma unroll
            for (int c = 0; c < 4; ++c) acc[c] = __builtin_amdgcn_mfma_f32_16x16x32_bf16(b[q][c], a[q], acc[c], 0, 0, 0); } }
    }
    __syncthreads();
#pragma unroll
    for (int c = 0; c < 4; ++c) *(LAS f32x4*)(lds + wave * 4096 + c * 1024 + lane * 16) = acc[c];
    __syncthreads();
    f32x4 r = (f32x4){0.f, 0.f, 0.f, 0.f};
    if (tid < 256) { const int row = tid >> 4, c4 = tid & 15, L = (c4 & 3) * 16 + row, cg = c4 >> 2;
#pragma unroll
        for (int w = 0; w < 8; ++w) r += *(const LAS f32x4*)(lds + w * 4096 + cg * 1024 + L * 16); }
    return r;
}
__device__ __forceinline__ void skinny_proj(const Frame& F, int l, int tile) {
    const int tid = F.otid(), rg = tile & 7, cs = tile >> 3, row0 = MP + 16 * rg, n0 = 64 * cs;
    const f32x4 v = skinny_tile<4>(l == 0 ? F.hb0() : F.hbb(l - 1), wcat(F, l), DM, row0, n0, F.lds, tid);
    if (tid < 256) { const int row = row0 + (tid >> 4), c4 = tid & 15;
        const float rs = __builtin_amdgcn_rsqf(sum16((l == 0 ? F.ssq0() : F.ssqa(l - 1))[(size_t)row * 16 + c4]) * (1.0f / 1024.0f) + EPS);
        if (n0 < DM) { u32x2 w; w.x = cvtpk(v[0] * rs, v[1] * rs); w.y = cvtpk(v[2] * rs, v[3] * rs); *(u32x2*)(F.proj(l) + (size_t)row * DM + n0 + 4 * c4) = w; }
        else *(f32x4*)(F.kvraw() + (size_t)row * 512 + (n0 - DM) + 4 * c4) = v * rs; }
}
__device__ __forceinline__ void skinny_resid(const Frame& F, const bf16* A, const bf16* Bt, int K, const float* xin, const bf16* hin, bf16* hout, float* ssq_out, bool last, int tile) {
    const int tid = F.otid(), rg = tile & 7, cs = tile >> 3, row0 = MP + 16 * rg, n0 = 64 * cs;
    const f32x4 v = K > 1024 ? skinny_tile<6>(A, Bt, K, row0, n0, F.lds, tid) : skinny_tile<4>(A, Bt, K, row0, n0, F.lds, tid);
    if (tid < 256) { const int row = row0 + (tid >> 4), c4 = tid & 15; const size_t off = (size_t)row * DM + n0 + 4 * c4; f32x4 hn;
        if (xin) hn = *(const f32x4*)(xin + off - (size_t)MP * DM); else { const u32x2 hw = *(const u32x2*)(hin + off); hn = (f32x4){bflo(hw.x), bfhi(hw.x), bflo(hw.y), bfhi(hw.y)}; }
        hn += v;
        if (last) *(f32x4*)(F.out() + OFF_Y + off) = hn;
        u32x2 w; w.x = cvtpk(hn[0], hn[1]); w.y = cvtpk(hn[2], hn[3]); *(u32x2*)(hout + off) = w;
        const float ss = sum16((hn[0] * hn[0] + hn[1] * hn[1]) + (hn[2] * hn[2] + hn[3] * hn[3]));
        if (c4 == 0) ssq_out[(size_t)row * 16 + cs] = ss; }
}

__device__ __forceinline__ float row16_sum_to_lane15(float v) {
    v += __builtin_bit_cast(float, __builtin_amdgcn_update_dpp(0, __builtin_bit_cast(int, v), 0x111, 0xf, 0xf, true));
    v += __builtin_bit_cast(float, __builtin_amdgcn_update_dpp(0, __builtin_bit_cast(int, v), 0x112, 0xf, 0xf, true));
    v += __builtin_bit_cast(float, __builtin_amdgcn_update_dpp(0, __builtin_bit_cast(int, v), 0x114, 0xf, 0xf, true));
    v += __builtin_bit_cast(float, __builtin_amdgcn_update_dpp(0, __builtin_bit_cast(int, v), 0x118, 0xf, 0xf, true));
    return v;
}
template <bool MOBA>
__device__ __forceinline__ void decode_wave(const Frame& F, int l, int s, int hd, LAS unsigned char* wl) {
    LAS float* sc = (LAS float*)wl; LAS float* gate = (LAS float*)(wl + 3200); LAS int* segs = (LAS int*)(wl + 3264);
    const int lane = F.otid() & 63, rg = lane >> 4, lq = lane & 15; const bool wr15 = lq == 15;
    const size_t row = MP + s; const int qcol = MOBA ? hd * 64 : MIXW + hd * 64, kvh = MOBA ? hd / 3 : hd;
    const float* gq = MOBA ? F.g_q() + (l - 2) * 64 : F.g_mq() + l * 64;
    const u32x2 qw = *(const u32x2*)(F.proj(l) + row * DM + qcol + 4 * lq);
    float q0 = bflo(qw.x), q1 = bfhi(qw.x), q2 = bflo(qw.y), q3 = bfhi(qw.y);
    { const float ss = sum16((q0 * q0 + q1 * q1) + (q2 * q2 + q3 * q3)); const float rs = __builtin_amdgcn_rsqf(ss * (1.0f / 64.0f) + EPS) * C2; const f32x4 g4 = *(const f32x4*)(gq + 4 * lq);
      q0 *= rs * g4[0]; q1 *= rs * g4[1]; q2 *= rs * g4[2]; q3 *= rs * g4[3]; }
    constexpr int NSEG = MOBA ? 6 : 2, NKEY = NSEG * 128 + (MOBA ? 1 : 0);
    if (MOBA) {
#pragma unroll
        for (int h2 = 0; h2 < 2; ++h2) { const int blk = rg + 4 * h2; const f32x4 km = *(const f32x4*)(F.kmeans() + ((size_t)(s * 8 + blk)) * 256 + kvh * 64 + 4 * lq);
            const float d = row16_sum_to_lane15((q0 * km[0] + q1 * km[1]) + (q2 * km[2] + q3 * km[3])); if (wr15) gate[blk] = d; }
        float g0 = gate[0], g1 = gate[1], g2 = gate[2], g3 = gate[3], g4 = gate[4], g5 = gate[5], g6 = gate[6], g7 = gate[7]; unsigned selm = 0u;
#pragma unroll
        for (int k = 0; k < 3; ++k) { float best = g0; int bi = 0;
            if (g1 > best) { best = g1; bi = 1; } if (g2 > best) { best = g2; bi = 2; } if (g3 > best) { best = g3; bi = 3; } if (g4 > best) { best = g4; bi = 4; } if (g5 > best) { best = g5; bi = 5; } if (g6 > best) { best = g6; bi = 6; } if (g7 > best) { best = g7; bi = 7; }
            selm |= 1u << bi; const float NI = -INFINITY;
            g0 = bi == 0 ? NI : g0; g1 = bi == 1 ? NI : g1; g2 = bi == 2 ? NI : g2; g3 = bi == 3 ? NI : g3; g4 = bi == 4 ? NI : g4; g5 = bi == 5 ? NI : g5; g6 = bi == 6 ? NI : g6; g7 = bi == 7 ? NI : g7; }
        if (lane == 0) { int n = 0; for (int jb = 0; jb < 8; ++jb) if ((selm >> jb) & 1u) { segs[n++] = F.page_table()[s * 16 + 2 * jb]; segs[n++] = F.page_table()[s * 16 + 2 * jb + 1]; } }
    }
#pragma unroll 1
    for (int sg = 0; sg < NSEG; ++sg) {
        const float* kb = (MOBA ? F.cache_k() + (size_t)segs[sg] * 32768 + kvh * 64 : F.cache_mem_k() + ((size_t)((l * NS + s) * 256 + sg * 128)) * 256 + hd * 64) + (size_t)rg * 256 + 4 * lq;
#pragma unroll
        for (int hb2 = 0; hb2 < 2; ++hb2) { f32x4 kv[16];
#pragma unroll
            for (int i = 0; i < 16; ++i) kv[i] = *(const f32x4*)(kb + (size_t)(hb2 * 64 + 4 * i) * 256);
#pragma unroll
            for (int i = 0; i < 16; ++i) { const float d = row16_sum_to_lane15((q0 * kv[i][0] + q1 * kv[i][1]) + (q2 * kv[i][2] + q3 * kv[i][3])); if (wr15) sc[sg * 128 + hb2 * 64 + 4 * i + rg] = d; } }
    }
    if (MOBA) { const f32x4 kn = *(const f32x4*)(F.out() + OFF_SK + (size_t)s * 256 + kvh * 64 + 4 * lq); const float d = row16_sum_to_lane15((q0 * kn[0] + q1 * kn[1]) + (q2 * kn[2] + q3 * kn[3])); if (lane == 15) sc[NSEG * 128] = d; }
    float m = -INFINITY;
    for (int i = lane; i < NKEY; i += 64) m = fmaxf(m, sc[i]);
    m = wave_max(m);
    float sm = 0.f;
    for (int i = lane; i < NKEY; i += 64) { const float p = __builtin_amdgcn_exp2f(sc[i] - m); sc[i] = p; sm += p; }
    sm = wave_sum(sm);
    f32x4 acc = (f32x4){0.f, 0.f, 0.f, 0.f};
#pragma unroll 1
    for (int sg = 0; sg < NSEG; ++sg) {
        const float* vb = (MOBA ? F.cache_v() + (size_t)segs[sg] * 32768 + kvh * 64 : F.cache_mem_v() + ((size_t)((l * NS + s) * 256 + sg * 128)) * 256 + hd * 64) + (size_t)rg * 256 + 4 * lq;
#pragma unroll
        for (int hb2 = 0; hb2 < 2; ++hb2) { f32x4 vv[16];
#pragma unroll
            for (int i = 0; i < 16; ++i) vv[i] = *(const f32x4*)(vb + (size_t)(hb2 * 64 + 4 * i) * 256);
#pragma unroll
            for (int i = 0; i < 16; ++i) acc += vv[i] * sc[sg * 128 + hb2 * 64 + 4 * i + rg]; }
    }
    if (MOBA && rg == 0) { const f32x4 vn = *(const f32x4*)(F.out() + OFF_SV + (size_t)s * 256 + kvh * 64 + 4 * lq); acc += vn * sc[NSEG * 128]; }
#pragma unroll
    for (int e = 0; e < 4; ++e) { acc[e] += __shfl_xor(acc[e], 16); acc[e] += __shfl_xor(acc[e], 32); }
    if (lane < 16) { const float inv = __builtin_amdgcn_rcpf(sm); u32x2 w; w.x = cvtpk(acc[0] * inv, acc[1] * inv); w.y = cvtpk(acc[2] * inv, acc[3] * inv); *(u32x2*)(F.mixo(l) + row * DM + qcol + 4 * lq) = w; }
}


constexpr int N_PHASES = 29;
__host__ __device__ constexpr bool phase_exists(int p) { if (p == 0) return true; const int l = (p - 1) / 7, k = (p - 1) % 7; if (k == 1) return l == 0 || l == 2; if (k == 3) return l < 2; return true; }

__global__ void __launch_bounds__(NWAVES * 64, 2) fwd(Args args) {
    extern __shared__ __attribute__((aligned(16))) unsigned char lds[];
    Frame F;
    F.lds = (LAS unsigned char*)lds; F.MISC = (volatile LAS unsigned*)(F.lds + MISC_OFF);
    F.tid = threadIdx.x; F.lane = F.tid & 63; F.wave = __builtin_amdgcn_readfirstlane(F.tid >> 6);
    F.G = gridDim.x; { const int bx = blockIdx.x; F.vcu = (F.G % 8 == 0) ? (bx % 8) * (F.G / 8) + bx / 8 : bx; }
    F.ap = (const __attribute__((address_space(4))) Args*)__builtin_amdgcn_kernarg_segment_ptr(); F.ctl = (gu32*)(args.ws + WS_CTL);
    for (int u = F.tid; u < (LDS_BYTES - LDSCTL_OFF) / 4; u += NWAVES * 64) ((LAS unsigned*)(F.lds + LDSCTL_OFF))[u] = 0u;
    __syncthreads();
    XcdBarrier bar = xcd_barrier_post((unsigned*)(F.ctl + CW_BAR) + args.li * XCD_BAR_WORDS, F.MISC + 8);
    const int lo = args.ph_lo, hi = args.ph_hi;
#define IN(p) (lo <= (p) && (p) < hi)
#define SEAM(p) do { if ((p) + 1 < hi) xcd_barrier(bar); } while (0)

    if (IN(0)) {
        if (hi - lo > 1) xcd_barrier(bar);
        p0_prologue(F); SEAM(0); }

    for (int l = 0; l < 4; ++l) {
        const int pb = 1 + 7 * l;
        if (IN(pb)) {
            pg8::Gemm g{l == 0 ? F.hb0() : F.hbb(l - 1), wcat(F, l), AROWS, 0, DM};
            pg8::ListSched S; S.init(NPP, l == 2 ? 6 : 4, NPT, l == 0 ? 4 : 0, 4, 8, F.G, (int)blockIdx.x);
            pg8::EpiProj E{l == 0 ? F.ssq0() : F.ssqa(l - 1), F.proj(l), F.kvraw(), F.kmraw(), F.out() + OFF_PMV, NPT};
            pg8::gemm_phase<pg8::EpiProj, pg8::ListSched, true, true>(F.lds, g, S, E);
            for (int tl = (int)blockIdx.x - 128; tl >= 0 && tl < (l == 2 ? 192 : 128); tl += 128) skinny_proj(F, l, tl);
            if (l == 2 && (int)blockIdx.x >= 128) sample_kmeans(F, 684, NS * 8, (int)blockIdx.x - 128, F.G - 128);
            SEAM(pb);
        }
        if (l < 2) {
            if (l == 0 && IN(pb + 1)) { memkv_norm(F); SEAM(pb + 1); }
            if (IN(pb + 2)) {
                const int skipm = args.pad;
                if (skipm & 4) {} else if (F.vcu < NBATCH * NG) { const int b = F.vcu / NG, g = F.vcu % NG; LAS float* elds = (LAS float*)(F.lds + NWAVES * XS_WAVE);
                    s5_item<false>(F, l, b, g, F.wave, nullptr, elds);
                    __syncthreads();
                    s5_item<true>(F, l, b, g, F.wave, F.lds + F.wave * XS_WAVE, elds);
                } else if (!(skipm & 16)) { const int a = F.vcu - NBATCH * NG, na = F.G - NBATCH * NG;
                    for (int it = a * NWAVES + F.wave; it < NS * 4; it += na * NWAVES) decode_wave<false>(F, l, it >> 2, it & 3, F.lds + F.wave * 4096); }
                if (!(skipm & 8)) { const int gw = F.vcu * NWAVES + F.wave;
                    if (F.G * NWAVES == 2048) {
                        if (gw < 42 * NG) s5_sample3(F, l, gw % NG, gw / NG);
                        else for (int it = gw - 42 * NG; it < 2 * NG; it += 32) s5_sample(F, l, 126 + it / NG, it % NG);
                    } else for (int it = gw; it < NS * NG; it += F.G * NWAVES) s5_sample(F, l, it / NG, it % NG); }
                if (!(skipm & 32)) { gu32* qm = F.ctl + CW_QUEUE + (64 + l + 4 * args.li) * 64; unsigned nxt = 0u;
                  if (F.tid == 0) nxt = __hip_atomic_fetch_add(qm, 1u, RLX_AGENT);
                  for (int itn = 0;; ++itn) {
                      if (F.tid == 0) F.MISC[16 + (itn & 1)] = nxt;
                      __syncthreads();
                      const unsigned u = (unsigned)__builtin_amdgcn_readfirstlane((int)F.MISC[16 + (itn & 1)]);
                      if (u >= 256u) break;
                      if (F.tid == 0) nxt = __hip_atomic_fetch_add(qm, 1u, RLX_AGENT);
                      const int b = u >> 6, mh = (u >> 4) & 3, qb = u & 15; const size_t row0 = (size_t)b * SEQ + qb * 256;
                      attn_body::attn_unit<0, 8>(qb, F.proj(l) + row0 * DM + MIXW + mh * 64, F.memkb() + ((size_t)(l * MEMR + b * 256)) * 256 + mh * 64, F.memvb() + ((size_t)(l * MEMR + b * 256)) * 256 + mh * 64,
                                                 F.mixo(l) + row0 * DM + MIXW + mh * 64, F.g_mq() + l * 64, nullptr, (char*)lds); } }
                SEAM(pb + 2);
            }
            if (IN(pb + 3)) {
                pg8::Gemm g{F.ybuf(l), (const bf16*)(F.wsb() + WS_WGLU + (size_t)l * WGLU_STRIDE), MROWS, MIXW, MIXW};
                pg8::ListSched S; S.init(NPT, 3, 0, 0, 0, 0, F.G, (int)blockIdx.x);
                pg8::EpiGlu E{F.ybuf(l), F.mixo(l)};
                pg8::gemm_phase<pg8::EpiGlu, pg8::ListSched, true, true>(F.lds, g, S, E);
                SEAM(pb + 3);
            }
        } else {
            if (l == 2 && IN(pb + 1)) { kv_norm(F); SEAM(pb + 1); }
            if (IN(pb + 2)) {
                gu32* qa = F.ctl + CW_QUEUE + ((l - 2) + 2 * args.li) * 128; gu32* qd = qa + 64;
                constexpr unsigned NA = NBATCH * NQH * 16 + 256, NDB = (NS * NQH) / 8 + (NS * 4) / 8;
                int curq = (F.vcu < ND_FIRST) ? 1 : 0; bool switched = false; unsigned nxt = 0u;
                if (F.tid == 0) nxt = __hip_atomic_fetch_add(curq ? qd : qa, 1u, RLX_AGENT);
                for (int itn = 0;; ++itn) {
                    if (F.tid == 0) F.MISC[16 + (itn & 1)] = nxt;
                    __syncthreads();
                    const unsigned idx = (unsigned)__builtin_amdgcn_readfirstlane((int)F.MISC[16 + (itn & 1)]);
                    if (idx >= (curq ? NDB : NA)) { if (switched) break; switched = true; curq ^= 1; if (F.tid == 0) nxt = __hip_atomic_fetch_add(curq ? qd : qa, 1u, RLX_AGENT); continue; }
                    if (F.tid == 0) nxt = __hip_atomic_fetch_add(curq ? qd : qa, 1u, RLX_AGENT);
                    if (curq == 0) {
                        if (idx < (unsigned)(NBATCH * NQH * 16)) { const int qb = 15 - (int)(idx / 48u), bh = (int)(idx % 48u), b = bh / NQH, hq = bh % NQH, kvh = hq / 3; const size_t row0 = (size_t)b * SEQ + qb * 256;
                            attn_body::attn_unit<1, 8>(qb, F.proj(l) + row0 * DM + hq * 64, F.kbuf() + ((size_t)b * SEQ) * 256 + kvh * 64, F.vbuf() + ((size_t)b * SEQ) * 256 + kvh * 64,
                                                       F.mixo(l) + row0 * DM + hq * 64, F.g_q() + (l - 2) * 64, F.kmeanp() + ((size_t)b * 16) * 256 + kvh * 64, (char*)lds); }
                        else { const int u = (int)idx - NBATCH * NQH * 16, b = u >> 6, mh = (u >> 4) & 3, qb = u & 15; const size_t row0 = (size_t)b * SEQ + qb * 256;
                            attn_body::attn_unit<0, 8>(qb, F.proj(l) + row0 * DM + MIXW + mh * 64, F.memkb() + ((size_t)(l * MEMR + b * 256)) * 256 + mh * 64, F.memvb() + ((size_t)(l * MEMR + b * 256)) * 256 + mh * 64,
                                                       F.mixo(l) + row0 * DM + MIXW + mh * 64, F.g_mq() + l * 64, nullptr, (char*)lds); }
                    } else {
                        if (idx < (unsigned)((NS * NQH) / 8)) { const int it = (int)idx * 8 + F.wave; decode_wave<true>(F, l, it / NQH, it % NQH, F.lds + F.wave * 4096); }
                        else { const int it = ((int)idx - (NS * NQH) / 8) * 8 + F.wave; decode_wave<false>(F, l, it >> 2, it & 3, F.lds + F.wave * 4096); }
                    }
                }
                SEAM(pb + 2);
            }
        }
        if (IN(pb + 4)) {
            pg8::Gemm g{F.mixo(l), (const bf16*)(F.wsb() + WS_WOUT + (size_t)l * 2 * MiB), MROWS, DM, DM};
            pg8::ListSched S; S.init(NPP, 4, 0, 0, 0, 0, F.G, (int)blockIdx.x);
            pg8::EpiResid E{l == 0 ? F.x_prompt() : nullptr, l == 0 ? nullptr : F.hbb(l - 1), F.hba(l), F.ssqb(l), nullptr};
            pg8::gemm_phase<pg8::EpiResid, pg8::ListSched, true, true>(F.lds, g, S, E);
            for (int tl = F.vcu; tl < 128; tl += F.G) skinny_resid(F, F.mixo(l), (const bf16*)(F.wsb() + WS_WOUT + (size_t)l * 2 * MiB), DM, l == 0 ? F.x_sample() : nullptr, l == 0 ? nullptr : F.hbb(l - 1), F.hba(l), F.ssqb(l), false, tl);
            SEAM(pb + 4);
        }
        if (IN(pb + 5)) {
            pg8::Gemm g{F.hba(l), (const bf16*)(F.wsb() + WS_WGU + (size_t)l * WGU_STRIDE), MROWS, 2 * DFF, DM};
            pg8::ListSched S; S.init(NPT, 22, 0, 0, 0, 0, F.G, (int)blockIdx.x);
            pg8::EpiSwiglu E{F.ssqb(l), F.ffh(l)};
            pg8::gemm_phase<pg8::EpiSwiglu, pg8::ListSched, true, true>(F.lds, g, S, E);
            if (l < 2 && (int)blockIdx.x >= 150) sample_kmeans(F, 342 * l, 342 * l + 342, (int)blockIdx.x - 150, F.G - 150);
            SEAM(pb + 5);
        }
        if (IN(pb + 6)) {
            pg8::Gemm g{F.ffh(l), (const bf16*)(F.wsb() + WS_WDOWN + (size_t)l * WDOWN_STRIDE), MROWS, DM, DFF};
            pg8::ListSched S; S.init(NPP, 4, 0, 0, 0, 0, F.G, (int)blockIdx.x);
            pg8::EpiResid E{nullptr, F.hba(l), F.hbb(l), F.ssqa(l), l == 3 ? F.out() + OFF_Y : nullptr};
            pg8::gemm_phase<pg8::EpiResid, pg8::ListSched, true, true>(F.lds, g, S, E);
            for (int tl = F.vcu; tl < 128; tl += F.G) skinny_resid(F, F.ffh(l), (const bf16*)(F.wsb() + WS_WDOWN + (size_t)l * WDOWN_STRIDE), DFF, nullptr, F.hba(l), F.hbb(l), F.ssqa(l), l == 3, tl);
            SEAM(pb + 6);
        }
    }
    if (hi - lo > 1) xcd_barrier(bar);
#undef IN
#undef SEAM
}

#ifndef MK_ONE_LAUNCH
#define MK_ONE_LAUNCH 0
#endif
extern "C" void kernel_launch(void* const* d_in, const int* in_sizes, int n_in, void* d_out, int out_size, void* d_ws, size_t ws_size, hipStream_t stream) {
    static int grid = 0;
    if (grid == 0) {
        if (n_in != 33 || out_size != (int)OUT_TOTAL || ws_size < WS_END) { fprintf(stderr, "kernel_launch: unexpected shapes: n_in %d out %d ws %zu; nothing launched\n", n_in, out_size, ws_size); grid = -1; return; }
        int dev = 0, cus = 0, per_cu = 0;
        if (hipGetDevice(&dev) != hipSuccess || hipDeviceGetAttribute(&cus, hipDeviceAttributeMultiprocessorCount, dev) != hipSuccess) { fprintf(stderr, "kernel_launch: device query failed\n"); grid = -1; return; }
        if (hipFuncSetAttribute((const void*)fwd, hipFuncAttributeMaxDynamicSharedMemorySize, LDS_BYTES) != hipSuccess) { fprintf(stderr, "kernel_launch: hipFuncSetAttribute failed\n"); grid = -1; return; }
        if (hipOccupancyMaxActiveBlocksPerMultiprocessor(&per_cu, (const void*)fwd, NWAVES * 64, LDS_BYTES) != hipSuccess || per_cu < 1) fprintf(stderr, "kernel_launch: note: occupancy query reports %d workgroups per CU\n", per_cu);
        (void)hipGetLastError();
        grid = cus;
    }
    if (grid < 0) return;
    if (hipMemsetAsync((char*)d_ws + WS_CTL, 0, CTL_ZERO_BYTES, stream) != hipSuccess) { fprintf(stderr, "kernel_launch: memset failed\n"); return; }
    Args a{};
    for (int i = 0; i < 33; ++i) a.in[i] = d_in[i];
    a.out = (float*)d_out; a.ws = (unsigned char*)d_ws; a.pad = 0;
    if (MK_ONE_LAUNCH) {
        a.ph_lo = 0; a.ph_hi = N_PHASES; a.li = 0;
        hipLaunchKernelGGL(fwd, dim3(grid), dim3(NWAVES * 64), LDS_BYTES, stream, a);
        const hipError_t le = hipPeekAtLastError(); if (le != hipSuccess) fprintf(stderr, "kernel_launch: launch failed: %s\n", hipGetErrorName(le));
    } else {
        int li = 0;
        for (int p = 0; p < N_PHASES; ++p) { if (!phase_exists(p)) continue;
            a.ph_lo = p; a.ph_hi = p + 1; a.li = li++;
            hipLaunchKernelGGL(fwd, dim3(grid), dim3(NWAVES * 64), LDS_BYTES, stream, a);
            const hipError_t le = hipPeekAtLastError(); if (le != hipSuccess) { fprintf(stderr, "kernel_launch: launch %d failed: %s\n", p, hipGetErrorName(le)); break; } }
    }
}
```

```cpp
#include <hip/hip_runtime.h>
#include <cstdio>
#include <cstdint>
#include <cmath>
#define MK_ONE_LAUNCH 1
namespace pg8 {
#define PG8_LAS __attribute__((address_space(3)))
typedef unsigned short bf16_t;
typedef short bf16x8 __attribute__((ext_vector_type(8)));
typedef float f32x4 __attribute__((ext_vector_type(4)));
typedef unsigned u32x4 __attribute__((ext_vector_type(4)));
constexpr int BM = 256, BK = 64, HALF = 128, HTB = HALF * BK * 2  , STAGE_BYTES = 8 * HTB, NXCD = 8, WGM = 8;

__host__ __device__ __forceinline__ int lds_byte(int r, int c) { const int st = (r >> 4) * 2 + (c >> 5), rr = r & 15, cc = c & 31, ob = rr * 64 + cc * 2; return st * 1024 + (ob ^ (((ob >> 9) & 1) << 5)); }
__host__ __device__ __forceinline__ void stage_rc(int b, int& R, int& C) { const int st = b / 1024, sb = b % 1024, swz = sb ^ (((sb >> 9) & 1) << 5); R = (st >> 1) * 16 + swz / 64; C = (st & 1) * 32 + (swz % 64) / 2; }
__host__ __device__ __forceinline__ int perm32(int rho) { const int n = rho >> 4, i = rho & 15; return 8 * (i >> 2) + 4 * n + (i & 3); }

struct Unit { int pm, pn; };
struct Gemm { const bf16_t* A; const bf16_t* Bt; int M, N, K; };

struct StaticOrder {
    int nM, nN, nwg, G, c;
    __host__ __device__ void init(int M, int N, int G_, int c_) { nM = M / BM; nN = N / BM; nwg = nM * nN; G = G_; c = c_; }
    __host__ __device__ bool next(int i, Unit& u) const {
        const long L = (long)i * G + c; if (L >= nwg) return false;
        int wgid = (int)L; { const int q = nwg / NXCD, r = nwg % NXCD, xcd = wgid % NXCD, off = wgid / NXCD; wgid = (xcd < r ? xcd * (q + 1) : r * (q + 1) + (xcd - r) * q) + off; }
        const int nig = WGM * nN, gid = wgid / nig, fm = gid * WGM, gsz = (nM - fm) < WGM ? (nM - fm) : WGM;
        u.pm = fm + ((wgid % nig) % gsz); u.pn = (wgid % nig) / gsz; return true;
    }
    __device__ __forceinline__ void a_ready(const Unit&) const {}
    __device__ __forceinline__ void done(const Unit&) const {}
};

struct ListSched {
    int nM0, nN0, m1, nM1, n1, nN1, n0, ntot, G, c;
    __device__ void init(int nM0_, int nN0_, int m1_, int nM1_, int n1_, int nN1_, int G_, int c_) { nM0 = nM0_; nN0 = nN0_; m1 = m1_; nM1 = nM1_; n1 = n1_; nN1 = nN1_; n0 = nM0_ * nN0_; ntot = n0 + nM1_ * nN1_; G = G_; c = c_; }
    __device__ bool next(int i, Unit& u) const {
        const long L = (long)i * G + c; if (L >= ntot) return false;
        if (L < n0) {
            int wgid = (int)L; const int nwg = n0; { const int q = nwg / NXCD, r = nwg % NXCD, xcd = wgid % NXCD, off = wgid / NXCD; wgid = (xcd < r ? xcd * (q + 1) : r * (q + 1) + (xcd - r) * q) + off; }
            const int nig = WGM * nN0, gid = wgid / nig, fm = gid * WGM, gsz = (nM0 - fm) < WGM ? (nM0 - fm) : WGM;
            u.pm = fm + ((wgid % nig) % gsz); u.pn = (wgid % nig) / gsz;
        } else { const int r = (int)L - n0; u.pm = m1 + r % nM1; u.pn = n1 + r / nM1; }
        return true;
    }
    __device__ __forceinline__ void a_ready(const Unit&) const {}
    __device__ __forceinline__ void done(const Unit&) const {}
};
__device__ __forceinline__ unsigned cvt_pk_bf16(float lo, float hi) { unsigned r; asm volatile("v_cvt_pk_bf16_f32 %0, %1, %2" : "=v"(r) : "v"(lo), "v"(hi)); return r; }
__device__ __forceinline__ float bf_lo(unsigned w) { return __builtin_bit_cast(float, w << 16); }
__device__ __forceinline__ float bf_hi(unsigned w) { return __builtin_bit_cast(float, w & 0xffff0000u); }
constexpr float RMS_EPS = 1e-6f;
__device__ __forceinline__ float row_rstd(const float* ssq, int row, int fq) {
    const f32x4 p = *(const f32x4*)(ssq + (size_t)row * 16 + 4 * fq);
    float s = (p[0] + p[1]) + (p[2] + p[3]); s += __shfl_xor(s, 16); s += __shfl_xor(s, 32);
    return __builtin_amdgcn_rsqf(s * (1.0f / 1024.0f) + RMS_EPS);
}
__device__ __forceinline__ float sigm(float x) { return __builtin_amdgcn_rcpf(1.0f + __builtin_amdgcn_exp2f(-1.4426950408889634f * x)); }
typedef float f32x2p __attribute__((ext_vector_type(2)));
__device__ __forceinline__ f32x2p sigm2_of_t(f32x2p t2) { f32x2p a; a.x = __builtin_amdgcn_exp2f(t2.x); a.y = __builtin_amdgcn_exp2f(t2.y); a = a + 1.0f; f32x2p s; s.x = __builtin_amdgcn_rcpf(a.x); s.y = __builtin_amdgcn_rcpf(a.y); return s; }

struct EpiProj {
    static constexpr bool PERM = true, AFTER_DRAIN = false;
    const float* ssq; bf16_t* proj; float* kvraw; float* pmk; float* pmv; int npt;
    __device__ __forceinline__ void operator()(const f32x4 (&acc)[2][2][4][2], const Unit& u, int wr, int wc, int fr, int fq) const {
        const int row0 = u.pm * BM + wr * 64 + fr, cl = wc * 32 + 8 * fq;
#pragma unroll
        for (int ai = 0; ai < 2; ++ai)
#pragma unroll
            for (int m = 0; m < 4; ++m) {
                const int row = row0 + ai * HALF + m * 16; const float rs = row_rstd(ssq, row, fq);
                if (u.pm < npt) {
                    if (u.pn < 4) { bf16_t* rowp = proj + (size_t)row * 1024 + u.pn * BM + cl;
#pragma unroll
                        for (int bj = 0; bj < 2; ++bj) { const f32x4 v0 = acc[ai][bj][m][0] * rs, v1 = acc[ai][bj][m][1] * rs; u32x4 w; w.x = cvt_pk_bf16(v0[0], v0[1]); w.y = cvt_pk_bf16(v0[2], v0[3]); w.z = cvt_pk_bf16(v1[0], v1[1]); w.w = cvt_pk_bf16(v1[2], v1[3]); *(u32x4*)(rowp + bj * HALF) = w; }
                    } else { float* rowp = kvraw + (size_t)row * 512 + (u.pn - 4) * BM + cl;
#pragma unroll
                        for (int bj = 0; bj < 2; ++bj) { *(f32x4*)(rowp + bj * HALF) = acc[ai][bj][m][0] * rs; *(f32x4*)(rowp + bj * HALF + 4) = acc[ai][bj][m][1] * rs; }
                    }
                } else { const int t = u.pn - 4; float* rowp = ((t & 1) ? pmv : pmk) + (size_t)(t >> 1) * 262144 + (size_t)(row - npt * BM) * 256 + cl;
#pragma unroll
                    for (int bj = 0; bj < 2; ++bj) { *(f32x4*)(rowp + bj * HALF) = acc[ai][bj][m][0] * rs; *(f32x4*)(rowp + bj * HALF + 4) = acc[ai][bj][m][1] * rs; }
                }
            }
    }
};
struct EpiGlu {
    static constexpr bool PERM = true, AFTER_DRAIN = false;
    const bf16_t* y; bf16_t* out;
    __device__ __forceinline__ void operator()(const f32x4 (&acc)[2][2][4][2], const Unit& u, int wr, int wc, int fr, int fq) const {
        const int row0 = u.pm * BM + wr * 64 + fr, col0 = u.pn * BM + wc * 32 + 8 * fq;
#pragma unroll
        for (int ai = 0; ai < 2; ++ai)
#pragma unroll
            for (int m = 0; m < 4; ++m) { const int row = row0 + ai * HALF + m * 16;
#pragma unroll
                for (int bj = 0; bj < 2; ++bj) { const u32x4 yw = *(const u32x4*)(y + (size_t)row * 768 + col0 + bj * HALF); const f32x4 z0 = acc[ai][bj][m][0], z1 = acc[ai][bj][m][1]; u32x4 w;
                    { const float nl = -1.4426950408889634f;
                      const f32x2p s0 = sigm2_of_t((f32x2p){z0[0], z0[1]} * nl), s1 = sigm2_of_t((f32x2p){z0[2], z0[3]} * nl), s2 = sigm2_of_t((f32x2p){z1[0], z1[1]} * nl), s3 = sigm2_of_t((f32x2p){z1[2], z1[3]} * nl);
                      const f32x2p p0 = (f32x2p){bf_lo(yw.x), bf_hi(yw.x)} * s0, p1 = (f32x2p){bf_lo(yw.y), bf_hi(yw.y)} * s1, p2 = (f32x2p){bf_lo(yw.z), bf_hi(yw.z)} * s2, p3 = (f32x2p){bf_lo(yw.w), bf_hi(yw.w)} * s3;
                      w.x = cvt_pk_bf16(p0.x, p0.y); w.y = cvt_pk_bf16(p1.x, p1.y); w.z = cvt_pk_bf16(p2.x, p2.y); w.w = cvt_pk_bf16(p3.x, p3.y); }
                    *(u32x4*)(out + (size_t)row * 1024 + col0 + bj * HALF) = w; } }
    }
};
struct EpiSwiglu {
    static constexpr bool PERM = true, AFTER_DRAIN = false;
    const float* ssq; bf16_t* out;
    __device__ __forceinline__ void operator()(const f32x4 (&acc)[2][2][4][2], const Unit& u, int wr, int wc, int fr, int fq) const {
        const int row0 = u.pm * BM + wr * 64 + fr, col0 = u.pn * HALF + wc * 32 + 8 * fq;
#pragma unroll
        for (int ai = 0; ai < 2; ++ai)
#pragma unroll
            for (int m = 0; m < 4; ++m) { const int row = row0 + ai * HALF + m * 16;
                const float rs = row_rstd(ssq, row, fq);
                const float c1 = -1.4426950408889634f * rs, rs2 = rs * rs;
                f32x2p o2[4];
#pragma unroll
                for (int n = 0; n < 2; ++n)
#pragma unroll
                    for (int h = 0; h < 2; ++h) { const f32x2p g2 = {acc[ai][0][m][n][2 * h], acc[ai][0][m][n][2 * h + 1]}, u2 = {acc[ai][1][m][n][2 * h], acc[ai][1][m][n][2 * h + 1]};
                        o2[2 * n + h] = ((g2 * u2) * rs2) * sigm2_of_t(g2 * c1); }
                u32x4 w; w.x = cvt_pk_bf16(o2[0].x, o2[0].y); w.y = cvt_pk_bf16(o2[1].x, o2[1].y); w.z = cvt_pk_bf16(o2[2].x, o2[2].y); w.w = cvt_pk_bf16(o2[3].x, o2[3].y);
                *(u32x4*)(out + (size_t)row * 2816 + col0) = w; }
    }
};
struct EpiResid {
    static constexpr bool PERM = true, AFTER_DRAIN = false;
    const float* xin; const bf16_t* hin; bf16_t* hb; float* ssq_out; float* yout;
    template <bool XIN>
    __device__ __forceinline__ void body(const f32x4 (&acc)[2][2][4][2], const Unit& u, int wr, int wc, int fr, int fq) const {
        const int row0 = u.pm * BM + wr * 64 + fr, col0 = u.pn * BM + wc * 32 + 8 * fq;
#pragma unroll
        for (int ai = 0; ai < 2; ++ai) {
            u32x4 hw[4][2];
            if (!XIN) {
#pragma unroll
                for (int m = 0; m < 4; ++m)
#pragma unroll
                    for (int bj = 0; bj < 2; ++bj) hw[m][bj] = *(const u32x4*)(hin + (size_t)(row0 + ai * HALF + m * 16) * 1024 + col0 + bj * HALF);
            }
#pragma unroll
            for (int mh = 0; mh < 2; ++mh) {
                f32x4 xv[2][2][2];
                if (XIN) {
#pragma unroll
                    for (int ml = 0; ml < 2; ++ml)
#pragma unroll
                        for (int bj = 0; bj < 2; ++bj) { const float* xp = xin + (size_t)(row0 + ai * HALF + (2 * mh + ml) * 16) * 1024 + col0 + bj * HALF; xv[ml][bj][0] = *(const f32x4*)xp; xv[ml][bj][1] = *(const f32x4*)(xp + 4); }
                }
#pragma unroll
                for (int ml = 0; ml < 2; ++ml) { const int m = 2 * mh + ml, row = row0 + ai * HALF + m * 16; f32x2p ss2 = {0.f, 0.f};
#pragma unroll
                    for (int bj = 0; bj < 2; ++bj) { const size_t off = (size_t)row * 1024 + col0 + bj * HALF; f32x4 v0, v1;
                        if (XIN) { v0 = xv[ml][bj][0]; v1 = xv[ml][bj][1]; }
                        else { const u32x4 h = hw[m][bj]; v0 = (f32x4){bf_lo(h.x), bf_hi(h.x), bf_lo(h.y), bf_hi(h.y)}; v1 = (f32x4){bf_lo(h.z), bf_hi(h.z), bf_lo(h.w), bf_hi(h.w)}; }
                        v0 += acc[ai][bj][m][0]; v1 += acc[ai][bj][m][1];
                        if (yout) { *(f32x4*)(yout + off) = v0; *(f32x4*)(yout + off + 4) = v1; }
                        u32x4 w; w.x = cvt_pk_bf16(v0[0], v0[1]); w.y = cvt_pk_bf16(v0[2], v0[3]); w.z = cvt_pk_bf16(v1[0], v1[1]); w.w = cvt_pk_bf16(v1[2], v1[3]);
                        *(u32x4*)(hb + off) = w;
                        { const f32x2p a0 = {v0[0], v0[1]}, a1 = {v0[2], v0[3]}, a2 = {v1[0], v1[1]}, a3 = {v1[2], v1[3]}; ss2 = a0 * a0 + ss2; ss2 = a1 * a1 + ss2; ss2 = a2 * a2 + ss2; ss2 = a3 * a3 + ss2; } }
                    float ss = ss2.x + ss2.y; ss += __shfl_xor(ss, 16); ss += __shfl_xor(ss, 32);
                    if (fq == 0) ssq_out[(size_t)row * 16 + 4 * u.pn + wc] = ss; }
            }
        }
    }
    __device__ __forceinline__ void operator()(const f32x4 (&acc)[2][2][4][2], const Unit& u, int wr, int wc, int fr, int fq) const {
        if (xin) body<true>(acc, u, wr, wc, fr, fq); else body<false>(acc, u, wr, wc, fr, fq);
    }
};

template <class Epi, class Sched, bool ALIGN_EPI = false, bool SP2 = false>
__device__ __forceinline__ void gemm_phase(PG8_LAS unsigned char* lds, const Gemm g, const Sched& S, const Epi& E) {
    int tid_ = threadIdx.x; asm volatile("" : "+v"(tid_)); const int tid = tid_, wid = __builtin_amdgcn_readfirstlane(tid >> 6), lane = tid & 63, wr = wid >> 2, wc = wid & 3, fr = lane & 15, fq = lane >> 4;
    const int K = g.K, nt = K / BK;
    unsigned voffA[2], voffB[2];
#pragma unroll
    for (int i = 0; i < 2; ++i) { int R, C; stage_rc(tid * 16 + i * 8192, R, C); const int Rb = Epi::PERM ? ((R & ~31) + perm32(R & 31)) : R;
        voffA[i] = (unsigned)(R * K + C) * 2u; voffB[i] = (unsigned)(Rb * K + C) * 2u; }
    const size_t kstep = (size_t)(BK * 2);
    const size_t hstep = (size_t)HALF * K * 2;
    const size_t tstep = 2 * hstep;
    const unsigned ldsw = (unsigned)wid * 1024u;
    const int aoff = lds_byte(wr * 64 + fr, fq * 8), boff = lds_byte(wc * 32 + fr, fq * 8);
#define PG8_SA(b, h) (((b) * 2 + (h)) * HTB)
#define PG8_SB(b, h) ((4 + (b) * 2 + (h)) * HTB)
#define PG8_STAGE(bufoff, gbase, voff) do { _Pragma("unroll") for (int _i = 0; _i < 2; ++_i) \
        __builtin_amdgcn_global_load_lds((const unsigned*)((const char*)(gbase) + (voff)[_i]), (PG8_LAS unsigned*)(lds + (bufoff) + ldsw + _i * 8192), 16, 0, 0); } while (0)
#define PG8_LDA(dst, b, h) do { _Pragma("unroll") for (int m = 0; m < 4; ++m) _Pragma("unroll") for (int k = 0; k < 2; ++k) dst[m][k] = *(const PG8_LAS bf16x8*)(lds + PG8_SA(b, h) + aoff + m * 2048 + k * 1024); } while (0)
#define PG8_LDB(dst, b, h) do { _Pragma("unroll") for (int n = 0; n < 2; ++n) _Pragma("unroll") for (int k = 0; k < 2; ++k) dst[n][k] = *(const PG8_LAS bf16x8*)(lds + PG8_SB(b, h) + boff + n * 2048 + k * 1024); } while (0)
#define PG8_MMA(ai, bj, At, Bt) do { __builtin_amdgcn_s_setprio(1); _Pragma("unroll") for (int m = 0; m < 4; ++m) _Pragma("unroll") for (int n = 0; n < 2; ++n) _Pragma("unroll") for (int k = 0; k < 2; ++k) \
        acc[ai][bj][m][n] = __builtin_amdgcn_mfma_f32_16x16x32_bf16(Bt[n][k], At[m][k], acc[ai][bj][m][n], 0, 0, 0); __builtin_amdgcn_s_setprio(0); } while (0)
#define PG8_WAIT_V(n) asm volatile("s_waitcnt vmcnt(" #n ")" ::: "memory")
#define PG8_WAIT_L(n) asm volatile("s_waitcnt lgkmcnt(" #n ")" ::: "memory")
#define PG8_BAR __builtin_amdgcn_s_barrier()
#define PG8_SCHED __builtin_amdgcn_sched_barrier(0)
    Unit cur, nxt; int ui = 0;
    if (!S.next(0, cur)) return;
    f32x4 acc[2][2][4][2];
#pragma unroll
    for (int a = 0; a < 2; ++a)
#pragma unroll
        for (int b = 0; b < 2; ++b)
#pragma unroll
            for (int m = 0; m < 4; ++m)
#pragma unroll
                for (int n = 0; n < 2; ++n) acc[a][b][m][n] = (f32x4){0.f, 0.f, 0.f, 0.f};
    bf16x8 At[4][2], B0[2][2], B1[2][2];
    const char* cA = (const char*)g.A + (size_t)cur.pm * tstep; const char* cB = (const char*)g.Bt + (size_t)cur.pn * tstep;
    S.a_ready(cur);
    if constexpr (SP2) {
        PG8_STAGE(PG8_SB(0, 0), cB, voffB); PG8_STAGE(PG8_SB(0, 1), cB + hstep, voffB); PG8_STAGE(PG8_SA(0, 0), cA, voffA); PG8_STAGE(PG8_SA(0, 1), cA + hstep, voffA);
        if (wr == 1) PG8_BAR;
        PG8_WAIT_V(2); PG8_BAR;
        PG8_STAGE(PG8_SB(1, 0), cB + kstep, voffB); PG8_STAGE(PG8_SA(1, 0), cA + kstep, voffA); PG8_STAGE(PG8_SB(1, 1), cB + hstep + kstep, voffB);
        PG8_WAIT_V(6); PG8_BAR;
    } else {
        PG8_STAGE(PG8_SB(0, 0), cB, voffB); PG8_STAGE(PG8_SA(0, 0), cA, voffA); PG8_STAGE(PG8_SB(0, 1), cB + hstep, voffB); PG8_STAGE(PG8_SA(0, 1), cA + hstep, voffA);
        if (wr == 1) PG8_BAR;
        PG8_WAIT_V(4); PG8_BAR;
        PG8_STAGE(PG8_SB(1, 0), cB + kstep, voffB); PG8_STAGE(PG8_SA(1, 0), cA + kstep, voffA); PG8_STAGE(PG8_SB(1, 1), cB + hstep + kstep, voffB);
        PG8_WAIT_V(6); PG8_BAR;
    }
    for (;;) {
        const bool has_next = S.next(ui + 1, nxt);
        const char* nA = has_next ? (const char*)g.A + (size_t)nxt.pm * tstep : cA; const char* nB = has_next ? (const char*)g.Bt + (size_t)nxt.pn * tstep : cB;
        for (int t = 0; t < nt; t += 2) {
            const bool last = (t == nt - 2);
            const char* a1 = cA + (size_t)(t + 1) * kstep;
            const char* a2 = last ? nA : cA + (size_t)(t + 2) * kstep; const char* b2 = last ? nB : cB + (size_t)(t + 2) * kstep;
            const char* a3 = a2 + kstep; const char* b3 = b2 + kstep;
            if (last && has_next) S.a_ready(nxt);
            if constexpr (SP2) {
            PG8_LDB(B0, 0, 0); PG8_LDB(B1, 0, 1); PG8_SCHED; PG8_LDA(At, 0, 0); PG8_STAGE(PG8_SA(1, 1), a1 + hstep, voffA);
            PG8_WAIT_V(8); PG8_WAIT_L(0); PG8_BAR; PG8_MMA(0, 0, At, B0); PG8_MMA(0, 1, At, B1); PG8_BAR; PG8_SCHED;
            PG8_LDA(At, 0, 1); PG8_STAGE(PG8_SB(0, 0), b2, voffB); PG8_STAGE(PG8_SB(0, 1), b2 + hstep, voffB); PG8_STAGE(PG8_SA(0, 0), a2, voffA);
            PG8_WAIT_V(8); PG8_WAIT_L(0); PG8_BAR; PG8_MMA(1, 0, At, B0); PG8_MMA(1, 1, At, B1); PG8_BAR; PG8_SCHED;
            PG8_LDB(B0, 1, 0); PG8_LDB(B1, 1, 1); PG8_SCHED; PG8_LDA(At, 1, 0); PG8_STAGE(PG8_SA(0, 1), a2 + hstep, voffA);
            PG8_WAIT_V(8); PG8_WAIT_L(0); PG8_BAR; PG8_MMA(0, 0, At, B0); PG8_MMA(0, 1, At, B1); PG8_BAR; PG8_SCHED;
            PG8_LDA(At, 1, 1); PG8_STAGE(PG8_SB(1, 0), b3, voffB); PG8_STAGE(PG8_SB(1, 1), b3 + hstep, voffB); PG8_STAGE(PG8_SA(1, 0), a3, voffA);
            PG8_WAIT_V(8); PG8_WAIT_L(0); PG8_BAR; PG8_MMA(1, 0, At, B0); PG8_MMA(1, 1, At, B1); PG8_BAR; PG8_SCHED;
            } else {
            PG8_LDB(B0, 0, 0); PG8_SCHED; PG8_LDA(At, 0, 0); PG8_STAGE(PG8_SA(1, 1), a1 + hstep, voffA);
            PG8_WAIT_L(8); PG8_BAR; PG8_WAIT_L(0); PG8_MMA(0, 0, At, B0); PG8_BAR; PG8_SCHED;
            PG8_LDB(B1, 0, 1); PG8_STAGE(PG8_SB(0, 0), b2, voffB);
            PG8_BAR; PG8_WAIT_L(0); PG8_MMA(0, 1, At, B1); PG8_BAR;
            PG8_LDA(At, 0, 1); PG8_STAGE(PG8_SA(0, 0), a2, voffA);
            PG8_BAR; PG8_WAIT_L(0); PG8_MMA(1, 0, At, B0); PG8_BAR; PG8_SCHED;
            PG8_STAGE(PG8_SB(0, 1), b2 + hstep, voffB);
            PG8_WAIT_V(6); PG8_BAR; PG8_MMA(1, 1, At, B1); PG8_BAR;
            PG8_LDB(B0, 1, 0); PG8_SCHED; PG8_LDA(At, 1, 0); PG8_STAGE(PG8_SA(0, 1), a2 + hstep, voffA);
            PG8_WAIT_L(8); PG8_BAR; PG8_WAIT_L(0); PG8_MMA(0, 0, At, B0); PG8_BAR; PG8_SCHED;
            PG8_LDB(B1, 1, 1); PG8_STAGE(PG8_SB(1, 0), b3, voffB);
            PG8_BAR; PG8_WAIT_L(0); PG8_MMA(0, 1, At, B1); PG8_BAR;
            PG8_LDA(At, 1, 1); PG8_STAGE(PG8_SA(1, 0), a3, voffA);
            PG8_BAR; PG8_WAIT_L(0); PG8_MMA(1, 0, At, B0); PG8_BAR; PG8_SCHED;
            PG8_STAGE(PG8_SB(1, 1), b3 + hstep, voffB);
            PG8_WAIT_V(6); PG8_BAR; PG8_MMA(1, 1, At, B1); PG8_BAR;
            }
        }
        if constexpr (ALIGN_EPI) { if (wr == 0) PG8_BAR; }
        if constexpr (!Epi::AFTER_DRAIN) { E(acc, cur, wr, wc, fr, fq); S.done(cur); }
        if (!has_next) break;
#pragma unroll
        for (int a = 0; a < 2; ++a)
#pragma unroll
            for (int b = 0; b < 2; ++b)
#pragma unroll
                for (int m = 0; m < 4; ++m)
#pragma unroll
                    for (int n = 0; n < 2; ++n) acc[a][b][m][n] = (f32x4){0.f, 0.f, 0.f, 0.f};
        cur = nxt; cA = nA; cB = nB; ++ui;
        if constexpr (ALIGN_EPI) { if (wr == 1) PG8_BAR; }
    }
    PG8_WAIT_V(0);
    if constexpr (!ALIGN_EPI) { if (wr == 0) PG8_BAR; }
    PG8_BAR;
    if constexpr (Epi::AFTER_DRAIN) { E.fused(acc, cur, wr, wc, fr, fq, lds, wid, lane); S.done(cur); }
#undef PG8_SA
#undef PG8_SB
#undef PG8_STAGE
#undef PG8_LDA
#undef PG8_LDB
#undef PG8_MMA
#undef PG8_WAIT_V
#undef PG8_WAIT_L
#undef PG8_BAR
#undef PG8_SCHED
}
}
namespace attn_body {
typedef unsigned short bf16;
using bf16x8=__attribute__((ext_vector_type(8)))short;
using s16x4=__attribute__((ext_vector_type(4)))short;
using f32x16=__attribute__((ext_vector_type(16)))float;
using u32x4=__attribute__((ext_vector_type(4)))unsigned;
constexpr int D=64,QP=1024,KVP=256,OP=1024;
constexpr int NW=8,QBLK=32,QB=QBLK*NW,KVBLK=64;
constexpr float NEGB=-1.0e30f;
__device__ __forceinline__ int crow(int r,int hi){return (r&3)+8*(r>>2)+4*hi;}
#define SBAR() __builtin_amdgcn_sched_barrier(0)
__device__ __forceinline__ void cmask(f32x16&p0,f32x16&p1,int jb,int qrel,int hi){
  const float NEG=-INFINITY; int kb=64*jb+4*hi;
  #pragma unroll
  for(int r=0;r<16;++r){int kv=kb+(r&3)+8*(r>>2); if(kv>qrel)p0[r]=NEG; if(kv+32>qrel)p1[r]=NEG;}
}

constexpr int NSLOT=3, SLOTB=8192;
constexpr int LDS_K=0, LDS_V=NSLOT*SLOTB, LDS_WS=2*NSLOT*SLOTB, LDS_OST=LDS_WS+NW*64*4, LDS_BYTES=LDS_OST+NW*4096;
constexpr float C2=0.125f*1.4426950408889634f;
__device__ __forceinline__ void glds16(const void*sbase,unsigned voff,unsigned lds_dst){unsigned keep;
  const unsigned long long sb0=(unsigned long long)sbase; const unsigned long long sb=((unsigned long long)(unsigned)__builtin_amdgcn_readfirstlane((unsigned)(sb0>>32))<<32)|(unsigned)__builtin_amdgcn_readfirstlane((unsigned)sb0);
  asm volatile("s_mov_b32 %0, m0\n\ts_mov_b32 m0, %3\n\ts_nop 0\n\tglobal_load_lds_dwordx4 %1, %2\n\ts_mov_b32 m0, %0":"=&s"(keep):"v"(voff),"s"(sb),"s"(lds_dst):"memory");}
__device__ __forceinline__ float max3f(float a,float b,float c){float r;asm("v_max3_f32 %0, %1, %2, %3":"=v"(r):"v"(a),"v"(b),"v"(c));return r;}
__device__ __forceinline__ float max2f(float a,float b){float r;asm("v_max_f32_e32 %0, %1, %2":"=v"(r):"v"(a),"v"(b));return r;}
__device__ __forceinline__ float fadd_s(float a,float b){float r;asm("v_add_f32_e32 %0, %1, %2":"=v"(r):"v"(a),"v"(b));return r;}
__device__ __forceinline__ float fsub_s(float a,float b){float r;asm("v_sub_f32_e32 %0, %1, %2":"=v"(r):"v"(a),"v"(b));return r;}
typedef float f32x2_t __attribute__((ext_vector_type(2))); typedef float f32x4_t __attribute__((ext_vector_type(4))); typedef __bf16 bf16x2_t __attribute__((ext_vector_type(2)));
__device__ __forceinline__ unsigned cvtpk_s(float lo,float hi){f32x2_t v={lo,hi};bf16x2_t b=__builtin_convertvector(v,bf16x2_t);return __builtin_bit_cast(unsigned,b);}
#define WAIT_BAR(N) asm volatile("s_waitcnt vmcnt(" #N ") lgkmcnt(0)\n\ts_barrier":::"memory")

__device__ __forceinline__ void qkt(f32x16&p0,f32x16&p1,const char*Kslot,const bf16x8*qr,const f32x16&negm,int r32,int hi){
  const char*kb=Kslot+hi*1024+r32*16;
  #pragma unroll
  for(int d0=0;d0<4;++d0){
    const bf16x8 b0=*reinterpret_cast<const bf16x8*>(kb+d0*2048);
    const bf16x8 b1=*reinterpret_cast<const bf16x8*>(kb+d0*2048+512);
    if(d0==0){p0=__builtin_amdgcn_mfma_f32_32x32x16_bf16(b0,qr[0],negm,0,0,0);p1=__builtin_amdgcn_mfma_f32_32x32x16_bf16(b1,qr[0],negm,0,0,0);}
    else{p0=__builtin_amdgcn_mfma_f32_32x32x16_bf16(b0,qr[d0],p0,0,0,0);p1=__builtin_amdgcn_mfma_f32_32x32x16_bf16(b1,qr[d0],p1,0,0,0);}}
}
typedef __attribute__((address_space(3))) const char* lds_cptr;
typedef short v4i16_t __attribute__((ext_vector_type(4)));
__device__ __forceinline__ void kload8(bf16x8*kf,lds_cptr kp){
  kf[0]=*(const __attribute__((address_space(3))) bf16x8*)(kp);      kf[1]=*(const __attribute__((address_space(3))) bf16x8*)(kp+512);
  kf[2]=*(const __attribute__((address_space(3))) bf16x8*)(kp+2048); kf[3]=*(const __attribute__((address_space(3))) bf16x8*)(kp+2560);
  kf[4]=*(const __attribute__((address_space(3))) bf16x8*)(kp+4096); kf[5]=*(const __attribute__((address_space(3))) bf16x8*)(kp+4608);
  kf[6]=*(const __attribute__((address_space(3))) bf16x8*)(kp+6144); kf[7]=*(const __attribute__((address_space(3))) bf16x8*)(kp+6656);
}
__device__ __forceinline__ void kload2(bf16x8*kf,lds_cptr kp,int j){ kf[2*j]=*(const __attribute__((address_space(3))) bf16x8*)(kp+j*2048); kf[2*j+1]=*(const __attribute__((address_space(3))) bf16x8*)(kp+j*2048+512); }
__device__ __forceinline__ s16x4 vtr(lds_cptr p){ return __builtin_bit_cast(s16x4,__builtin_amdgcn_ds_read_tr16_b64_v4i16((__attribute__((address_space(3))) v4i16_t*)p)); }
__device__ __forceinline__ float rowmax(const f32x16&p0,const f32x16&p1){
  float a=max3f(p0[0],p0[1],p1[0]),b=max3f(p0[2],p0[3],p1[1]);a=max3f(a,p1[2],p1[3]);
  #pragma unroll
  for(int r=4;r<16;r+=4){a=max3f(a,p0[r],p0[r+1]);b=max3f(b,p0[r+2],p0[r+3]);a=max3f(a,p1[r],p1[r+1]);b=max3f(b,p1[r+2],p1[r+3]);}
  const float m=max2f(a,b);
  auto rr=__builtin_amdgcn_permlane32_swap(__float_as_uint(m),__float_as_uint(m),false,false);
  return max2f(__uint_as_float(rr[0]),__uint_as_float(rr[1]));
}
__device__ __forceinline__ void pv(f32x16*o,int vb,bf16x8 pa0,bf16x8 pa1,bf16x8 pa2,bf16x8 pa3){
  #pragma unroll
  for(int d0=0;d0<2;++d0){s16x4 lo[4],hi[4];
    #pragma unroll
    for(int ks=0;ks<4;++ks){
      asm volatile("ds_read_b64_tr_b16 %0,%1 offset:%c2":"=&v"(lo[ks]):"v"(vb),"i"(d0*4096+ks*1024):"memory");
      asm volatile("ds_read_b64_tr_b16 %0,%1 offset:%c2":"=&v"(hi[ks]):"v"(vb),"i"(d0*4096+ks*1024+512):"memory");}
    asm volatile("s_waitcnt lgkmcnt(0)":::"memory");SBAR();
    #define PK(k) (bf16x8){lo[k][0],lo[k][1],lo[k][2],lo[k][3],hi[k][0],hi[k][1],hi[k][2],hi[k][3]}
    o[d0]=__builtin_amdgcn_mfma_f32_32x32x16_bf16(pa0,PK(0),o[d0],0,0,0);
    o[d0]=__builtin_amdgcn_mfma_f32_32x32x16_bf16(pa1,PK(1),o[d0],0,0,0);
    o[d0]=__builtin_amdgcn_mfma_f32_32x32x16_bf16(pa2,PK(2),o[d0],0,0,0);
    o[d0]=__builtin_amdgcn_mfma_f32_32x32x16_bf16(pa3,PK(3),o[d0],0,0,0);
    #undef PK
  }
}

#ifndef ATTN_STORE16
#define ATTN_STORE16(p,v) (*(u32x4*)(p)=(v))
#endif
template<int MODE,int THRL> __device__ __forceinline__ void attn_unit(int qb,const bf16*Qu,const bf16*__restrict__ Kh,const bf16*__restrict__ Vh,bf16*Ou,const float*__restrict__ gq,const bf16*__restrict__ kmean,char*shm){
  int tid_=threadIdx.x; asm volatile("":"+v"(tid_));   const int tid=tid_,lane=tid&63,r32=lane&31,hi=lane>>5; const int wid=__builtin_amdgcn_readfirstlane(tid>>6);
  const bf16*Qw=Qu+(long)(wid*QBLK)*QP;
  const unsigned lds0=(unsigned)(uintptr_t)shm;
  float*wsf=(float*)(shm+LDS_WS)+wid*64;
  const int NT=(MODE==1)?4*(qb+1):4;
  const unsigned kvoff=(unsigned)(lane*KVP+wid*8)*2u;
  const unsigned vvoff=(unsigned)((16*(wid&3)+(lane>>2))*KVP+(wid>>2)*32+(lane&3)*8)*2u;
  const unsigned kdst=lds0+LDS_K+wid*1024, vdst=lds0+LDS_V+wid*1024;
  #define TMAP(t) ((MODE==1)?(((t)<4)?(NT-4+(t)):((t)-4)):(t))
  #define DMA_K(t,slot) glds16(Kh+(long)TMAP(t)*KVBLK*KVP,kvoff,(unsigned)__builtin_amdgcn_readfirstlane(kdst+(slot)))
  #define DMA_V(t,slot) glds16(Vh+(long)TMAP(t)*KVBLK*KVP,vvoff,(unsigned)__builtin_amdgcn_readfirstlane(vdst+(slot)))
  const int vb0=(int)(lds0+LDS_V)+((lane>>4)&1)*32+(lane&3)*8+(4*hi+((lane&15)>>2))*64;
  const char*Kbase=shm+LDS_K; bf16x8 kf[8];
  const lds_cptr shm3=(lds_cptr)shm; const lds_cptr kp0=shm3+LDS_K+hi*1024+r32*16; const lds_cptr vp0=shm3+LDS_V+((lane>>4)&1)*32+(lane&3)*8+(4*hi+((lane&15)>>2))*64;
  DMA_K(0,0);DMA_V(0,0);DMA_K(1,SLOTB);
  bf16x8 qr[4]; unsigned sel=0u;
  { bf16x8 qraw[4]; f32x4_t gg[8]; bf16x8 kmf[4];
    #pragma unroll
    for(int d0=0;d0<4;++d0)qraw[d0]=*reinterpret_cast<const bf16x8*>(&Qw[(long)r32*QP+d0*16+hi*8]);
    #pragma unroll
    for(int d0=0;d0<4;++d0){gg[2*d0]=*reinterpret_cast<const f32x4_t*>(gq+d0*16+hi*8);gg[2*d0+1]=*reinterpret_cast<const f32x4_t*>(gq+d0*16+hi*8+4);}
    if(MODE==1){
      #pragma unroll
      for(int d0=0;d0<4;++d0){ kmf[d0]=bf16x8{}; if(r32<16)kmf[d0]=*reinterpret_cast<const bf16x8*>(kmean+(long)r32*KVP+d0*16+hi*8); } }
    float qf[32]; float ss=0.f;
    #pragma unroll
    for(int d0=0;d0<4;++d0){
      #pragma unroll
      for(int e=0;e<8;++e){const float v=__uint_as_float(((unsigned)(unsigned short)qraw[d0][e])<<16); qf[d0*8+e]=v; ss+=v*v;} }
    ss+=__shfl_xor(ss,32);
    const float rs=__builtin_amdgcn_rsqf(ss*(1.0f/64.0f)+1e-6f)*C2;
    #pragma unroll
    for(int d0=0;d0<4;++d0){ u32x4 w;
      w[0]=cvtpk_s(qf[d0*8+0]*rs*gg[2*d0][0],qf[d0*8+1]*rs*gg[2*d0][1]); w[1]=cvtpk_s(qf[d0*8+2]*rs*gg[2*d0][2],qf[d0*8+3]*rs*gg[2*d0][3]);
      w[2]=cvtpk_s(qf[d0*8+4]*rs*gg[2*d0+1][0],qf[d0*8+5]*rs*gg[2*d0+1][1]); w[3]=cvtpk_s(qf[d0*8+6]*rs*gg[2*d0+1][2],qf[d0*8+7]*rs*gg[2*d0+1][3]);
      qr[d0]=__builtin_bit_cast(bf16x8,w); }
    if(MODE==1){ if(qb>0){
      f32x16 ga=f32x16{};
      #pragma unroll
      for(int d0=0;d0<4;++d0)ga=__builtin_amdgcn_mfma_f32_32x32x16_bf16(kmf[d0],qr[d0],ga,0,0,0);
      float gv[8];
      #pragma unroll
      for(int r=0;r<8;++r){const int bi=crow(r,hi); gv[r]=(bi<qb)?ga[r]:-INFINITY;}
      #pragma unroll
      for(int k=0;k<3;++k){
        float best=gv[0]; int bidx=0;
        #pragma unroll
        for(int r=1;r<8;++r){ if(gv[r]>best){best=gv[r];bidx=r;} }
        const int bblk=crow(bidx,hi);
        const float obest=__shfl_xor(best,32); const int oblk=__shfl_xor(bblk,32);
        const bool mine=(best>obest)||(best==obest&&bblk<oblk);
        const float wbest=mine?best:obest; const int wblk=mine?bblk:oblk;
        if(wbest>-INFINITY)sel|=(1u<<wblk);
        #pragma unroll
        for(int r=0;r<8;++r)gv[r]=(mine&&bidx==r)?-INFINITY:gv[r];
      } } }
  }
  float mhat=0.f,l_reg=0.f;f32x16 o[2];o[0]=f32x16{};o[1]=f32x16{};f32x16 negm=f32x16{};asm volatile("":"+v"(negm));
  const int qrel=wid*QBLK+r32;
  #define CMASK(P0,P1,t) do{ if(MODE==1){ const int jb_=(t); if(jb_<4)cmask(P0,P1,jb_,qrel,hi); } }while(0)
  bool resc=false;
  #define START(P0,P1) do{ const float rm=rowmax(P0,P1); resc=false; \
    { const float dl=rm; mhat=fadd_s(mhat,dl); \
      _Pragma("unroll") for(int r=0;r<16;++r){P0[r]=fsub_s(P0[r],dl);P1[r]=fsub_s(P1[r],dl);} \
      _Pragma("unroll") for(int r=0;r<16;++r)negm[r]=-mhat; asm volatile("":"+v"(negm)); } \
    _Pragma("unroll") for(int r=0;r<16;++r)P0[r]=__builtin_amdgcn_exp2f(P0[r]); }while(0)
  #define RESC() do{ if(resc){ asm volatile("s_waitcnt lgkmcnt(0)":::"memory"); \
      _Pragma("unroll") for(int d_=0;d_<2;++d_) _Pragma("unroll") for(int r=0;r<16;++r)o[d_][r]*=wsf[crow(r,hi)]; } }while(0)
  f32x16 pA0,pA1,pB0,pB1;
  int sl_prev=0,sl_cur=0,sl_next=SLOTB;
  #define ROT() do{sl_prev=sl_cur;sl_cur=sl_next;sl_next=(sl_next==(NSLOT-1)*SLOTB)?0:sl_next+SLOTB;}while(0)
  DMA_K(2,2*SLOTB);
  WAIT_BAR(3);
  qkt(pA0,pA1,Kbase,qr,negm,r32,hi);asm volatile("s_nop 15\n\ts_nop 7":"+v"(pA0),"+v"(pA1));CMASK(pA0,pA1,0);
  START(pA0,pA1);
  _Pragma("unroll") for(int r=0;r<16;++r)pA1[r]=__builtin_amdgcn_exp2f(pA1[r]);
  WAIT_BAR(0);
  DMA_K(3,0);DMA_V(1,SLOTB);
  ROT();
  kload8(kf,kp0+sl_cur);
  WAIT_BAR(2);
  s16x4 vlo[8],vhi[8]; u32x4 pw0,pw1,pw2,pw3;
  #define PKW(P,B) cvtpk_s(P[B],P[B+1])
  #define PAF(k) __builtin_bit_cast(bf16x8,pw##k)
  #define VFR(i) (bf16x8){vlo[i][0],vlo[i][1],vlo[i][2],vlo[i][3],vhi[i][0],vhi[i][1],vhi[i][2],vhi[i][3]}
  #define PIN(x) asm volatile("":"+v"(x))
  #define MX3(a,b,c) __builtin_fmaxf(__builtin_fmaxf((a),(b)),(c))
  #define GAPA(MF,A0,A1,A2,A3,W0,W1,PW) do{ MF; sacc+=A0; sacc+=A1; sacc+=A2; sacc+=A3; PIN(sacc); W0; W1; PIN(PW); SBAR(); }while(0)
  #define EX(v) __builtin_amdgcn_exp2f(v)
  #define GAPB(MF,X,B) do{ MF; X[B]=EX(X[B]); X[B+1]=EX(X[B+1]); X[B+2]=EX(X[B+2]); X[B+3]=EX(X[B+3]); PIN(X); SBAR(); }while(0)
  #define VRD(i) do{ vlo[i]=vtr(vp_+(((i)>>2)*4096+((i)&3)*1024)); vhi[i]=vtr(vp_+(((i)>>2)*4096+((i)&3)*1024+512)); }while(0)
  #define KRD(G,j) do{ if(G){ kload2(kf,kp0+sl_next,j); SBAR(); } }while(0)
  #define STEP(C0,C1,P0,P1,t,GK,GV,GL) do{ SBAR(); \
    const lds_cptr vp_=vp0+sl_prev; \
    VRD(0); SBAR(); float sacc=(P0[0]+P0[1]); \
    GAPA(C0=__builtin_amdgcn_mfma_f32_32x32x16_bf16(kf[0],qr[0],negm,0,0,0), P0[2],P0[3],P0[4],P0[5],     pw0[0]=PKW(P0,0), pw0[1]=PKW(P0,2), pw0); \
    VRD(4); SBAR(); GAPA(C1=__builtin_amdgcn_mfma_f32_32x32x16_bf16(kf[1],qr[0],negm,0,0,0), P0[6],P0[7],P0[8],P0[9],     pw0[2]=PKW(P0,4), pw0[3]=PKW(P0,6), pw0); \
    VRD(1); SBAR(); GAPA(C0=__builtin_amdgcn_mfma_f32_32x32x16_bf16(kf[2],qr[1],C0,0,0,0),   P0[10],P0[11],P0[12],P0[13], pw1[0]=PKW(P0,8), pw1[1]=PKW(P0,10), pw1); \
    VRD(5); SBAR(); GAPA(C1=__builtin_amdgcn_mfma_f32_32x32x16_bf16(kf[3],qr[1],C1,0,0,0),   P0[14],P0[15],P1[0],P1[1],   pw1[2]=PKW(P0,12),pw1[3]=PKW(P0,14), pw1); \
    VRD(2); SBAR(); GAPA(C0=__builtin_amdgcn_mfma_f32_32x32x16_bf16(kf[4],qr[2],C0,0,0,0),   P1[2],P1[3],P1[4],P1[5],     pw2[0]=PKW(P1,0), pw2[1]=PKW(P1,2), pw2); \
    VRD(6); SBAR(); GAPA(C1=__builtin_amdgcn_mfma_f32_32x32x16_bf16(kf[5],qr[2],C1,0,0,0),   P1[6],P1[7],P1[8],P1[9],     pw2[2]=PKW(P1,4), pw2[3]=PKW(P1,6), pw2); \
    VRD(3); SBAR(); GAPA(C0=__builtin_amdgcn_mfma_f32_32x32x16_bf16(kf[6],qr[3],C0,0,0,0),   P1[10],P1[11],P1[12],P1[13], pw3[0]=PKW(P1,8), pw3[1]=PKW(P1,10), pw3); \
    VRD(7); SBAR(); GAPA(C1=__builtin_amdgcn_mfma_f32_32x32x16_bf16(kf[7],qr[3],C1,0,0,0),   P1[14],P1[15],0.f,0.f,       pw3[2]=PKW(P1,12),pw3[3]=PKW(P1,14), pw3); \
    l_reg+=sacc; \
    if(GK){DMA_K((t)+3,sl_cur);} if(GV){DMA_V((t)+1,sl_next);} \
    CMASK(C0,C1,t); \
    { float a=MX3(C0[0],C0[1],C1[0]),b=MX3(C0[2],C0[3],C1[1]); a=MX3(a,C1[2],C1[3]); \
      _Pragma("unroll") for(int r=4;r<16;r+=4){a=MX3(a,C0[r],C0[r+1]);b=MX3(b,C0[r+2],C0[r+3]);a=MX3(a,C1[r],C1[r+1]);b=MX3(b,C1[r+2],C1[r+3]);} \
      float rm=__builtin_fmaxf(a,b); { auto rr=__builtin_amdgcn_permlane32_swap(__float_as_uint(rm),__float_as_uint(rm),false,false); rm=__builtin_fmaxf(__uint_as_float(rr[0]),__uint_as_float(rr[1])); } \
      resc=false; \
      if(__builtin_expect(__any(rm>(float)THRL),0)){ const float dl=__builtin_fmaxf(rm,0.f); mhat+=dl; \
        _Pragma("unroll") for(int r=0;r<16;++r){C0[r]-=dl;C1[r]-=dl;} \
        { const bool ro_=(MODE!=1)||((t)<4)||(((sel>>(((t)-4)>>2))&1u)!=0u); const float nm_=ro_?-mhat:NEGB; _Pragma("unroll") for(int r=0;r<16;++r)negm[r]=nm_; } asm volatile("":"+v"(negm)); \
        const float f=__builtin_amdgcn_exp2f(-dl); l_reg*=f; if(hi==0)wsf[r32]=f; resc=true; } } \
    SBAR(); \
    GAPB(o[0]=__builtin_amdgcn_mfma_f32_32x32x16_bf16(PAF(0),VFR(0),o[0],0,0,0), C0,0); \
    GAPB(o[1]=__builtin_amdgcn_mfma_f32_32x32x16_bf16(PAF(0),VFR(4),o[1],0,0,0), C0,4); \
    KRD(GL,0); GAPB(o[0]=__builtin_amdgcn_mfma_f32_32x32x16_bf16(PAF(1),VFR(1),o[0],0,0,0), C0,8); \
    KRD(GL,1); GAPB(o[1]=__builtin_amdgcn_mfma_f32_32x32x16_bf16(PAF(1),VFR(5),o[1],0,0,0), C0,12); \
    KRD(GL,2); GAPB(o[0]=__builtin_amdgcn_mfma_f32_32x32x16_bf16(PAF(2),VFR(2),o[0],0,0,0), C1,0); \
    KRD(GL,3); GAPB(o[1]=__builtin_amdgcn_mfma_f32_32x32x16_bf16(PAF(2),VFR(6),o[1],0,0,0), C1,4); \
    GAPB(o[0]=__builtin_amdgcn_mfma_f32_32x32x16_bf16(PAF(3),VFR(3),o[0],0,0,0), C1,8); \
    GAPB(o[1]=__builtin_amdgcn_mfma_f32_32x32x16_bf16(PAF(3),VFR(7),o[1],0,0,0), C1,12); \
    }while(0)
  int t=1;
  #define PRE(tt) do{ if(MODE==1){ const int t_=(tt); if(t_>=4&&(t_&3)==0){ const bool ro_=((sel>>((t_-4)>>2))&1u)!=0u; const float nm_=ro_?-mhat:NEGB; _Pragma("unroll") for(int r=0;r<16;++r)negm[r]=nm_; asm volatile("":"+v"(negm)); } } }while(0)
  #define ENDW(tt) do{ if((tt)+3<NT){WAIT_BAR(2);} else if((tt)+2<NT){WAIT_BAR(1);} else {WAIT_BAR(0);} }while(0)
  for(;t+1<NT;t+=2){
    PRE(t);   STEP(pB0,pB1,pA0,pA1,t,(t+3<NT),(t+1<NT),(t+1<NT));       ENDW(t);   RESC(); ROT();
    PRE(t+1); STEP(pA0,pA1,pB0,pB1,t+1,(t+4<NT),(t+2<NT),(t+2<NT));     ENDW(t+1); RESC(); ROT();
  }
  PRE(NT-1); STEP(pB0,pB1,pA0,pA1,NT-1,false,false,false); RESC();
  { float sacc=pB0[0]+pB0[1]; _Pragma("unroll") for(int r=2;r<16;++r)sacc+=pB0[r]; _Pragma("unroll") for(int r=0;r<16;++r)sacc+=pB1[r]; l_reg+=sacc;
    pw0=(u32x4){PKW(pB0,0),PKW(pB0,2),PKW(pB0,4),PKW(pB0,6)};pw1=(u32x4){PKW(pB0,8),PKW(pB0,10),PKW(pB0,12),PKW(pB0,14)};pw2=(u32x4){PKW(pB1,0),PKW(pB1,2),PKW(pB1,4),PKW(pB1,6)};pw3=(u32x4){PKW(pB1,8),PKW(pB1,10),PKW(pB1,12),PKW(pB1,14)};
    SBAR(); pv(o,vb0+sl_cur,PAF(0),PAF(1),PAF(2),PAF(3)); }
  #undef PKW
  #undef PAF
  #undef VFR
  #undef PIN
  #undef MX3
  #undef GAPA
  #undef GAPB
  #undef EX
  #undef VRD
  #undef KRD
  #undef STEP
  #undef ENDW
  {auto rr=__builtin_amdgcn_permlane32_swap(__float_as_uint(l_reg),__float_as_uint(l_reg),false,false);l_reg=__uint_as_float(rr[0])+__uint_as_float(rr[1]);}
  if(hi==0)wsf[32+r32]=l_reg;asm volatile("s_waitcnt lgkmcnt(0)":::"memory");
  float rli[16];
  #pragma unroll
  for(int r=0;r<16;++r)rli[r]=__builtin_amdgcn_rcpf(wsf[32+crow(r,hi)]);
  bf16*Ow=Ou+(long)(wid*QBLK)*OP;
  { bf16*stg=(bf16*)(shm+LDS_OST)+wid*2048;
    #pragma unroll
    for(int r=0;r<16;++r){const int orow=crow(r,hi);
      #pragma unroll
      for(int d0=0;d0<2;++d0)stg[orow*64+d0*32+r32]=(bf16)cvtpk_s(o[d0][r]*rli[r],0.f);}
    asm volatile("s_waitcnt lgkmcnt(0)":::"memory");
    #pragma unroll
    for(int i=0;i<4;++i){const int row=i*8+(lane>>3),ch=lane&7; const u32x4 v=*(const u32x4*)(stg+row*64+ch*8); ATTN_STORE16(Ow+(long)row*OP+ch*8,v);} }
  asm volatile("s_waitcnt lgkmcnt(0)\n\ts_barrier":::"memory");
  #undef DMA_K
  #undef TMAP
  #undef PRE
  #undef DMA_V
  #undef CMASK
  #undef START
  #undef RESC
  #undef ROT
}
constexpr int ATTN_LDS_BYTES=LDS_BYTES;
#undef SBAR
#undef WAIT_BAR
}
constexpr int NWAVES = 8;
constexpr int DM = 1024, NBATCH = 4, SEQ = 4096, MP = NBATCH * SEQ, NS = 128, MT = MP + NS, MROWS = 16640, NPT = MROWS / 256, NPP = MP / 256, MEMR = 1024, AROWS = MROWS + MEMR;
constexpr int MIXW = 768, NG = 48, NST = 64, DFF = 2816, NKVH = 4, NQH = 12;
constexpr float EPS = 1e-6f;
constexpr float C2 = 0.125f * 1.4426950408889634f;
constexpr size_t OFF_Y = 0, OFF_PSR = 16908288, OFF_PSI = 16932864, OFF_PK = 16957440, OFF_PV = 21151744, OFF_PMK = 25346048, OFF_PMV = 26394624,
                 OFF_SSR = 27443200, OFF_SSI = 28229632, OFF_SK = 29016064, OFF_SV = 29048832, OUT_TOTAL = 29081600;
constexpr size_t MiB = 1u << 20;
constexpr size_t WS_CTL = 0, CTL_ZERO_BYTES = 1 * MiB;
constexpr size_t WS_WCAT0 = 2 * MiB, WS_WCAT1 = 8 * MiB, WS_WCAT2 = 10 * MiB, WS_WCAT3 = 13 * MiB;
constexpr size_t WS_WOUT = 15 * MiB;
constexpr size_t WS_WGLU = 23 * MiB, WGLU_STRIDE = 3 * MiB / 2;
constexpr size_t WS_WGU = 26 * MiB, WGU_STRIDE = 11 * MiB;
constexpr size_t WS_WDOWN = 70 * MiB, WDOWN_STRIDE = 11 * MiB / 2;
constexpr size_t WS_HB0 = 92 * MiB;
constexpr size_t WS_SSQ0 = 127 * MiB;
constexpr size_t WS_LAYER = 130 * MiB, LSTRIDE = 226 * MiB;
constexpr size_t LO_PROJ = 0, LO_MIXO = 33 * MiB, LO_HBA = 66 * MiB, LO_HBB = 99 * MiB, LO_FFH = 132 * MiB, LO_SSQA = 222 * MiB, LO_SSQB = 224 * MiB;
constexpr size_t WS_YBUF = 1034 * MiB, YBUF_STRIDE = 25 * MiB;
constexpr size_t WS_KVRAW = 1084 * MiB;
constexpr size_t WS_KBUF = 1117 * MiB, WS_VBUF = 1126 * MiB;
constexpr size_t WS_MEMKB = 1135 * MiB, WS_MEMVB = 1137 * MiB;
constexpr size_t WS_E = 1139 * MiB;
constexpr size_t WS_TAB = 1142 * MiB;
constexpr size_t WS_KMEANP = 1143 * MiB;
constexpr size_t WS_KMEANS = 1144 * MiB;
constexpr size_t WS_KMRAW = 1146 * MiB;
constexpr size_t WS_END = 1150 * MiB;
static_assert(WS_WCAT0 + 3072 * 2048 <= WS_WCAT1 && WS_WCAT2 + 1536 * 2048 <= WS_WCAT3 && WS_WGU + 4 * WGU_STRIDE <= WS_WDOWN && WS_WDOWN + 4 * WDOWN_STRIDE <= WS_HB0, "ws map (weights)");
static_assert(WS_HB0 + (size_t)AROWS * 2048 <= WS_SSQ0 && WS_SSQ0 + (size_t)AROWS * 64 <= WS_LAYER && WS_LAYER + 4 * LSTRIDE <= WS_YBUF && WS_YBUF + 2 * YBUF_STRIDE <= WS_KVRAW, "ws map (1)");
static_assert((size_t)MROWS * 2048 <= 33 * MiB && LO_FFH + (size_t)MROWS * 5632 <= LO_SSQA && LO_SSQA + (size_t)MROWS * 64 <= LO_SSQB && LO_SSQB + (size_t)MROWS * 64 <= LSTRIDE && (size_t)MROWS * 1536 <= YBUF_STRIDE, "ws map (layer)");
static_assert(WS_KVRAW + (size_t)MROWS * 2048 <= WS_KBUF && WS_KBUF + (size_t)MROWS * 512 <= WS_VBUF && WS_VBUF + (size_t)MROWS * 512 <= WS_MEMKB && WS_KMRAW + 4u * 1024 * 256 * 4 <= WS_END, "ws map (2)");
constexpr int CW_QUEUE = 131072;
#ifndef ND_FIRST
#define ND_FIRST 96
#endif
constexpr int CW_BAR = 4096;
constexpr int RING_BYTES = 131072, LDSCTL_OFF = RING_BYTES, MISC_OFF = LDSCTL_OFF + 320, LDS_BYTES = 147456;

#define GAS __attribute__((address_space(1)))
#define LAS __attribute__((address_space(3)))
typedef unsigned short bf16;
typedef unsigned v4u __attribute__((ext_vector_type(4)));
typedef float f32x4 __attribute__((ext_vector_type(4)));
typedef short bf16x8 __attribute__((ext_vector_type(8)));
typedef GAS unsigned gu32;
typedef GAS unsigned long long gu64;
#define RLX_AGENT __ATOMIC_RELAXED, __HIP_MEMORY_SCOPE_AGENT
#define LDS_WAIT() asm volatile("s_waitcnt lgkmcnt(0)" ::: "memory")
#define VM_WAIT() asm volatile("s_waitcnt vmcnt(0)" ::: "memory")
__device__ __forceinline__ unsigned long long rt() { return __builtin_amdgcn_s_memrealtime(); }
__device__ __forceinline__ unsigned f2bf(float f) { unsigned u = __builtin_bit_cast(unsigned, f); return (u + 0x7fffu + ((u >> 16) & 1u)) >> 16; }
__device__ __forceinline__ unsigned pk2(float lo, float hi) { return f2bf(lo) | (f2bf(hi) << 16); }

#define XB_TMO      128
#define XB_XCNT(j)  (256  + 64 * (j))
#define XB_XSUB(j)  (1280 + 64 * (j))
#define XB_XGEN(j)  (2304 + 64 * (j))
#define XB_TOP      3328
#define XB_TOPGEN   3392
#define XCD_BAR_WORDS 3456
#define XB_SPIN_CAP (1u << 18)

__device__ __forceinline__ unsigned xb_ld(unsigned* p)              { return __hip_atomic_load(p, __ATOMIC_RELAXED, __HIP_MEMORY_SCOPE_AGENT); }
__device__ __forceinline__ unsigned xb_add(unsigned* p, unsigned v) { return __hip_atomic_fetch_add(p, v, __ATOMIC_RELAXED, __HIP_MEMORY_SCOPE_AGENT); }
__device__ __forceinline__ unsigned xb_xcc_id() { return (unsigned)__builtin_amdgcn_s_getreg((3 << 11) | 20) & 0xFu; }
#define XB_SPIN(cond, bar) do { unsigned _sp = 0; while (cond) { __builtin_amdgcn_s_sleep(1); \
    if ((++_sp & 255u) == 0u) { if (xb_ld(&(bar)[XB_TMO])) break; if (_sp > XB_SPIN_CAP) { atomicAdd(&(bar)[XB_TMO], 1u); break; } } } } while (0)

struct XcdBarrier {
    unsigned* bar; unsigned x;
    volatile LAS unsigned* st;
};

__device__ __forceinline__ XcdBarrier xcd_barrier_post(unsigned* bar, volatile LAS unsigned* st) {
    XcdBarrier b; b.bar = bar; b.x = xb_xcc_id(); b.st = st;
    if (threadIdx.x == 0) (void)xb_add(&bar[XB_XCNT(b.x)], 1u);
    return b;
}
__device__ __forceinline__ void xcd_barrier_complete(unsigned* bar, unsigned x, unsigned& nloc, unsigned& nx) {
    const unsigned G = gridDim.x * gridDim.y * gridDim.z;
    unsigned sum, cnt, mine, sp = 0u;
    for (;;) {
        sum = 0u; cnt = 0u; mine = 0u;
#pragma unroll
        for (unsigned j = 0; j < 16; ++j) { const unsigned c = xb_ld(&bar[XB_XCNT(j)]); sum += c; cnt += (c > 0u) ? 1u : 0u; mine = (j == x) ? c : mine; }
        if (sum == G) break;
        __builtin_amdgcn_s_sleep(1);
        if ((++sp & 255u) == 0u) { if (xb_ld(&bar[XB_TMO])) break; if (sp > XB_SPIN_CAP) { atomicAdd(&bar[XB_TMO], 1u); break; } }
    }
    nloc = mine > 0u ? mine : 1u; nx = cnt > 0u ? cnt : 1u;
}

__device__ __forceinline__ void xcd_barrier(const XcdBarrier& b) {
    asm volatile("s_waitcnt vmcnt(0)" ::: "memory");
    __syncthreads();
    if (threadIdx.x == 0) {
        unsigned* bar = b.bar;
        __builtin_amdgcn_s_waitcnt(0);
        unsigned nloc = b.st[0], nx = b.st[1];
        if (nloc == 0u) { xcd_barrier_complete(bar, b.x, nloc, nx); b.st[0] = nloc; b.st[1] = nx; }
        const unsigned old = xb_add(&bar[XB_XSUB(b.x)], 1u);
        const unsigned gen = old / nloc;
        if (old + 1u == (gen + 1u) * nloc) {
            __builtin_amdgcn_fence(__ATOMIC_RELEASE, "agent");
            asm volatile("s_waitcnt vmcnt(0)" ::: "memory");
            const unsigned og = xb_add(&bar[XB_TOP], 1u);
            const unsigned tg = og / nx;
            __builtin_amdgcn_fence(__ATOMIC_ACQUIRE, "agent");
            if (og + 1u == (tg + 1u) * nx) xb_add(&bar[XB_TOPGEN], 1u);
            else XB_SPIN(xb_ld(&bar[XB_TOPGEN]) == tg, bar);
            xb_add(&bar[XB_XGEN(b.x)], 1u);
            asm volatile("s_waitcnt vmcnt(0)" ::: "memory");
        } else {
            __builtin_amdgcn_fence(__ATOMIC_ACQUIRE, "agent");
            XB_SPIN(xb_ld(&bar[XB_XGEN(b.x)]) == gen, bar);
            asm volatile("s_waitcnt vmcnt(0)" ::: "memory");
        }
    }
    __syncthreads();
}

typedef float f32x16 __attribute__((ext_vector_type(16)));
typedef unsigned u32x2 __attribute__((ext_vector_type(2)));
struct Args { const void* in[33]; float* out; unsigned char* ws; int ph_lo, ph_hi, li, pad; };
struct Frame {
    LAS unsigned char* lds; volatile LAS unsigned* MISC; gu32* ctl; const __attribute__((address_space(4))) Args* ap;
    int tid, lane, wave, vcu, G;
    __device__ __forceinline__ int otid() const { int t = threadIdx.x; asm volatile("" : "+v"(t)); return t; }
    __device__ __forceinline__ const __attribute__((address_space(4))) Args* A() const { const __attribute__((address_space(4))) Args* p = ap; asm volatile("" : "+s"(p)); return p; }
    __device__ __forceinline__ unsigned char* wsb() const { return A()->ws; }
    __device__ __forceinline__ float* out() const { return A()->out; }
#define FIN(name, idx, T) __device__ __forceinline__ const T* name() const { return (const T*)A()->in[idx]; }
    FIN(x_prompt, 0, float) FIN(x_sample, 1, float) FIN(mem_prompt, 2, float) FIN(st_re, 3, float) FIN(st_im, 4, float) FIN(cache_k, 5, float) FIN(cache_v, 6, float) FIN(page_table, 7, int) FIN(cache_mem_k, 8, float) FIN(cache_mem_v, 9, float)
    FIN(g_mix, 10, float) FIN(w_in, 11, float) FIN(w_out, 12, float) FIN(g_ffn, 13, float) FIN(w_gu, 14, float) FIN(w_down, 15, float) FIN(ssm_a_re, 16, float) FIN(ssm_a_im, 17, float) FIN(ssm_log_dt, 18, float) FIN(ssm_b_re, 19, float)
    FIN(ssm_b_im, 20, float) FIN(ssm_c_re, 21, float) FIN(ssm_c_im, 22, float) FIN(ssm_d, 23, float) FIN(w_glu, 24, float) FIN(g_q, 25, float) FIN(g_mq, 26, float) FIN(g_mem, 27, float) FIN(w_mem_kv, 28, float) FIN(g_mk, 29, float)
    FIN(g_kv, 30, float) FIN(w_kv, 31, float) FIN(g_k, 32, float)
#undef FIN
#define FWS(name, off, T) __device__ __forceinline__ T* name() const { return (T*)(wsb() + (off)); }
    FWS(hb0, WS_HB0, bf16) FWS(ssq0, WS_SSQ0, float) FWS(kvraw, WS_KVRAW, float) FWS(kbuf, WS_KBUF, bf16) FWS(vbuf, WS_VBUF, bf16)
    FWS(memkb, WS_MEMKB, bf16) FWS(memvb, WS_MEMVB, bf16) FWS(tab, WS_TAB, f32x4) FWS(kmeanp, WS_KMEANP, bf16) FWS(kmeans, WS_KMEANS, float) FWS(kmraw, WS_KMRAW, float)
#define FWL(name, off, T) __device__ __forceinline__ T* name(int l) const { return (T*)(wsb() + WS_LAYER + (size_t)l * LSTRIDE + (off)); }
    FWL(proj, LO_PROJ, bf16) FWL(mixo, LO_MIXO, bf16) FWL(hba, LO_HBA, bf16) FWL(hbb, LO_HBB, bf16) FWL(ffh, LO_FFH, bf16) FWL(ssqa, LO_SSQA, float) FWL(ssqb, LO_SSQB, float)
#undef FWL
    __device__ __forceinline__ bf16* ybuf(int l) const { return (bf16*)(wsb() + WS_YBUF + (size_t)l * YBUF_STRIDE); }
#undef FWS
};
__device__ __forceinline__ bf16* wcat(const Frame& F, int l) { return (bf16*)(F.wsb() + (l == 0 ? WS_WCAT0 : l == 1 ? WS_WCAT1 : l == 2 ? WS_WCAT2 : WS_WCAT3)); }
__device__ __forceinline__ float wave_sum(float v) {
#pragma unroll
    for (int o = 1; o < 64; o <<= 1) v += __shfl_xor(v, o);
    return v;
}
__device__ __forceinline__ float wave_max(float v) {
#pragma unroll
    for (int o = 1; o < 64; o <<= 1) v = fmaxf(v, __shfl_xor(v, o));
    return v;
}
__device__ __forceinline__ float sum16(float v) { v += __shfl_xor(v, 1); v += __shfl_xor(v, 2); v += __shfl_xor(v, 4); v += __shfl_xor(v, 8); return v; }
__device__ __forceinline__ float wave_sum_dpp(float v) {
    v += __builtin_bit_cast(float, __builtin_amdgcn_update_dpp(0, __builtin_bit_cast(int, v), 0x111, 0xf, 0xf, true));
    v += __builtin_bit_cast(float, __builtin_amdgcn_update_dpp(0, __builtin_bit_cast(int, v), 0x112, 0xf, 0xf, true));
    v += __builtin_bit_cast(float, __builtin_amdgcn_update_dpp(0, __builtin_bit_cast(int, v), 0x114, 0xf, 0xf, true));
    v += __builtin_bit_cast(float, __builtin_amdgcn_update_dpp(0, __builtin_bit_cast(int, v), 0x118, 0xf, 0xf, true));
    v += __builtin_bit_cast(float, __builtin_amdgcn_update_dpp(0, __builtin_bit_cast(int, v), 0x142, 0xa, 0xf, false));
    v += __builtin_bit_cast(float, __builtin_amdgcn_update_dpp(0, __builtin_bit_cast(int, v), 0x143, 0xc, 0xf, false));
    return __builtin_bit_cast(float, __builtin_amdgcn_readlane(__builtin_bit_cast(int, v), 63));
}
__device__ __forceinline__ float bflo(unsigned w) { return __builtin_bit_cast(float, w << 16); }
__device__ __forceinline__ float bfhi(unsigned w) { return __builtin_bit_cast(float, w & 0xffff0000u); }
__device__ __forceinline__ unsigned cvtpk(float lo, float hi) { return pg8::cvt_pk_bf16(lo, hi); }
typedef float f32x2q __attribute__((ext_vector_type(2)));
__device__ __forceinline__ f32x2q gelu_tanh2(f32x2q y) {
    const float k0 = -2.0f * 1.4426950408889634f * 0.7978845608028654f, k1 = k0 * 0.044715f;
    const f32x2q t = y * ((y * y) * k1 + k0); f32x2q a; a.x = __builtin_amdgcn_exp2f(t.x); a.y = __builtin_amdgcn_exp2f(t.y); a = a + 1.0f;
    f32x2q s; s.x = __builtin_amdgcn_rcpf(a.x); s.y = __builtin_amdgcn_rcpf(a.y); return y * s;
}
__device__ __forceinline__ float gelu_tanh(float y) {
    const float z = 0.7978845608028654f * (y + 0.044715f * y * y * y);
    return y * __builtin_amdgcn_rcpf(1.0f + __builtin_amdgcn_exp2f(-2.0f * 1.4426950408889634f * z));
}

__device__ __forceinline__ void tr_item(const float* W, int K, int N, const float* gain, bf16* WT, int R0, int k0, int n0, LAS float* scr, int lane) {
    float wv[32];
#pragma unroll
    for (int i = 0; i < 32; ++i) wv[i] = W[(size_t)(k0 + 2 * i + (lane >> 5)) * N + n0 + (lane & 31)];
    if (gain) {
#pragma unroll
        for (int i = 0; i < 32; ++i) wv[i] *= gain[k0 + 2 * i + (lane >> 5)]; }
#pragma unroll
    for (int i = 0; i < 32; ++i) scr[(2 * i + (lane >> 5)) * 33 + (lane & 31)] = wv[i];
    LDS_WAIT(); asm volatile("" ::: "memory");
    const int c = lane & 7;
#pragma unroll
    for (int j = 0; j < 4; ++j) { const int n = (lane >> 3) + 8 * j; const LAS float* s = scr + (8 * c) * 33 + n;
        v4u o; o.x = pk2(s[0 * 33], s[1 * 33]); o.y = pk2(s[2 * 33], s[3 * 33]); o.z = pk2(s[4 * 33], s[5 * 33]); o.w = pk2(s[6 * 33], s[7 * 33]);
        *(GAS v4u*)(WT + (size_t)(R0 + n) * K + k0 + 8 * c) = o; }
    LDS_WAIT(); asm volatile("" ::: "memory");
}
__device__ __forceinline__ double dexp_small(double x) {
    const double k = __builtin_rint(x * 1.4426950408889634); const double r = __builtin_fma(-k, 0.6931471805599453, x) - k * 2.3190468138462996e-17;
    double s = 1.0;
#pragma unroll
    for (int n = 14; n >= 1; --n) s = 1.0 + s * r * (1.0 / n);
    const long long ki = (long long)k; return s * __builtin_bit_cast(double, (ki + 1023) << 52);
}
__device__ __forceinline__ void dsincos(double x, double& sn, double& cs) {
    const double k = __builtin_rint(x * 0.15915494309189535); double r = __builtin_fma(-k, 6.283185307179586, x); r = __builtin_fma(-k, 2.4492935982947064e-16, r);
    const double y = 0.25 * r, y2 = y * y;
    double s = 1.0, c = 1.0;
#pragma unroll
    for (int n = 8; n >= 1; --n) { s = 1.0 - s * y2 * (1.0 / ((2 * n) * (2 * n + 1))); c = 1.0 - c * y2 * (1.0 / ((2 * n - 1) * (2 * n))); }
    s *= y;
    const double s2 = 2.0 * s * c, c2 = 1.0 - 2.0 * s * s;
    sn = 2.0 * s2 * c2; cs = 1.0 - 2.0 * s2 * s2;
}
constexpr int IT_IN = 512, IT_OUT = 512, IT_GU = 2816, IT_DN = 1408, IT_L = IT_IN + IT_OUT + IT_GU + IT_DN, IT_GLU = 288, IT_KV = 256, IT_MKV = 256;
constexpr int IT_TOTAL = 4 * IT_L + 2 * IT_GLU + IT_KV + 4 * IT_MKV;
constexpr int IT_FIRST_LO = 4 * IT_L + 2 * IT_GLU + IT_KV;
__device__ __forceinline__ void convert_items(const Frame& F, int it_lo, int it_hi, int widx, int nw) {
    LAS float* scr = (LAS float*)(F.lds + F.wave * 8448); const int lane = F.otid() & 63;
    for (int it = it_lo + widx; it < it_hi; it += nw) {
        const float* W; const float* gain = nullptr; bf16* WT; int K, N, r, mode = 0;
        if (it < 4 * IT_L) { const int l = it / IT_L; r = it % IT_L;
            if (r < IT_IN) { W = F.w_in() + (size_t)l * 1048576; K = 1024; N = 1024; gain = F.g_mix() + l * 1024; WT = wcat(F, l); }
            else if ((r -= IT_IN) < IT_OUT) { W = F.w_out() + (size_t)l * 1048576; K = 1024; N = 1024; WT = (bf16*)(F.wsb() + WS_WOUT + (size_t)l * 2 * MiB); }
            else if ((r -= IT_OUT) < IT_GU) { W = F.w_gu() + (size_t)l * 1024 * 5632; K = 1024; N = 5632; gain = F.g_ffn() + l * 1024; WT = (bf16*)(F.wsb() + WS_WGU + (size_t)l * WGU_STRIDE); mode = 1; }
            else { r -= IT_GU; W = F.w_down() + (size_t)l * 2816 * 1024; K = 2816; N = 1024; WT = (bf16*)(F.wsb() + WS_WDOWN + (size_t)l * WDOWN_STRIDE); }
        } else { r = it - 4 * IT_L;
            if (r < 2 * IT_GLU) { const int l = r / IT_GLU; r %= IT_GLU; W = F.w_glu() + (size_t)l * 768 * 768; K = 768; N = 768; WT = (bf16*)(F.wsb() + WS_WGLU + (size_t)l * WGLU_STRIDE); }
            else if ((r -= 2 * IT_GLU) < IT_KV) { W = F.w_kv(); K = 1024; N = 512; gain = F.g_kv(); WT = wcat(F, 2) + (size_t)1024 * 1024; }
            else { r -= IT_KV; const int L = r / IT_MKV; r %= IT_MKV; W = F.w_mem_kv() + (size_t)L * 1024 * 512; K = 1024; N = 512; gain = F.g_mem() + L * 1024; WT = wcat(F, 0) + (size_t)(1024 + 512 * L) * 1024; }
        }
        const int nblk = N / 32, kb = r / nblk, nb = r % nblk, k0 = 64 * kb, n0 = 32 * nb;
        int R0 = n0;
        if (mode == 1) { const int j0 = n0 < DFF ? n0 : n0 - DFF; R0 = 256 * (j0 >> 7) + (j0 & 127) + (n0 < DFF ? 0 : 128); }
        tr_item(W, K, N, gain, WT, R0, k0, n0, scr, lane);
    }
}
__device__ __forceinline__ void p0_prologue(Frame& F) {
    const int gw = F.vcu * NWAVES + F.wave, NGW = F.G * NWAVES, lane = F.otid() & 63;
    convert_items(F, 0, IT_TOTAL, gw, NGW);
    for (int m = gw; m < AROWS; m += NGW) {
        const float* src = m < MP ? F.x_prompt() + (size_t)m * DM : m < MT ? F.x_sample() + (size_t)(m - MP) * DM : m < MROWS ? nullptr : F.mem_prompt() + (size_t)(m - MROWS) * DM;
        f32x4 v[4]; float s = 0.f;
#pragma unroll
        for (int j = 0; j < 4; ++j) { v[j] = src ? *((const GAS f32x4*)src + lane + 64 * j) : (f32x4){0.f, 0.f, 0.f, 0.f}; s += (v[j].x * v[j].x + v[j].y * v[j].y) + (v[j].z * v[j].z + v[j].w * v[j].w); }
        s = wave_sum(s);
#pragma unroll
        for (int j = 0; j < 4; ++j) {
            u32x2 w; w.x = pk2(v[j].x, v[j].y); w.y = pk2(v[j].z, v[j].w); *((GAS u32x2*)(F.hb0() + (size_t)m * DM) + lane + 64 * j) = w; }
        if (lane < 16) F.ssq0()[(size_t)m * 16 + lane] = lane == 0 ? s : 0.f;
    }
    for (int e = blockIdx.x * (NWAVES * 64) + F.tid; e < 2 * NG * NST; e += F.G * NWAVES * 64) {
        const int lg = e / NST;
        const double dt = dexp_small((double)F.ssm_log_dt()[lg]);
        const double lre = fmin((double)F.ssm_a_re()[e], -1e-4), lim = (double)F.ssm_a_im()[e];
        const double mag = dexp_small(dt * lre); double sn, cs; dsincos(dt * lim, sn, cs);
        const double are = mag * cs, aim = mag * sn, den = lre * lre + lim * lim, nre = are - 1.0;
        const double fre = (nre * lre + aim * lim) / den, fim = (aim * lre - nre * lim) / den;
        F.tab()[e] = (f32x4){(float)are, (float)aim, (float)fre, (float)fim};
    }
}
__device__ __forceinline__ void sample_kmeans(const Frame& F, int it0, int it1, int sh, int nsh) {
    LAS float* red = (LAS float*)F.lds; const int tid = F.otid(), c4 = tid & 63, rgp = tid >> 6;
    for (int it = it0 + sh; it < it1; it += nsh) { const int s = it >> 3, blk = it & 7;
        const int pg0 = F.page_table()[s * 16 + 2 * blk], pg1 = F.page_table()[s * 16 + 2 * blk + 1];
        const float* p0 = F.cache_k() + ((size_t)pg0 * 128 + rgp) * 256 + 4 * c4; const float* p1 = F.cache_k() + ((size_t)pg1 * 128 + rgp) * 256 + 4 * c4;
        f32x4 va[16], vb[16];
#pragma unroll
        for (int i = 0; i < 16; ++i) { va[i] = *(const f32x4*)(p0 + (size_t)i * 8 * 256); vb[i] = *(const f32x4*)(p1 + (size_t)i * 8 * 256); }
        f32x4 a = (f32x4){0.f, 0.f, 0.f, 0.f};
#pragma unroll
        for (int i = 0; i < 16; ++i) a += va[i] + vb[i];
        __syncthreads();
        *(LAS f32x4*)(red + rgp * 256 + 4 * c4) = a;
        __syncthreads();
        if (tid < 256) { float t = 0.f;
#pragma unroll
            for (int w = 0; w < 8; ++w) t += red[w * 256 + tid];
            F.kmeans()[(size_t)it * 256 + tid] = t * (1.0f / 256.0f); } }
    __syncthreads();
}

__device__ __forceinline__ bf16x8 pack8(const float (&v)[8]) { v4u w; w.x = cvtpk(v[0], v[1]); w.y = cvtpk(v[2], v[3]); w.z = cvtpk(v[4], v[5]); w.w = cvtpk(v[6], v[7]); return __builtin_bit_cast(bf16x8, w); }
constexpr int XS_ROW = 272, XS_CH = 16 * XS_ROW, XS_WAVE = 2 * XS_CH;
template <bool PC>
__device__ __forceinline__ void s5_item(const Frame& F, int l, int b, int g, int cp, LAS unsigned char* xs, LAS float* elds) {
    const int lane = F.otid() & 63, j = lane & 31, hi = lane >> 5, lg = l * NG + g;
    const f32x4 t0 = F.tab()[lg * NST + j], t1 = F.tab()[lg * NST + j + 32];
    bf16x8 Bop[4];
#pragma unroll
    for (int s = 0; s < 2; ++s) { const f32x4 tt = s ? t1 : t0; const int p = j + 32 * s;
        const float* br = F.ssm_b_re() + ((size_t)lg * NST + p) * 16 + 8 * hi; const float* bi = F.ssm_b_im() + ((size_t)lg * NST + p) * 16 + 8 * hi;
        const f32x4 r0 = *(const f32x4*)br, r1 = *(const f32x4*)(br + 4), i0 = *(const f32x4*)bi, i1 = *(const f32x4*)(bi + 4);
        float re[8], im[8];
#pragma unroll
        for (int e = 0; e < 4; ++e) { re[e] = tt[2] * r0[e] - tt[3] * i0[e]; im[e] = tt[2] * i0[e] + tt[3] * r0[e]; re[4 + e] = tt[2] * r1[e] - tt[3] * i1[e]; im[4 + e] = tt[2] * i1[e] + tt[3] * r1[e]; }
        Bop[2 * s] = pack8(re); Bop[2 * s + 1] = pack8(im); }
    const int hh = (j >> 2) & 1, rr0 = (j & 3) + 4 * (j >> 3);
    const bf16* ap = F.proj(l) + ((size_t)(b * SEQ + (cp + 8 * hh) * 256 + rr0)) * DM + 16 * g + 8 * hi;
    const float a0r = t0[0], a0i = t0[1], a1r = t1[0], a1i = t1[1];
    float x0r = 0.f, x0i = 0.f, x1r = 0.f, x1i = 0.f;
    const int c = cp + 8 * hi;
    bf16x8 Cop[4]; f32x4 dsk; const int hq = lane >> 4, tk = lane & 15;
    if (PC) {
        float p0r = a0r, p0i = a0i, p1r = a1r, p1i = a1i;
#pragma unroll
        for (int q = 0; q < 8; ++q) { const float n0r = p0r * p0r - p0i * p0i, n0i = 2.f * p0r * p0i, n1r = p1r * p1r - p1i * p1i, n1i = 2.f * p1r * p1i; p0r = n0r; p0i = n0i; p1r = n1r; p1i = n1i; }
        { typedef float f32x2e __attribute__((ext_vector_type(2))); f32x2e ea[15], eb[15];
          const LAS f32x2e* e = (const LAS f32x2e*)elds;
#pragma unroll
          for (int cc = 0; cc < 15; ++cc) { ea[cc] = (f32x2e){0.f, 0.f}; eb[cc] = (f32x2e){0.f, 0.f}; if (cc < c) { ea[cc] = e[cc * NST + j]; eb[cc] = e[cc * NST + j + 32]; } }
#pragma unroll
          for (int cc = 0; cc < 15; ++cc) { if (cc < c) {
            const float n0r = p0r * x0r - p0i * x0i + ea[cc].x, n0i = p0r * x0i + p0i * x0r + ea[cc].y, n1r = p1r * x1r - p1i * x1i + eb[cc].x, n1i = p1r * x1i + p1i * x1r + eb[cc].y; x0r = n0r; x0i = n0i; x1r = n1r; x1i = n1i; } } }
#pragma unroll
        for (int kk = 0; kk < 4; ++kk) { const f32x4 cr = *(const f32x4*)(F.ssm_c_re() + ((size_t)lg * 16 + tk) * NST + 16 * kk + 4 * hq), ci = *(const f32x4*)(F.ssm_c_im() + ((size_t)lg * 16 + tk) * NST + 16 * kk + 4 * hq);
            const float cv[8] = {cr[0], -ci[0], cr[1], -ci[1], cr[2], -ci[2], cr[3], -ci[3]}; Cop[kk] = pack8(cv); }
        dsk = *(const f32x4*)(F.ssm_d() + (size_t)lg * 16 + 4 * hq);
    }
    constexpr int PD = 3;
    bf16x8 a_q[PD];
#pragma unroll
    for (int d = 0; d < PD; ++d) a_q[d] = *(const bf16x8*)(ap + (size_t)d * 16 * DM);
    const bf16* up0 = F.proj(l) + ((size_t)(b * SEQ + cp * 256 + tk)) * DM + 16 * g + 4 * hq;
    u32x2 u_q[PD][2];
    if (PC) {
#pragma unroll
        for (int d = 0; d < PD; ++d) { u_q[d][0] = *(const u32x2*)(up0 + (size_t)d * 16 * DM); u_q[d][1] = *(const u32x2*)(up0 + (size_t)(8 * 256 + d * 16) * DM); } }
    bf16* const ybp = F.ybuf(l) + (size_t)(b * SEQ + cp * 256 + tk) * MIXW + 16 * g + 4 * hq;
    for (int st = 0; st < 16; ++st) {
        const bf16x8 a = a_q[0]; const int sp = (st + PD < 16) ? st + PD : 15;
#pragma unroll
        for (int d = 0; d + 1 < PD; ++d) a_q[d] = a_q[d + 1];
        a_q[PD - 1] = *(const bf16x8*)(ap + (size_t)sp * 16 * DM);
        u32x2 u_cur[2];
        if (PC) { u_cur[0] = u_q[0][0]; u_cur[1] = u_q[0][1];
#pragma unroll
            for (int d = 0; d + 1 < PD; ++d) { u_q[d][0] = u_q[d + 1][0]; u_q[d][1] = u_q[d + 1][1]; }
            u_q[PD - 1][0] = *(const u32x2*)(up0 + (size_t)sp * 16 * DM); u_q[PD - 1][1] = *(const u32x2*)(up0 + (size_t)(8 * 256 + sp * 16) * DM); }
        const f32x16 z = {};
        const f32x16 br0 = __builtin_amdgcn_mfma_f32_32x32x16_bf16(a, Bop[0], z, 0, 0, 0), bi0 = __builtin_amdgcn_mfma_f32_32x32x16_bf16(a, Bop[1], z, 0, 0, 0);
        const f32x16 br1 = __builtin_amdgcn_mfma_f32_32x32x16_bf16(a, Bop[2], z, 0, 0, 0), bi1 = __builtin_amdgcn_mfma_f32_32x32x16_bf16(a, Bop[3], z, 0, 0, 0);
#pragma unroll
        for (int r = 0; r < 16; ++r) {
            const float n0r = __builtin_fmaf(a0r, x0r, __builtin_fmaf(-a0i, x0i, br0[r])), n0i = __builtin_fmaf(a0r, x0i, __builtin_fmaf(a0i, x0r, bi0[r]));
            const float n1r = __builtin_fmaf(a1r, x1r, __builtin_fmaf(-a1i, x1i, br1[r])), n1i = __builtin_fmaf(a1r, x1i, __builtin_fmaf(a1i, x1r, bi1[r]));
            x0r = n0r; x0i = n0i; x1r = n1r; x1i = n1i;
            if (PC) { LAS unsigned* xr = (LAS unsigned*)(xs + hi * XS_CH + r * XS_ROW); xr[j] = cvtpk(x0r, x0i); xr[j + 32] = cvtpk(x1r, x1i); }
        }
        if (PC) {
#pragma unroll
            for (int h2 = 0; h2 < 2; ++h2) {
                f32x4 ya = (f32x4){0.f, 0.f, 0.f, 0.f};
#pragma unroll
                for (int kk = 0; kk < 4; ++kk) { const bf16x8 xb = *(const LAS bf16x8*)(xs + h2 * XS_CH + tk * XS_ROW + kk * 64 + hq * 16); ya = __builtin_amdgcn_mfma_f32_16x16x32_bf16(Cop[kk], xb, ya, 0, 0, 0); }
                const size_t tok = (size_t)(b * SEQ + (cp + 8 * h2) * 256 + st * 16 + tk);
                const u32x2 uw = u_cur[h2];
                const f32x2q g01 = gelu_tanh2((f32x2q){ya[0] + dsk[0] * bflo(uw.x), ya[1] + dsk[1] * bfhi(uw.x)}), g23 = gelu_tanh2((f32x2q){ya[2] + dsk[2] * bflo(uw.y), ya[3] + dsk[3] * bfhi(uw.y)});
                u32x2 ow; ow.x = cvtpk(g01.x, g01.y); ow.y = cvtpk(g23.x, g23.y); *(u32x2*)(ybp + (size_t)(h2 * 8 * 256 + st * 16) * MIXW) = ow;
            }
        }
    }
    if (!PC) { LAS float* e = elds + (size_t)c * NST * 2; e[2 * j] = x0r; e[2 * j + 1] = x0i; e[2 * (j + 32)] = x1r; e[2 * (j + 32) + 1] = x1i; }
    else if (c == 15) { const size_t o = ((size_t)(l * NBATCH + b) * NG + g) * NST; F.out()[OFF_PSR + o + j] = x0r; F.out()[OFF_PSI + o + j] = x0i; F.out()[OFF_PSR + o + j + 32] = x1r; F.out()[OFF_PSI + o + j + 32] = x1i; }
}
__device__ __forceinline__ void s5_sample(const Frame& F, int l, int s, int g) {
    const int p = F.otid() & 63, lg = l * NG + g; const size_t row = MP + s;
    const f32x4 tt = F.tab()[lg * NST + p];
    const v4u ua = *(const v4u*)(F.proj(l) + row * DM + 16 * g), ub = *(const v4u*)(F.proj(l) + row * DM + 16 * g + 8);
    const float u[16] = {bflo(ua.x), bfhi(ua.x), bflo(ua.y), bfhi(ua.y), bflo(ua.z), bfhi(ua.z), bflo(ua.w), bfhi(ua.w), bflo(ub.x), bfhi(ub.x), bflo(ub.y), bfhi(ub.y), bflo(ub.z), bfhi(ub.z), bflo(ub.w), bfhi(ub.w)};
    const float* br = F.ssm_b_re() + ((size_t)lg * NST + p) * 16; const float* bi = F.ssm_b_im() + ((size_t)lg * NST + p) * 16;
    float sr = 0.f, si = 0.f;
#pragma unroll
    for (int q = 0; q < 4; ++q) { const f32x4 r4 = *(const f32x4*)(br + 4 * q), i4 = *(const f32x4*)(bi + 4 * q);
#pragma unroll
        for (int e = 0; e < 4; ++e) { sr += r4[e] * u[4 * q + e]; si += i4[e] * u[4 * q + e]; } }
    const float bur = tt[2] * sr - tt[3] * si, bui = tt[2] * si + tt[3] * sr;
    const size_t so = ((size_t)(l * NS + s) * NG + g) * NST + p;
    const float h0r = F.st_re()[so], h0i = F.st_im()[so];
    const float xr = tt[0] * h0r - tt[1] * h0i + bur, xi = tt[0] * h0i + tt[1] * h0r + bui;
    F.out()[OFF_SSR + so] = xr; F.out()[OFF_SSI + so] = xi;
    float my = 0.f;
    { float cr[16], ci[16];
#pragma unroll
      for (int hh = 0; hh < 16; ++hh) { cr[hh] = F.ssm_c_re()[((size_t)lg * 16 + hh) * NST + p]; ci[hh] = F.ssm_c_im()[((size_t)lg * 16 + hh) * NST + p]; }
      const float dsk = p < 16 ? F.ssm_d()[lg * 16 + p] : 0.f;
#pragma unroll
      for (int hh = 0; hh < 16; ++hh) { const float tv = wave_sum_dpp(cr[hh] * xr - ci[hh] * xi); if (p == hh) my = tv + dsk * u[hh]; } }
    if (p < 16) F.ybuf(l)[row * MIXW + 16 * g + p] = (bf16)cvtpk(gelu_tanh(my), 0.f);
}
__device__ __forceinline__ void s5_sample3(const Frame& F, int l, int g, int s0) {
    const int p = F.otid() & 63, lg = l * NG + g;
    const f32x4 tt = F.tab()[lg * NST + p];
    const float* br = F.ssm_b_re() + ((size_t)lg * NST + p) * 16; const float* bi = F.ssm_b_im() + ((size_t)lg * NST + p) * 16;
    f32x4 r4[4], i4[4];
#pragma unroll
    for (int q = 0; q < 4; ++q) { r4[q] = *(const f32x4*)(br + 4 * q); i4[q] = *(const f32x4*)(bi + 4 * q); }
    v4u ua[3], ub[3]; float h0r[3], h0i[3];
    { const bf16* const pj = F.proj(l); const float* const sre = F.st_re(); const float* const sim = F.st_im();
#pragma unroll
      for (int k = 0; k < 3; ++k) { const int s = s0 + 42 * k; const size_t row = MP + s, so = ((size_t)(l * NS + s) * NG + g) * NST + p;
        ua[k] = *(const v4u*)(pj + row * DM + 16 * g); ub[k] = *(const v4u*)(pj + row * DM + 16 * g + 8); h0r[k] = sre[so]; h0i[k] = sim[so]; } }
    float cr[16], ci[16];
    { const float* ccr = F.ssm_c_re() + (size_t)lg * 16 * NST + p; const float* cci = F.ssm_c_im() + (size_t)lg * 16 * NST + p;
#pragma unroll
      for (int hh = 0; hh < 16; ++hh) { cr[hh] = ccr[hh * NST]; ci[hh] = cci[hh * NST]; } }
    const float dsk = p < 16 ? F.ssm_d()[lg * 16 + p] : 0.f;
    float* const outp = F.out(); bf16* const ybp = F.ybuf(l);
#pragma unroll
    for (int k = 0; k < 3; ++k) { const int s = s0 + 42 * k; const size_t row = MP + s, so = ((size_t)(l * NS + s) * NG + g) * NST + p;
        const float u[16] = {bflo(ua[k].x), bfhi(ua[k].x), bflo(ua[k].y), bfhi(ua[k].y), bflo(ua[k].z), bfhi(ua[k].z), bflo(ua[k].w), bfhi(ua[k].w), bflo(ub[k].x), bfhi(ub[k].x), bflo(ub[k].y), bfhi(ub[k].y), bflo(ub[k].z), bfhi(ub[k].z), bflo(ub[k].w), bfhi(ub[k].w)};
        float sr = 0.f, si = 0.f;
#pragma unroll
        for (int q = 0; q < 4; ++q)
#pragma unroll
            for (int e = 0; e < 4; ++e) { sr += r4[q][e] * u[4 * q + e]; si += i4[q][e] * u[4 * q + e]; }
        const float bur = tt[2] * sr - tt[3] * si, bui = tt[2] * si + tt[3] * sr;
        const float xr = tt[0] * h0r[k] - tt[1] * h0i[k] + bur, xi = tt[0] * h0i[k] + tt[1] * h0r[k] + bui;
        outp[OFF_SSR + so] = xr; outp[OFF_SSI + so] = xi;
        float my = 0.f;
#pragma unroll
        for (int hh = 0; hh < 16; ++hh) { const float tv = wave_sum_dpp(cr[hh] * xr - ci[hh] * xi); if (p == hh) my = tv + dsk * u[hh]; }
        if (p < 16) ybp[row * MIXW + 16 * g + p] = (bf16)cvtpk(gelu_tanh(my), 0.f); }
}

__device__ __forceinline__ void memkv_norm(const Frame& F) {
    const int gw = F.vcu * NWAVES + F.wave, NGW = F.G * NWAVES, lane = F.otid() & 63;
    for (int it0 = gw; it0 < 4 * MEMR; it0 += 2 * NGW) {
        f32x4 k[2], v[2], gk[2];
#pragma unroll
        for (int r = 0; r < 2; ++r) { const int it = it0 + r * NGW < 4 * MEMR ? it0 + r * NGW : it0, L = it / MEMR;
            k[r] = *(const f32x4*)(F.kmraw() + (size_t)it * 256 + 4 * lane); v[r] = *(const f32x4*)(F.out() + OFF_PMV + (size_t)it * 256 + 4 * lane); gk[r] = *(const f32x4*)(F.g_mk() + L * 64 + ((4 * lane) & 63)); }
#pragma unroll
        for (int r = 0; r < 2; ++r) { const int it = it0 + r * NGW; if (it < 4 * MEMR) {
            const float ss = sum16((k[r][0] * k[r][0] + k[r][1] * k[r][1]) + (k[r][2] * k[r][2] + k[r][3] * k[r][3])); const float rs = __builtin_amdgcn_rsqf(ss * (1.0f / 64.0f) + EPS);
            const f32x4 kn = k[r] * rs * gk[r]; *(f32x4*)(F.out() + OFF_PMK + (size_t)it * 256 + 4 * lane) = kn;
            u32x2 w; w.x = cvtpk(kn[0], kn[1]); w.y = cvtpk(kn[2], kn[3]); *(u32x2*)(F.memkb() + (size_t)it * 256 + 4 * lane) = w;
            w.x = cvtpk(v[r][0], v[r][1]); w.y = cvtpk(v[r][2], v[r][3]); *(u32x2*)(F.memvb() + (size_t)it * 256 + 4 * lane) = w; } }
    }
}
__device__ __forceinline__ void kv_norm(const Frame& F) {
    LAS float* red = (LAS float*)F.lds; const int lane = F.otid() & 63, wave = F.wave;
    const f32x4 gk = *(const f32x4*)(F.g_k() + ((4 * lane) & 63));
    const float* const kvr = F.kvraw(); float* const outp = F.out(); bf16* const kbp = F.kbuf(); bf16* const vbp = F.vbuf();
    for (int it2 = F.vcu; it2 < 256; it2 += F.G) {
        const int it = (it2 >> 5) * 8 + (it2 & 7), sub = (it2 >> 3) & 3;
        f32x4 acc = (f32x4){0.f, 0.f, 0.f, 0.f};
#pragma unroll
        for (int bt = 0; bt < 4; ++bt) {
            const size_t r0 = (size_t)it * 256 + wave * 32 + bt * 8; f32x4 k[8], v[8];
#pragma unroll
            for (int i = 0; i < 8; ++i) k[i] = *(const f32x4*)(kvr + (r0 + i) * 512 + 4 * lane);
            if (bt == sub) {
#pragma unroll
                for (int i = 0; i < 8; ++i) v[i] = *(const f32x4*)(kvr + (r0 + i) * 512 + 256 + 4 * lane); }
#pragma unroll
            for (int i = 0; i < 8; ++i) { const float ss = sum16((k[i][0] * k[i][0] + k[i][1] * k[i][1]) + (k[i][2] * k[i][2] + k[i][3] * k[i][3])); const float rs = __builtin_amdgcn_rsqf(ss * (1.0f / 64.0f) + EPS);
                k[i] = k[i] * rs * gk; acc += k[i]; }
            if (bt == sub) {
#pragma unroll
                for (int i = 0; i < 8; ++i) { const size_t row = r0 + i;
                    *(f32x4*)(outp + OFF_PK + row * 256 + 4 * lane) = k[i]; *(f32x4*)(outp + OFF_PV + row * 256 + 4 * lane) = v[i];
                    u32x2 w; w.x = cvtpk(k[i][0], k[i][1]); w.y = cvtpk(k[i][2], k[i][3]); *(u32x2*)(kbp + row * 256 + 4 * lane) = w;
                    w.x = cvtpk(v[i][0], v[i][1]); w.y = cvtpk(v[i][2], v[i][3]); *(u32x2*)(vbp + row * 256 + 4 * lane) = w; } }
        }
        *(LAS f32x4*)(red + wave * 256 + 4 * lane) = acc;
        __syncthreads();
        if (sub == 0 && F.tid < 256) { float t = 0.f;
#pragma unroll
            for (int w = 0; w < 8; ++w) t += red[w * 256 + F.tid];
            F.kmeanp()[(size_t)it * 256 + F.tid] = (bf16)cvtpk(t * (1.0f / 256.0f), 0.f); }
        __syncthreads(); }
    for (int r = F.vcu * NWAVES + wave; r < NS; r += F.G * NWAVES) {
        const size_t row = (size_t)MP + r;
        f32x4 k = *(const f32x4*)(kvr + row * 512 + 4 * lane); const f32x4 v = *(const f32x4*)(kvr + row * 512 + 256 + 4 * lane);
        const float ss = sum16((k[0] * k[0] + k[1] * k[1]) + (k[2] * k[2] + k[3] * k[3])); const float rs = __builtin_amdgcn_rsqf(ss * (1.0f / 64.0f) + EPS);
        k = k * rs * gk;
        *(f32x4*)(outp + OFF_SK + (size_t)r * 256 + 4 * lane) = k; *(f32x4*)(outp + OFF_SV + (size_t)r * 256 + 4 * lane) = v;
        u32x2 w; w.x = cvtpk(k[0], k[1]); w.y = cvtpk(k[2], k[3]); *(u32x2*)(kbp + row * 256 + 4 * lane) = w;
        w.x = cvtpk(v[0], v[1]); w.y = cvtpk(v[2], v[3]); *(u32x2*)(vbp + row * 256 + 4 * lane) = w; }
}

template <bool MOBA>
__device__ __forceinline__ void decode_item(const Frame& F, int l, int s, int hd) {
    LAS float* sc = (LAS float*)F.lds; LAS float* red = (LAS float*)(F.lds + 4096); LAS float* misc = (LAS float*)(F.lds + 12288); LAS int* segs = (LAS int*)(F.lds + 12288 + 256);
    const int t = F.otid(), rg = t >> 4, lq = t & 15, wave = F.wave;
    const size_t row = MP + s; const int qcol = MOBA ? hd * 64 : MIXW + hd * 64, kvh = MOBA ? hd / 3 : hd;
    const float* gq = MOBA ? F.g_q() + (l - 2) * 64 : F.g_mq() + l * 64;
    const u32x2 qw = *(const u32x2*)(F.proj(l) + row * DM + qcol + 4 * lq);
    float q0 = bflo(qw.x), q1 = bfhi(qw.x), q2 = bflo(qw.y), q3 = bfhi(qw.y);
    { const float ss = sum16((q0 * q0 + q1 * q1) + (q2 * q2 + q3 * q3)); const float rs = __builtin_amdgcn_rsqf(ss * (1.0f / 64.0f) + EPS) * C2; const f32x4 g4 = *(const f32x4*)(gq + 4 * lq);
      q0 *= rs * g4[0]; q1 *= rs * g4[1]; q2 *= rs * g4[2]; q3 *= rs * g4[3]; }
    __syncthreads();
    if (MOBA) {
        if (rg < 8) { const f32x4 km = *(const f32x4*)(F.kmeans() + ((size_t)(s * 8 + rg)) * 256 + kvh * 64 + 4 * lq); const float d = sum16((q0 * km[0] + q1 * km[1]) + (q2 * km[2] + q3 * km[3])); if (lq == 0) misc[rg] = d; }
        __syncthreads();
        if (t == 0) { float g0 = misc[0], g1 = misc[1], g2 = misc[2], g3 = misc[3], g4 = misc[4], g5 = misc[5], g6 = misc[6], g7 = misc[7]; unsigned selm = 0u;
#pragma unroll
            for (int k = 0; k < 3; ++k) { float best = g0; int bi = 0;
                if (g1 > best) { best = g1; bi = 1; } if (g2 > best) { best = g2; bi = 2; } if (g3 > best) { best = g3; bi = 3; } if (g4 > best) { best = g4; bi = 4; } if (g5 > best) { best = g5; bi = 5; } if (g6 > best) { best = g6; bi = 6; } if (g7 > best) { best = g7; bi = 7; }
                selm |= 1u << bi; const float NI = -INFINITY;
                g0 = bi == 0 ? NI : g0; g1 = bi == 1 ? NI : g1; g2 = bi == 2 ? NI : g2; g3 = bi == 3 ? NI : g3; g4 = bi == 4 ? NI : g4; g5 = bi == 5 ? NI : g5; g6 = bi == 6 ? NI : g6; g7 = bi == 7 ? NI : g7; }
            int n = 0;
            for (int jb = 0; jb < 8; ++jb) if ((selm >> jb) & 1u) { segs[n++] = F.page_table()[s * 16 + 2 * jb]; segs[n++] = F.page_table()[s * 16 + 2 * jb + 1]; } }
        __syncthreads();
    }
    constexpr int NSEG = MOBA ? 6 : 2;
#pragma unroll
    for (int sg = 0; sg < NSEG; ++sg) {
        const float* kb = MOBA ? F.cache_k() + (size_t)segs[sg] * 32768 + kvh * 64 : F.cache_mem_k() + ((size_t)((l * NS + s) * 256 + sg * 128)) * 256 + hd * 64;
        f32x4 kv[4];
#pragma unroll
        for (int i = 0; i < 4; ++i) kv[i] = *(const f32x4*)(kb + (size_t)(i * 32 + rg) * 256 + 4 * lq);
#pragma unroll
        for (int i = 0; i < 4; ++i) { const float d = sum16((q0 * kv[i][0] + q1 * kv[i][1]) + (q2 * kv[i][2] + q3 * kv[i][3])); if (lq == 0) sc[sg * 128 + i * 32 + rg] = d; }
    }
    constexpr int NKEY = NSEG * 128 + (MOBA ? 1 : 0);
    if (MOBA && rg == 0) { const f32x4 kn = *(const f32x4*)(F.out() + OFF_SK + (size_t)s * 256 + kvh * 64 + 4 * lq); const float d = sum16((q0 * kn[0] + q1 * kn[1]) + (q2 * kn[2] + q3 * kn[3])); if (lq == 0) sc[NSEG * 128] = d; }
    __syncthreads();
    float m = -INFINITY;
    for (int i = t; i < NKEY; i += NWAVES * 64) m = fmaxf(m, sc[i]);
    m = wave_max(m); if (F.lane == 0) misc[16 + wave] = m;
    __syncthreads();
    m = fmaxf(fmaxf(fmaxf(misc[16], misc[17]), fmaxf(misc[18], misc[19])), fmaxf(fmaxf(misc[20], misc[21]), fmaxf(misc[22], misc[23])));
    float sm = 0.f;
    for (int i = t; i < NKEY; i += NWAVES * 64) { const float p = __builtin_amdgcn_exp2f(sc[i] - m); sc[i] = p; sm += p; }
    sm = wave_sum(sm); if (F.lane == 0) misc[24 + wave] = sm;
    __syncthreads();
    const float tot = ((misc[24] + misc[25]) + (misc[26] + misc[27])) + ((misc[28] + misc[29]) + (misc[30] + misc[31]));
    f32x4 acc = (f32x4){0.f, 0.f, 0.f, 0.f};
#pragma unroll
    for (int sg = 0; sg < NSEG; ++sg) {
        const float* vb = MOBA ? F.cache_v() + (size_t)segs[sg] * 32768 + kvh * 64 : F.cache_mem_v() + ((size_t)((l * NS + s) * 256 + sg * 128)) * 256 + hd * 64;
        f32x4 vv[4];
#pragma unroll
        for (int i = 0; i < 4; ++i) vv[i] = *(const f32x4*)(vb + (size_t)(i * 32 + rg) * 256 + 4 * lq);
#pragma unroll
        for (int i = 0; i < 4; ++i) acc += vv[i] * sc[sg * 128 + i * 32 + rg];
    }
    if (MOBA && rg == 0) { const f32x4 vn = *(const f32x4*)(F.out() + OFF_SV + (size_t)s * 256 + kvh * 64 + 4 * lq); acc += vn * sc[NSEG * 128]; }
    *(LAS f32x4*)(red + rg * 64 + 4 * lq) = acc;
    __syncthreads();
    if (t < 64) { float o = 0.f;
#pragma unroll 8
        for (int r = 0; r < 32; ++r) o += red[r * 64 + t];
        F.mixo(l)[row * DM + qcol + t] = (bf16)cvtpk(o * __builtin_amdgcn_rcpf(tot), 0.f); }
}

template <int NQ>
__device__ __forceinline__ f32x4 skinny_tile(const bf16* __restrict__ A, const bf16* __restrict__ Bt, int K, int row0, int n0, LAS unsigned char* lds, int tid) {
    const int lane = tid & 63, wave = __builtin_amdgcn_readfirstlane(tid >> 6), fr = lane & 15, fq = lane >> 4;
    const int kw = K >> 3, nks = kw >> 5;
    const bf16* ap = A + (size_t)(row0 + fr) * K + wave * kw + 8 * fq;
    const bf16* bp = Bt + (size_t)(n0 + fr) * K + wave * kw + 8 * fq;
    f32x4 acc[4];
#pragma unroll
    for (int c = 0; c < 4; ++c) acc[c] = (f32x4){0.f, 0.f, 0.f, 0.f};
    for (int ks0 = 0; ks0 < nks; ks0 += NQ) {
        bf16x8 a[NQ], b[NQ][4];
#pragma unroll
        for (int q = 0; q < NQ; ++q) { const int ks = (ks0 + q < nks) ? ks0 + q : nks - 1; a[q] = *(const bf16x8*)(ap + ks * 32);
#pragma unroll
            for (int c = 0; c < 4; ++c) b[q][c] = *(const bf16x8*)(bp + (size_t)(16 * c) * K + ks * 32); }
#pragma unroll
        for (int q = 0; q < NQ; ++q) { if (ks0 + q < nks) {
#pragma unroll
            for (int c = 0; c < 4; ++c) acc[c] = __builtin_amdgcn_mfma_f32_16x16x32_bf16(b[q][c], a[q], acc[c], 0, 0, 0); } }
    }
    __syncthreads();
#pragma unroll
    for (int c = 0; c < 4; ++c) *(LAS f32x4*)(lds + wave * 4096 + c * 1024 + lane * 16) = acc[c];
    __syncthreads();
    f32x4 r = (f32x4){0.f, 0.f, 0.f, 0.f};
    if (tid < 256) { const int row = tid >> 4, c4 = tid & 15, L = (c4 & 3) * 16 + row, cg = c4 >> 2;
#pragma unroll
        for (int w = 0; w < 8; ++w) r += *(const LAS f32x4*)(lds + w * 4096 + cg * 1024 + L * 16); }
    return r;
}
__device__ __forceinline__ void skinny_proj(const Frame& F, int l, int tile) {
    const int tid = F.otid(), rg = tile & 7, cs = tile >> 3, row0 = MP + 16 * rg, n0 = 64 * cs;
    const f32x4 v = skinny_tile<4>(l == 0 ? F.hb0() : F.hbb(l - 1), wcat(F, l), DM, row0, n0, F.lds, tid);
    if (tid < 256) { const int row = row0 + (tid >> 4), c4 = tid & 15;
        const float rs = __builtin_amdgcn_rsqf(sum16((l == 0 ? F.ssq0() : F.ssqa(l - 1))[(size_t)row * 16 + c4]) * (1.0f / 1024.0f) + EPS);
        if (n0 < DM) { u32x2 w; w.x = cvtpk(v[0] * rs, v[1] * rs); w.y = cvtpk(v[2] * rs, v[3] * rs); *(u32x2*)(F.proj(l) + (size_t)row * DM + n0 + 4 * c4) = w; }
        else *(f32x4*)(F.kvraw() + (size_t)row * 512 + (n0 - DM) + 4 * c4) = v * rs; }
}
__device__ __forceinline__ void skinny_resid(const Frame& F, const bf16* A, const bf16* Bt, int K, const float* xin, const bf16* hin, bf16* hout, float* ssq_out, bool last, int tile) {
    const int tid = F.otid(), rg = tile & 7, cs = tile >> 3, row0 = MP + 16 * rg, n0 = 64 * cs;
    const f32x4 v = K > 1024 ? skinny_tile<6>(A, Bt, K, row0, n0, F.lds, tid) : skinny_tile<4>(A, Bt, K, row0, n0, F.lds, tid);
    if (tid < 256) { const int row = row0 + (tid >> 4), c4 = tid & 15; const size_t off = (size_t)row * DM + n0 + 4 * c4; f32x4 hn;
        if (xin) hn = *(const f32x4*)(xin + off - (size_t)MP * DM); else { const u32x2 hw = *(const u32x2*)(hin + off); hn = (f32x4){bflo(hw.x), bfhi(hw.x), bflo(hw.y), bfhi(hw.y)}; }
        hn += v;
        if (last) *(f32x4*)(F.out() + OFF_Y + off) = hn;
        u32x2 w; w.x = cvtpk(hn[0], hn[1]); w.y = cvtpk(hn[2], hn[3]); *(u32x2*)(hout + off) = w;
        const float ss = sum16((hn[0] * hn[0] + hn[1] * hn[1]) + (hn[2] * hn[2] + hn[3] * hn[3]));
        if (c4 == 0) ssq_out[(size_t)row * 16 + cs] = ss; }
}

__device__ __forceinline__ float row16_sum_to_lane15(float v) {
    v += __builtin_bit_cast(float, __builtin_amdgcn_update_dpp(0, __builtin_bit_cast(int, v), 0x111, 0xf, 0xf, true));
    v += __builtin_bit_cast(float, __builtin_amdgcn_update_dpp(0, __builtin_bit_cast(int, v), 0x112, 0xf, 0xf, true));
    v += __builtin_bit_cast(float, __builtin_amdgcn_update_dpp(0, __builtin_bit_cast(int, v), 0x114, 0xf, 0xf, true));
    v += __builtin_bit_cast(float, __builtin_amdgcn_update_dpp(0, __builtin_bit_cast(int, v), 0x118, 0xf, 0xf, true));
    return v;
}
template <bool MOBA>
__device__ __forceinline__ void decode_wave(const Frame& F, int l, int s, int hd, LAS unsigned char* wl) {
    LAS float* sc = (LAS float*)wl; LAS float* gate = (LAS float*)(wl + 3200); LAS int* segs = (LAS int*)(wl + 3264);
    const int lane = F.otid() & 63, rg = lane >> 4, lq = lane & 15; const bool wr15 = lq == 15;
    const size_t row = MP + s; const int qcol = MOBA ? hd * 64 : MIXW + hd * 64, kvh = MOBA ? hd / 3 : hd;
    const float* gq = MOBA ? F.g_q() + (l - 2) * 64 : F.g_mq() + l * 64;
    const u32x2 qw = *(const u32x2*)(F.proj(l) + row * DM + qcol + 4 * lq);
    float q0 = bflo(qw.x), q1 = bfhi(qw.x), q2 = bflo(qw.y), q3 = bfhi(qw.y);
    { const float ss = sum16((q0 * q0 + q1 * q1) + (q2 * q2 + q3 * q3)); const float rs = __builtin_amdgcn_rsqf(ss * (1.0f / 64.0f) + EPS) * C2; const f32x4 g4 = *(const f32x4*)(gq + 4 * lq);
      q0 *= rs * g4[0]; q1 *= rs * g4[1]; q2 *= rs * g4[2]; q3 *= rs * g4[3]; }
    constexpr int NSEG = MOBA ? 6 : 2, NKEY = NSEG * 128 + (MOBA ? 1 : 0);
    if (MOBA) {
#pragma unroll
        for (int h2 = 0; h2 < 2; ++h2) { const int blk = rg + 4 * h2; const f32x4 km = *(const f32x4*)(F.kmeans() + ((size_t)(s * 8 + blk)) * 256 + kvh * 64 + 4 * lq);
            const float d = row16_sum_to_lane15((q0 * km[0] + q1 * km[1]) + (q2 * km[2] + q3 * km[3])); if (wr15) gate[blk] = d; }
        float g0 = gate[0], g1 = gate[1], g2 = gate[2], g3 = gate[3], g4 = gate[4], g5 = gate[5], g6 = gate[6], g7 = gate[7]; unsigned selm = 0u;
#pragma unroll
        for (int k = 0; k < 3; ++k) { float best = g0; int bi = 0;
            if (g1 > best) { best = g1; bi = 1; } if (g2 > best) { best = g2; bi = 2; } if (g3 > best) { best = g3; bi = 3; } if (g4 > best) { best = g4; bi = 4; } if (g5 > best) { best = g5; bi = 5; } if (g6 > best) { best = g6; bi = 6; } if (g7 > best) { best = g7; bi = 7; }
            selm |= 1u << bi; const float NI = -INFINITY;
            g0 = bi == 0 ? NI : g0; g1 = bi == 1 ? NI : g1; g2 = bi == 2 ? NI : g2; g3 = bi == 3 ? NI : g3; g4 = bi == 4 ? NI : g4; g5 = bi == 5 ? NI : g5; g6 = bi == 6 ? NI : g6; g7 = bi == 7 ? NI : g7; }
        if (lane == 0) { int n = 0; for (int jb = 0; jb < 8; ++jb) if ((selm >> jb) & 1u) { segs[n++] = F.page_table()[s * 16 + 2 * jb]; segs[n++] = F.page_table()[s * 16 + 2 * jb + 1]; } }
    }
    const float* const kc = MOBA ? F.cache_k() : F.cache_mem_k(); const float* const vc = MOBA ? F.cache_v() : F.cache_mem_v();
#pragma unroll 1
    for (int sg = 0; sg < NSEG; ++sg) {
        const float* kb = (MOBA ? kc + (size_t)segs[sg] * 32768 + kvh * 64 : kc + ((size_t)((l * NS + s) * 256 + sg * 128)) * 256 + hd * 64) + (size_t)rg * 256 + 4 * lq;
#pragma unroll
        for (int hb2 = 0; hb2 < 2; ++hb2) { f32x4 kv[16];
#pragma unroll
            for (int i = 0; i < 16; ++i) kv[i] = *(const f32x4*)(kb + (size_t)(hb2 * 64 + 4 * i) * 256);
#pragma unroll
            for (int i = 0; i < 16; ++i) { const float d = row16_sum_to_lane15((q0 * kv[i][0] + q1 * kv[i][1]) + (q2 * kv[i][2] + q3 * kv[i][3])); if (wr15) sc[sg * 128 + hb2 * 64 + 4 * i + rg] = d; } }
    }
    if (MOBA) { const f32x4 kn = *(const f32x4*)(F.out() + OFF_SK + (size_t)s * 256 + kvh * 64 + 4 * lq); const float d = row16_sum_to_lane15((q0 * kn[0] + q1 * kn[1]) + (q2 * kn[2] + q3 * kn[3])); if (lane == 15) sc[NSEG * 128] = d; }
    float m = -INFINITY;
    for (int i = lane; i < NKEY; i += 64) m = fmaxf(m, sc[i]);
    m = wave_max(m);
    float sm = 0.f;
    for (int i = lane; i < NKEY; i += 64) { const float p = __builtin_amdgcn_exp2f(sc[i] - m); sc[i] = p; sm += p; }
    sm = wave_sum(sm);
    f32x4 acc = (f32x4){0.f, 0.f, 0.f, 0.f};
#pragma unroll 1
    for (int sg = 0; sg < NSEG; ++sg) {
        const float* vb = (MOBA ? vc + (size_t)segs[sg] * 32768 + kvh * 64 : vc + ((size_t)((l * NS + s) * 256 + sg * 128)) * 256 + hd * 64) + (size_t)rg * 256 + 4 * lq;
#pragma unroll
        for (int hb2 = 0; hb2 < 2; ++hb2) { f32x4 vv[16];
#pragma unroll
            for (int i = 0; i < 16; ++i) vv[i] = *(const f32x4*)(vb + (size_t)(hb2 * 64 + 4 * i) * 256);
#pragma unroll
            for (int i = 0; i < 16; ++i) acc += vv[i] * sc[sg * 128 + hb2 * 64 + 4 * i + rg]; }
    }
    if (MOBA && rg == 0) { const f32x4 vn = *(const f32x4*)(F.out() + OFF_SV + (size_t)s * 256 + kvh * 64 + 4 * lq); acc += vn * sc[NSEG * 128]; }
#pragma unroll
    for (int e = 0; e < 4; ++e) { acc[e] += __shfl_xor(acc[e], 16); acc[e] += __shfl_xor(acc[e], 32); }
    if (lane < 16) { const float inv = __builtin_amdgcn_rcpf(sm); u32x2 w; w.x = cvtpk(acc[0] * inv, acc[1] * inv); w.y = cvtpk(acc[2] * inv, acc[3] * inv); *(u32x2*)(F.mixo(l) + row * DM + qcol + 4 * lq) = w; }
}


constexpr int N_PHASES = 29;
__host__ __device__ constexpr bool phase_exists(int p) { if (p == 0) return true; const int l = (p - 1) / 7, k = (p - 1) % 7; if (k == 1) return l == 0 || l == 2; if (k == 3) return l < 2; return true; }

__global__ void __launch_bounds__(NWAVES * 64, 2) fwd(Args args) {
    extern __shared__ __attribute__((aligned(16))) unsigned char lds[];
    Frame F;
    F.lds = (LAS unsigned char*)lds; F.MISC = (volatile LAS unsigned*)(F.lds + MISC_OFF);
    F.tid = threadIdx.x; F.lane = F.tid & 63; F.wave = __builtin_amdgcn_readfirstlane(F.tid >> 6);
    F.G = gridDim.x; { const int bx = blockIdx.x; F.vcu = (F.G % 8 == 0) ? (bx % 8) * (F.G / 8) + bx / 8 : bx; }
    F.ap = (const __attribute__((address_space(4))) Args*)__builtin_amdgcn_kernarg_segment_ptr(); F.ctl = (gu32*)(args.ws + WS_CTL);
    for (int u = F.tid; u < (LDS_BYTES - LDSCTL_OFF) / 4; u += NWAVES * 64) ((LAS unsigned*)(F.lds + LDSCTL_OFF))[u] = 0u;
    __syncthreads();
    XcdBarrier bar = xcd_barrier_post((unsigned*)(F.ctl + CW_BAR) + args.li * XCD_BAR_WORDS, F.MISC + 8);
    const int lo = args.ph_lo, hi = args.ph_hi;
#define IN(p) (lo <= (p) && (p) < hi)
#define SEAM(p) do { if ((p) + 1 < hi) xcd_barrier(bar); } while (0)

    if (IN(0)) {
        if (hi - lo > 1) xcd_barrier(bar);
        p0_prologue(F); SEAM(0); }

    for (int l = 0; l < 4; ++l) {
        const int pb = 1 + 7 * l;
        if (IN(pb)) {
            pg8::Gemm g{l == 0 ? F.hb0() : F.hbb(l - 1), wcat(F, l), AROWS, 0, DM};
            pg8::ListSched S; S.init(NPP, l == 2 ? 6 : 4, NPT, l == 0 ? 4 : 0, 4, 8, F.G, (int)blockIdx.x);
            pg8::EpiProj E{l == 0 ? F.ssq0() : F.ssqa(l - 1), F.proj(l), F.kvraw(), F.kmraw(), F.out() + OFF_PMV, NPT};
            pg8::gemm_phase<pg8::EpiProj, pg8::ListSched, true, true>(F.lds, g, S, E);
            for (int tl = (int)blockIdx.x - 128; tl >= 0 && tl < (l == 2 ? 192 : 128); tl += 128) skinny_proj(F, l, tl);
            if (l == 2 && (int)blockIdx.x >= 128) sample_kmeans(F, 684, NS * 8, (int)blockIdx.x - 128, F.G - 128);
            SEAM(pb);
        }
        if (l < 2) {
            if (l == 0 && IN(pb + 1)) { memkv_norm(F); SEAM(pb + 1); }
            if (IN(pb + 2)) {
                const int skipm = args.pad;
                if (skipm & 4) {} else if (F.vcu < NBATCH * NG) { const int b = F.vcu / NG, g = F.vcu % NG; LAS float* elds = (LAS float*)(F.lds + NWAVES * XS_WAVE);
                    s5_item<false>(F, l, b, g, F.wave, nullptr, elds);
                    __syncthreads();
                    s5_item<true>(F, l, b, g, F.wave, F.lds + F.wave * XS_WAVE, elds);
                } else if (!(skipm & 16)) { const int a = F.vcu - NBATCH * NG, na = F.G - NBATCH * NG;
                    for (int it = a * NWAVES + F.wave; it < NS * 4; it += na * NWAVES) decode_wave<false>(F, l, it >> 2, it & 3, F.lds + F.wave * 4096); }
                if (!(skipm & 8)) { const int gw = F.vcu * NWAVES + F.wave;
                    if (F.G * NWAVES == 2048) {
                        if (gw < 42 * NG) s5_sample3(F, l, gw % NG, gw / NG);
                        else for (int it = gw - 42 * NG; it < 2 * NG; it += 32) s5_sample(F, l, 126 + it / NG, it % NG);
                    } else for (int it = gw; it < NS * NG; it += F.G * NWAVES) s5_sample(F, l, it / NG, it % NG); }
                if (!(skipm & 32)) { gu32* qm = F.ctl + CW_QUEUE + (64 + l + 4 * args.li) * 64; unsigned nxt = 0u;
                  if (F.tid == 0) nxt = __hip_atomic_fetch_add(qm, 1u, RLX_AGENT);
                  for (int itn = 0;; ++itn) {
                      if (F.tid == 0) F.MISC[16 + (itn & 1)] = nxt;
                      __syncthreads();
                      const unsigned u = (unsigned)__builtin_amdgcn_readfirstlane((int)F.MISC[16 + (itn & 1)]);
                      if (u >= 256u) break;
                      if (F.tid == 0) nxt = __hip_atomic_fetch_add(qm, 1u, RLX_AGENT);
                      const int b = u >> 6, mh = (u >> 4) & 3, qb = u & 15; const size_t row0 = (size_t)b * SEQ + qb * 256;
                      attn_body::attn_unit<0, 8>(qb, F.proj(l) + row0 * DM + MIXW + mh * 64, F.memkb() + ((size_t)(l * MEMR + b * 256)) * 256 + mh * 64, F.memvb() + ((size_t)(l * MEMR + b * 256)) * 256 + mh * 64,
                                                 F.mixo(l) + row0 * DM + MIXW + mh * 64, F.g_mq() + l * 64, nullptr, (char*)lds); } }
                SEAM(pb + 2);
            }
            if (IN(pb + 3)) {
                pg8::Gemm g{F.ybuf(l), (const bf16*)(F.wsb() + WS_WGLU + (size_t)l * WGLU_STRIDE), MROWS, MIXW, MIXW};
                pg8::ListSched S; S.init(NPT, 3, 0, 0, 0, 0, F.G, (int)blockIdx.x);
                pg8::EpiGlu E{F.ybuf(l), F.mixo(l)};
                pg8::gemm_phase<pg8::EpiGlu, pg8::ListSched, true, true>(F.lds, g, S, E);
                SEAM(pb + 3);
            }
        } else {
            if (l == 2 && IN(pb + 1)) { kv_norm(F); SEAM(pb + 1); }
            if (IN(pb + 2)) {
                gu32* qa = F.ctl + CW_QUEUE + ((l - 2) + 2 * args.li) * 128; gu32* qd = qa + 64;
                constexpr unsigned NA = NBATCH * NQH * 16 + 256, NDB = (NS * NQH) / 8 + (NS * 4) / 8;
                int curq = (F.vcu < ND_FIRST) ? 1 : 0; bool switched = false; unsigned nxt = 0u;
                if (F.tid == 0) nxt = __hip_atomic_fetch_add(curq ? qd : qa, 1u, RLX_AGENT);
                for (int itn = 0;; ++itn) {
                    if (F.tid == 0) F.MISC[16 + (itn & 1)] = nxt;
                    __syncthreads();
                    const unsigned idx = (unsigned)__builtin_amdgcn_readfirstlane((int)F.MISC[16 + (itn & 1)]);
                    if (idx >= (curq ? NDB : NA)) { if (switched) break; switched = true; curq ^= 1; if (F.tid == 0) nxt = __hip_atomic_fetch_add(curq ? qd : qa, 1u, RLX_AGENT); continue; }
                    if (F.tid == 0) nxt = __hip_atomic_fetch_add(curq ? qd : qa, 1u, RLX_AGENT);
                    if (curq == 0) {
                        if (idx < (unsigned)(NBATCH * NQH * 16)) { const int qb = 15 - (int)(idx / 48u), bh = (int)(idx % 48u), b = bh / NQH, hq = bh % NQH, kvh = hq / 3; const size_t row0 = (size_t)b * SEQ + qb * 256;
                            attn_body::attn_unit<1, 8>(qb, F.proj(l) + row0 * DM + hq * 64, F.kbuf() + ((size_t)b * SEQ) * 256 + kvh * 64, F.vbuf() + ((size_t)b * SEQ) * 256 + kvh * 64,
                                                       F.mixo(l) + row0 * DM + hq * 64, F.g_q() + (l - 2) * 64, F.kmeanp() + ((size_t)b * 16) * 256 + kvh * 64, (char*)lds); }
                        else { const int u = (int)idx - NBATCH * NQH * 16, b = u >> 6, mh = (u >> 4) & 3, qb = u & 15; const size_t row0 = (size_t)b * SEQ + qb * 256;
                            attn_body::attn_unit<0, 8>(qb, F.proj(l) + row0 * DM + MIXW + mh * 64, F.memkb() + ((size_t)(l * MEMR + b * 256)) * 256 + mh * 64, F.memvb() + ((size_t)(l * MEMR + b * 256)) * 256 + mh * 64,
                                                       F.mixo(l) + row0 * DM + MIXW + mh * 64, F.g_mq() + l * 64, nullptr, (char*)lds); }
                    } else {
                        if (idx < (unsigned)((NS * NQH) / 8)) { const int it = (int)idx * 8 + F.wave; decode_wave<true>(F, l, it / NQH, it % NQH, F.lds + F.wave * 4096); }
                        else { const int it = ((int)idx - (NS * NQH) / 8) * 8 + F.wave; decode_wave<false>(F, l, it >> 2, it & 3, F.lds + F.wave * 4096); }
                    }
                }
                SEAM(pb + 2);
            }
        }
        if (IN(pb + 4)) {
            pg8::Gemm g{F.mixo(l), (const bf16*)(F.wsb() + WS_WOUT + (size_t)l * 2 * MiB), MROWS, DM, DM};
            pg8::ListSched S; S.init(NPP, 4, 0, 0, 0, 0, F.G, (int)blockIdx.x);
            pg8::EpiResid E{l == 0 ? F.x_prompt() : nullptr, l == 0 ? nullptr : F.hbb(l - 1), F.hba(l), F.ssqb(l), nullptr};
            pg8::gemm_phase<pg8::EpiResid, pg8::ListSched, true, true>(F.lds, g, S, E);
            for (int tl = F.vcu; tl < 128; tl += F.G) skinny_resid(F, F.mixo(l), (const bf16*)(F.wsb() + WS_WOUT + (size_t)l * 2 * MiB), DM, l == 0 ? F.x_sample() : nullptr, l == 0 ? nullptr : F.hbb(l - 1), F.hba(l), F.ssqb(l), false, tl);
            SEAM(pb + 4);
        }
        if (IN(pb + 5)) {
            pg8::Gemm g{F.hba(l), (const bf16*)(F.wsb() + WS_WGU + (size_t)l * WGU_STRIDE), MROWS, 2 * DFF, DM};
            pg8::ListSched S; S.init(NPT, 22, 0, 0, 0, 0, F.G, (int)blockIdx.x);
            pg8::EpiSwiglu E{F.ssqb(l), F.ffh(l)};
            pg8::gemm_phase<pg8::EpiSwiglu, pg8::ListSched, true, true>(F.lds, g, S, E);
            if (l < 2 && (int)blockIdx.x >= 150) sample_kmeans(F, 342 * l, 342 * l + 342, (int)blockIdx.x - 150, F.G - 150);
            SEAM(pb + 5);
        }
        if (IN(pb + 6)) {
            pg8::Gemm g{F.ffh(l), (const bf16*)(F.wsb() + WS_WDOWN + (size_t)l * WDOWN_STRIDE), MROWS, DM, DFF};
            pg8::ListSched S; S.init(NPP, 4, 0, 0, 0, 0, F.G, (int)blockIdx.x);
            pg8::EpiResid E{nullptr, F.hba(l), F.hbb(l), F.ssqa(l), l == 3 ? F.out() + OFF_Y : nullptr};
            pg8::gemm_phase<pg8::EpiResid, pg8::ListSched, true, true>(F.lds, g, S, E);
            for (int tl = F.vcu; tl < 128; tl += F.G) skinny_resid(F, F.ffh(l), (const bf16*)(F.wsb() + WS_WDOWN + (size_t)l * WDOWN_STRIDE), DFF, nullptr, F.hba(l), F.hbb(l), F.ssqa(l), l == 3, tl);
            SEAM(pb + 6);
        }
    }
    if (hi - lo > 1) xcd_barrier(bar);
#undef IN
#undef SEAM
}

#ifndef MK_ONE_LAUNCH
#define MK_ONE_LAUNCH 0
#endif
extern "C" void kernel_launch(void* const* d_in, const int* in_sizes, int n_in, void* d_out, int out_size, void* d_ws, size_t ws_size, hipStream_t stream) {
    static int grid = 0;
    if (grid == 0) {
        if (n_in != 33 || out_size != (int)OUT_TOTAL || ws_size < WS_END) { fprintf(stderr, "kernel_launch: unexpected shapes: n_in %d out %d ws %zu; nothing launched\n", n_in, out_size, ws_size); grid = -1; return; }
        int dev = 0, cus = 0, per_cu = 0;
        if (hipGetDevice(&dev) != hipSuccess || hipDeviceGetAttribute(&cus, hipDeviceAttributeMultiprocessorCount, dev) != hipSuccess) { fprintf(stderr, "kernel_launch: device query failed\n"); grid = -1; return; }
        if (hipFuncSetAttribute((const void*)fwd, hipFuncAttributeMaxDynamicSharedMemorySize, LDS_BYTES) != hipSuccess) { fprintf(stderr, "kernel_launch: hipFuncSetAttribute failed\n"); grid = -1; return; }
        if (hipOccupancyMaxActiveBlocksPerMultiprocessor(&per_cu, (const void*)fwd, NWAVES * 64, LDS_BYTES) != hipSuccess || per_cu < 1) fprintf(stderr, "kernel_launch: note: occupancy query reports %d workgroups per CU\n", per_cu);
        (void)hipGetLastError();
        grid = cus;
    }
    if (grid < 0) return;
    if (hipMemsetAsync((char*)d_ws + WS_CTL, 0, CTL_ZERO_BYTES, stream) != hipSuccess) { fprintf(stderr, "kernel_launch: memset failed\n"); return; }
    Args a{};
    for (int i = 0; i < 33; ++i) a.in[i] = d_in[i];
    a.out = (float*)d_out; a.ws = (unsigned char*)d_ws; a.pad = 0;
    if (MK_ONE_LAUNCH) {
        a.ph_lo = 0; a.ph_hi = N_PHASES; a.li = 0;
        hipLaunchKernelGGL(fwd, dim3(grid), dim3(NWAVES * 64), LDS_BYTES, stream, a);
        const hipError_t le = hipPeekAtLastError(); if (le != hipSuccess) fprintf(stderr, "kernel_launch: launch failed: %s\n", hipGetErrorName(le));
    } else {
        int li = 0;
        for (int p = 0; p < N_PHASES; ++p) { if (!phase_exists(p)) continue;
            a.ph_lo = p; a.ph_hi = p + 1; a.li = li++;
            hipLaunchKernelGGL(fwd, dim3(grid), dim3(NWAVES * 64), LDS_BYTES, stream, a);
            const hipError_t le = hipPeekAtLastError(); if (le != hipSuccess) { fprintf(stderr, "kernel_launch: launch %d failed: %s\n", p, hipGetErrorName(le)); break; } }
    }
}
```

```cpp
#include <hip/hip_runtime.h>
#include <cstdio>
#include <cstdint>
#include <cmath>
#define MK_ONE_LAUNCH 1
#define L2INV 1
namespace pg8 {
#define PG8_LAS __attribute__((address_space(3)))
typedef unsigned short bf16_t;
typedef short bf16x8 __attribute__((ext_vector_type(8)));
typedef float f32x4 __attribute__((ext_vector_type(4)));
typedef unsigned u32x4 __attribute__((ext_vector_type(4)));
constexpr int BM = 256, BK = 64, HALF = 128, HTB = HALF * BK * 2  , STAGE_BYTES = 8 * HTB, NXCD = 8, WGM = 8;

__host__ __device__ __forceinline__ int lds_byte(int r, int c) { const int st = (r >> 4) * 2 + (c >> 5), rr = r & 15, cc = c & 31, ob = rr * 64 + cc * 2; return st * 1024 + (ob ^ (((ob >> 9) & 1) << 5)); }
__host__ __device__ __forceinline__ void stage_rc(int b, int& R, int& C) { const int st = b / 1024, sb = b % 1024, swz = sb ^ (((sb >> 9) & 1) << 5); R = (st >> 1) * 16 + swz / 64; C = (st & 1) * 32 + (swz % 64) / 2; }
__host__ __device__ __forceinline__ int perm32(int rho) { const int n = rho >> 4, i = rho & 15; return 8 * (i >> 2) + 4 * n + (i & 3); }

struct Unit { int pm, pn; };
struct Gemm { const bf16_t* A; const bf16_t* Bt; int M, N, K; };

struct StaticOrder {
    int nM, nN, nwg, G, c;
    __host__ __device__ void init(int M, int N, int G_, int c_) { nM = M / BM; nN = N / BM; nwg = nM * nN; G = G_; c = c_; }
    __host__ __device__ bool next(int i, Unit& u) const {
        const long L = (long)i * G + c; if (L >= nwg) return false;
        int wgid = (int)L; { const int q = nwg / NXCD, r = nwg % NXCD, xcd = wgid % NXCD, off = wgid / NXCD; wgid = (xcd < r ? xcd * (q + 1) : r * (q + 1) + (xcd - r) * q) + off; }
        const int nig = WGM * nN, gid = wgid / nig, fm = gid * WGM, gsz = (nM - fm) < WGM ? (nM - fm) : WGM;
        u.pm = fm + ((wgid % nig) % gsz); u.pn = (wgid % nig) / gsz; return true;
    }
    __device__ __forceinline__ void a_ready(const Unit&) const {}
    __device__ __forceinline__ void done(const Unit&) const {}
};

struct ListSched {
    int nM0, nN0, m1, nM1, n1, nN1, n0, ntot, G, c;
    __device__ void init(int nM0_, int nN0_, int m1_, int nM1_, int n1_, int nN1_, int G_, int c_) { nM0 = nM0_; nN0 = nN0_; m1 = m1_; nM1 = nM1_; n1 = n1_; nN1 = nN1_; n0 = nM0_ * nN0_; ntot = n0 + nM1_ * nN1_; G = G_; c = c_; }
    __device__ bool next(int i, Unit& u) const {
        const long L = (long)i * G + c; if (L >= ntot) return false;
        if (L < n0) {
            int wgid = (int)L; const int nwg = n0; { const int q = nwg / NXCD, r = nwg % NXCD, xcd = wgid % NXCD, off = wgid / NXCD; wgid = (xcd < r ? xcd * (q + 1) : r * (q + 1) + (xcd - r) * q) + off; }
            const int nig = WGM * nN0, gid = wgid / nig, fm = gid * WGM, gsz = (nM0 - fm) < WGM ? (nM0 - fm) : WGM;
            u.pm = fm + ((wgid % nig) % gsz); u.pn = (wgid % nig) / gsz;
        } else { const int r = (int)L - n0; u.pm = m1 + r % nM1; u.pn = n1 + r / nM1; }
        return true;
    }
    __device__ __forceinline__ void a_ready(const Unit&) const {}
    __device__ __forceinline__ void done(const Unit&) const {}
};
__device__ __forceinline__ unsigned cvt_pk_bf16(float lo, float hi) { unsigned r; asm volatile("v_cvt_pk_bf16_f32 %0, %1, %2" : "=v"(r) : "v"(lo), "v"(hi)); return r; }
__device__ __forceinline__ float bf_lo(unsigned w) { return __builtin_bit_cast(float, w << 16); }
__device__ __forceinline__ float bf_hi(unsigned w) { return __builtin_bit_cast(float, w & 0xffff0000u); }
constexpr float RMS_EPS = 1e-6f;
__device__ __forceinline__ float row_rstd(const float* ssq, int row, int fq) {
    const f32x4 p = *(const f32x4*)(ssq + (size_t)row * 16 + 4 * fq);
    float s = (p[0] + p[1]) + (p[2] + p[3]); s += __shfl_xor(s, 16); s += __shfl_xor(s, 32);
    return __builtin_amdgcn_rsqf(s * (1.0f / 1024.0f) + RMS_EPS);
}
__device__ __forceinline__ float sigm(float x) { return __builtin_amdgcn_rcpf(1.0f + __builtin_amdgcn_exp2f(-1.4426950408889634f * x)); }
typedef float f32x2p __attribute__((ext_vector_type(2)));
__device__ __forceinline__ f32x2p sigm2_of_t(f32x2p t2) { f32x2p a; a.x = __builtin_amdgcn_exp2f(t2.x); a.y = __builtin_amdgcn_exp2f(t2.y); a = a + 1.0f; f32x2p s; s.x = __builtin_amdgcn_rcpf(a.x); s.y = __builtin_amdgcn_rcpf(a.y); return s; }

struct EpiProj {
    static constexpr bool PERM = true, AFTER_DRAIN = false;
    const float* ssq; bf16_t* proj; float* kvraw; float* pmk; float* pmv; int npt;
    __device__ __forceinline__ void operator()(const f32x4 (&acc)[2][2][4][2], const Unit& u, int wr, int wc, int fr, int fq) const {
        const int row0 = u.pm * BM + wr * 64 + fr, cl = wc * 32 + 8 * fq;
#pragma unroll
        for (int ai = 0; ai < 2; ++ai)
#pragma unroll
            for (int m = 0; m < 4; ++m) {
                const int row = row0 + ai * HALF + m * 16; const float rs = row_rstd(ssq, row, fq);
                if (u.pm < npt) {
                    if (u.pn < 4) { bf16_t* rowp = proj + (size_t)row * 1024 + u.pn * BM + cl;
#pragma unroll
                        for (int bj = 0; bj < 2; ++bj) { const f32x4 v0 = acc[ai][bj][m][0] * rs, v1 = acc[ai][bj][m][1] * rs; u32x4 w; w.x = cvt_pk_bf16(v0[0], v0[1]); w.y = cvt_pk_bf16(v0[2], v0[3]); w.z = cvt_pk_bf16(v1[0], v1[1]); w.w = cvt_pk_bf16(v1[2], v1[3]); *(u32x4*)(rowp + bj * HALF) = w; }
                    } else { float* rowp = kvraw + (size_t)row * 512 + (u.pn - 4) * BM + cl;
#pragma unroll
                        for (int bj = 0; bj < 2; ++bj) { *(f32x4*)(rowp + bj * HALF) = acc[ai][bj][m][0] * rs; *(f32x4*)(rowp + bj * HALF + 4) = acc[ai][bj][m][1] * rs; }
                    }
                } else { const int t = u.pn - 4; float* rowp = ((t & 1) ? pmv : pmk) + (size_t)(t >> 1) * 262144 + (size_t)(row - npt * BM) * 256 + cl;
#pragma unroll
                    for (int bj = 0; bj < 2; ++bj) { *(f32x4*)(rowp + bj * HALF) = acc[ai][bj][m][0] * rs; *(f32x4*)(rowp + bj * HALF + 4) = acc[ai][bj][m][1] * rs; }
                }
            }
    }
};
struct EpiGlu {
    static constexpr bool PERM = true, AFTER_DRAIN = false;
    const bf16_t* y; bf16_t* out;
    __device__ __forceinline__ void operator()(const f32x4 (&acc)[2][2][4][2], const Unit& u, int wr, int wc, int fr, int fq) const {
        const int row0 = u.pm * BM + wr * 64 + fr, col0 = u.pn * BM + wc * 32 + 8 * fq;
#pragma unroll
        for (int ai = 0; ai < 2; ++ai)
#pragma unroll
            for (int m = 0; m < 4; ++m) { const int row = row0 + ai * HALF + m * 16;
#pragma unroll
                for (int bj = 0; bj < 2; ++bj) { const u32x4 yw = *(const u32x4*)(y + (size_t)row * 768 + col0 + bj * HALF); const f32x4 z0 = acc[ai][bj][m][0], z1 = acc[ai][bj][m][1]; u32x4 w;
                    { const float nl = -1.4426950408889634f;
                      const f32x2p s0 = sigm2_of_t((f32x2p){z0[0], z0[1]} * nl), s1 = sigm2_of_t((f32x2p){z0[2], z0[3]} * nl), s2 = sigm2_of_t((f32x2p){z1[0], z1[1]} * nl), s3 = sigm2_of_t((f32x2p){z1[2], z1[3]} * nl);
                      const f32x2p p0 = (f32x2p){bf_lo(yw.x), bf_hi(yw.x)} * s0, p1 = (f32x2p){bf_lo(yw.y), bf_hi(yw.y)} * s1, p2 = (f32x2p){bf_lo(yw.z), bf_hi(yw.z)} * s2, p3 = (f32x2p){bf_lo(yw.w), bf_hi(yw.w)} * s3;
                      w.x = cvt_pk_bf16(p0.x, p0.y); w.y = cvt_pk_bf16(p1.x, p1.y); w.z = cvt_pk_bf16(p2.x, p2.y); w.w = cvt_pk_bf16(p3.x, p3.y); }
                    *(u32x4*)(out + (size_t)row * 1024 + col0 + bj * HALF) = w; } }
    }
};
struct EpiSwiglu {
    static constexpr bool PERM = true, AFTER_DRAIN = false;
    const float* ssq; bf16_t* out;
    __device__ __forceinline__ void operator()(const f32x4 (&acc)[2][2][4][2], const Unit& u, int wr, int wc, int fr, int fq) const {
        const int row0 = u.pm * BM + wr * 64 + fr, col0 = u.pn * HALF + wc * 32 + 8 * fq;
#pragma unroll
        for (int ai = 0; ai < 2; ++ai)
#pragma unroll
            for (int m = 0; m < 4; ++m) { const int row = row0 + ai * HALF + m * 16;
                const float rs = row_rstd(ssq, row, fq);
                const float c1 = -1.4426950408889634f * rs, rs2 = rs * rs;
                f32x2p o2[4];
#pragma unroll
                for (int n = 0; n < 2; ++n)
#pragma unroll
                    for (int h = 0; h < 2; ++h) { const f32x2p g2 = {acc[ai][0][m][n][2 * h], acc[ai][0][m][n][2 * h + 1]}, u2 = {acc[ai][1][m][n][2 * h], acc[ai][1][m][n][2 * h + 1]};
                        o2[2 * n + h] = ((g2 * u2) * rs2) * sigm2_of_t(g2 * c1); }
                u32x4 w; w.x = cvt_pk_bf16(o2[0].x, o2[0].y); w.y = cvt_pk_bf16(o2[1].x, o2[1].y); w.z = cvt_pk_bf16(o2[2].x, o2[2].y); w.w = cvt_pk_bf16(o2[3].x, o2[3].y);
                *(u32x4*)(out + (size_t)row * 2816 + col0) = w; }
    }
};
struct EpiResid {
    static constexpr bool PERM = true, AFTER_DRAIN = false;
    const float* xin; const bf16_t* hin; bf16_t* hb; float* ssq_out; float* yout;
    template <bool XIN>
    __device__ __forceinline__ void body(const f32x4 (&acc)[2][2][4][2], const Unit& u, int wr, int wc, int fr, int fq) const {
        const int row0 = u.pm * BM + wr * 64 + fr, col0 = u.pn * BM + wc * 32 + 8 * fq;
#pragma unroll
        for (int ai = 0; ai < 2; ++ai) {
            u32x4 hw[4][2];
            if (!XIN) {
#pragma unroll
                for (int m = 0; m < 4; ++m)
#pragma unroll
                    for (int bj = 0; bj < 2; ++bj) hw[m][bj] = *(const u32x4*)(hin + (size_t)(row0 + ai * HALF + m * 16) * 1024 + col0 + bj * HALF);
            }
#pragma unroll
            for (int mh = 0; mh < 2; ++mh) {
                f32x4 xv[2][2][2];
                if (XIN) {
#pragma unroll
                    for (int ml = 0; ml < 2; ++ml)
#pragma unroll
                        for (int bj = 0; bj < 2; ++bj) { const float* xp = xin + (size_t)(row0 + ai * HALF + (2 * mh + ml) * 16) * 1024 + col0 + bj * HALF; xv[ml][bj][0] = *(const f32x4*)xp; xv[ml][bj][1] = *(const f32x4*)(xp + 4); }
                }
#pragma unroll
                for (int ml = 0; ml < 2; ++ml) { const int m = 2 * mh + ml, row = row0 + ai * HALF + m * 16; f32x2p ss2 = {0.f, 0.f};
#pragma unroll
                    for (int bj = 0; bj < 2; ++bj) { const size_t off = (size_t)row * 1024 + col0 + bj * HALF; f32x4 v0, v1;
                        if (XIN) { v0 = xv[ml][bj][0]; v1 = xv[ml][bj][1]; }
                        else { const u32x4 h = hw[m][bj]; v0 = (f32x4){bf_lo(h.x), bf_hi(h.x), bf_lo(h.y), bf_hi(h.y)}; v1 = (f32x4){bf_lo(h.z), bf_hi(h.z), bf_lo(h.w), bf_hi(h.w)}; }
                        v0 += acc[ai][bj][m][0]; v1 += acc[ai][bj][m][1];
                        if (yout) { *(f32x4*)(yout + off) = v0; *(f32x4*)(yout + off + 4) = v1; }
                        u32x4 w; w.x = cvt_pk_bf16(v0[0], v0[1]); w.y = cvt_pk_bf16(v0[2], v0[3]); w.z = cvt_pk_bf16(v1[0], v1[1]); w.w = cvt_pk_bf16(v1[2], v1[3]);
                        *(u32x4*)(hb + off) = w;
                        { const f32x2p a0 = {v0[0], v0[1]}, a1 = {v0[2], v0[3]}, a2 = {v1[0], v1[1]}, a3 = {v1[2], v1[3]}; ss2 = a0 * a0 + ss2; ss2 = a1 * a1 + ss2; ss2 = a2 * a2 + ss2; ss2 = a3 * a3 + ss2; } }
                    float ss = ss2.x + ss2.y; ss += __shfl_xor(ss, 16); ss += __shfl_xor(ss, 32);
                    if (fq == 0) ssq_out[(size_t)row * 16 + 4 * u.pn + wc] = ss; }
            }
        }
    }
    __device__ __forceinline__ void operator()(const f32x4 (&acc)[2][2][4][2], const Unit& u, int wr, int wc, int fr, int fq) const {
        if (xin) body<true>(acc, u, wr, wc, fr, fq); else body<false>(acc, u, wr, wc, fr, fq);
    }
};

template <class Epi, class Sched, bool ALIGN_EPI = false, bool SP2 = false>
__device__ __forceinline__ void gemm_phase(PG8_LAS unsigned char* lds, const Gemm g, const Sched& S, const Epi& E) {
    int tid_ = threadIdx.x; asm volatile("" : "+v"(tid_)); const int tid = tid_, wid = __builtin_amdgcn_readfirstlane(tid >> 6), lane = tid & 63, wr = wid >> 2, wc = wid & 3, fr = lane & 15, fq = lane >> 4;
    const int K = g.K, nt = K / BK;
    unsigned voffA[2], voffB[2];
#pragma unroll
    for (int i = 0; i < 2; ++i) { int R, C; stage_rc(tid * 16 + i * 8192, R, C); const int Rb = Epi::PERM ? ((R & ~31) + perm32(R & 31)) : R;
        voffA[i] = (unsigned)(R * K + C) * 2u; voffB[i] = (unsigned)(Rb * K + C) * 2u; }
    const size_t kstep = (size_t)(BK * 2);
    const size_t hstep = (size_t)HALF * K * 2;
    const size_t tstep = 2 * hstep;
    const unsigned ldsw = (unsigned)wid * 1024u;
    const int aoff = lds_byte(wr * 64 + fr, fq * 8), boff = lds_byte(wc * 32 + fr, fq * 8);
#define PG8_SA(b, h) (((b) * 2 + (h)) * HTB)
#define PG8_SB(b, h) ((4 + (b) * 2 + (h)) * HTB)
#define PG8_STAGE(bufoff, gbase, voff) do { _Pragma("unroll") for (int _i = 0; _i < 2; ++_i) \
        __builtin_amdgcn_global_load_lds((const unsigned*)((const char*)(gbase) + (voff)[_i]), (PG8_LAS unsigned*)(lds + (bufoff) + ldsw + _i * 8192), 16, 0, 0); } while (0)
#define PG8_LDA(dst, b, h) do { _Pragma("unroll") for (int m = 0; m < 4; ++m) _Pragma("unroll") for (int k = 0; k < 2; ++k) dst[m][k] = *(const PG8_LAS bf16x8*)(lds + PG8_SA(b, h) + aoff + m * 2048 + k * 1024); } while (0)
#define PG8_LDB(dst, b, h) do { _Pragma("unroll") for (int n = 0; n < 2; ++n) _Pragma("unroll") for (int k = 0; k < 2; ++k) dst[n][k] = *(const PG8_LAS bf16x8*)(lds + PG8_SB(b, h) + boff + n * 2048 + k * 1024); } while (0)
#define PG8_MMA(ai, bj, At, Bt) do { __builtin_amdgcn_s_setprio(1); _Pragma("unroll") for (int m = 0; m < 4; ++m) _Pragma("unroll") for (int n = 0; n < 2; ++n) _Pragma("unroll") for (int k = 0; k < 2; ++k) \
        acc[ai][bj][m][n] = __builtin_amdgcn_mfma_f32_16x16x32_bf16(Bt[n][k], At[m][k], acc[ai][bj][m][n], 0, 0, 0); __builtin_amdgcn_s_setprio(0); } while (0)
#define PG8_WAIT_V(n) asm volatile("s_waitcnt vmcnt(" #n ")" ::: "memory")
#define PG8_WAIT_L(n) asm volatile("s_waitcnt lgkmcnt(" #n ")" ::: "memory")
#define PG8_BAR __builtin_amdgcn_s_barrier()
#define PG8_SCHED __builtin_amdgcn_sched_barrier(0)
    Unit cur, nxt; int ui = 0;
    if (!S.next(0, cur)) return;
    f32x4 acc[2][2][4][2];
#pragma unroll
    for (int a = 0; a < 2; ++a)
#pragma unroll
        for (int b = 0; b < 2; ++b)
#pragma unroll
            for (int m = 0; m < 4; ++m)
#pragma unroll
                for (int n = 0; n < 2; ++n) acc[a][b][m][n] = (f32x4){0.f, 0.f, 0.f, 0.f};
    bf16x8 At[4][2], B0[2][2], B1[2][2];
    const char* cA = (const char*)g.A + (size_t)cur.pm * tstep; const char* cB = (const char*)g.Bt + (size_t)cur.pn * tstep;
    S.a_ready(cur);
    if constexpr (SP2) {
        PG8_STAGE(PG8_SB(0, 0), cB, voffB); PG8_STAGE(PG8_SB(0, 1), cB + hstep, voffB); PG8_STAGE(PG8_SA(0, 0), cA, voffA); PG8_STAGE(PG8_SA(0, 1), cA + hstep, voffA);
        if (wr == 1) PG8_BAR;
        PG8_WAIT_V(2); PG8_BAR;
        PG8_STAGE(PG8_SB(1, 0), cB + kstep, voffB); PG8_STAGE(PG8_SA(1, 0), cA + kstep, voffA); PG8_STAGE(PG8_SB(1, 1), cB + hstep + kstep, voffB);
        PG8_WAIT_V(6); PG8_BAR;
    } else {
        PG8_STAGE(PG8_SB(0, 0), cB, voffB); PG8_STAGE(PG8_SA(0, 0), cA, voffA); PG8_STAGE(PG8_SB(0, 1), cB + hstep, voffB); PG8_STAGE(PG8_SA(0, 1), cA + hstep, voffA);
        if (wr == 1) PG8_BAR;
        PG8_WAIT_V(4); PG8_BAR;
        PG8_STAGE(PG8_SB(1, 0), cB + kstep, voffB); PG8_STAGE(PG8_SA(1, 0), cA + kstep, voffA); PG8_STAGE(PG8_SB(1, 1), cB + hstep + kstep, voffB);
        PG8_WAIT_V(6); PG8_BAR;
    }
    for (;;) {
        const bool has_next = S.next(ui + 1, nxt);
        const char* nA = has_next ? (const char*)g.A + (size_t)nxt.pm * tstep : cA; const char* nB = has_next ? (const char*)g.Bt + (size_t)nxt.pn * tstep : cB;
        for (int t = 0; t < nt; t += 2) {
            const bool last = (t == nt - 2);
            const char* a1 = cA + (size_t)(t + 1) * kstep;
            const char* a2 = last ? nA : cA + (size_t)(t + 2) * kstep; const char* b2 = last ? nB : cB + (size_t)(t + 2) * kstep;
            const char* a3 = a2 + kstep; const char* b3 = b2 + kstep;
            if (last && has_next) S.a_ready(nxt);
            if constexpr (SP2) {
            PG8_LDB(B0, 0, 0); PG8_LDB(B1, 0, 1); PG8_SCHED; PG8_LDA(At, 0, 0); PG8_STAGE(PG8_SA(1, 1), a1 + hstep, voffA);
            PG8_WAIT_V(8); PG8_WAIT_L(0); PG8_BAR; PG8_MMA(0, 0, At, B0); PG8_MMA(0, 1, At, B1); PG8_BAR; PG8_SCHED;
            PG8_LDA(At, 0, 1); PG8_STAGE(PG8_SB(0, 0), b2, voffB); PG8_STAGE(PG8_SB(0, 1), b2 + hstep, voffB); PG8_STAGE(PG8_SA(0, 0), a2, voffA);
            PG8_WAIT_V(8); PG8_WAIT_L(0); PG8_BAR; PG8_MMA(1, 0, At, B0); PG8_MMA(1, 1, At, B1); PG8_BAR; PG8_SCHED;
            PG8_LDB(B0, 1, 0); PG8_LDB(B1, 1, 1); PG8_SCHED; PG8_LDA(At, 1, 0); PG8_STAGE(PG8_SA(0, 1), a2 + hstep, voffA);
            PG8_WAIT_V(8); PG8_WAIT_L(0); PG8_BAR; PG8_MMA(0, 0, At, B0); PG8_MMA(0, 1, At, B1); PG8_BAR; PG8_SCHED;
            PG8_LDA(At, 1, 1); PG8_STAGE(PG8_SB(1, 0), b3, voffB); PG8_STAGE(PG8_SB(1, 1), b3 + hstep, voffB); PG8_STAGE(PG8_SA(1, 0), a3, voffA);
            PG8_WAIT_V(8); PG8_WAIT_L(0); PG8_BAR; PG8_MMA(1, 0, At, B0); PG8_MMA(1, 1, At, B1); PG8_BAR; PG8_SCHED;
            } else {
            PG8_LDB(B0, 0, 0); PG8_SCHED; PG8_LDA(At, 0, 0); PG8_STAGE(PG8_SA(1, 1), a1 + hstep, voffA);
            PG8_WAIT_L(8); PG8_BAR; PG8_WAIT_L(0); PG8_MMA(0, 0, At, B0); PG8_BAR; PG8_SCHED;
            PG8_LDB(B1, 0, 1); PG8_STAGE(PG8_SB(0, 0), b2, voffB);
            PG8_BAR; PG8_WAIT_L(0); PG8_MMA(0, 1, At, B1); PG8_BAR;
            PG8_LDA(At, 0, 1); PG8_STAGE(PG8_SA(0, 0), a2, voffA);
            PG8_BAR; PG8_WAIT_L(0); PG8_MMA(1, 0, At, B0); PG8_BAR; PG8_SCHED;
            PG8_STAGE(PG8_SB(0, 1), b2 + hstep, voffB);
            PG8_WAIT_V(6); PG8_BAR; PG8_MMA(1, 1, At, B1); PG8_BAR;
            PG8_LDB(B0, 1, 0); PG8_SCHED; PG8_LDA(At, 1, 0); PG8_STAGE(PG8_SA(0, 1), a2 + hstep, voffA);
            PG8_WAIT_L(8); PG8_BAR; PG8_WAIT_L(0); PG8_MMA(0, 0, At, B0); PG8_BAR; PG8_SCHED;
            PG8_LDB(B1, 1, 1); PG8_STAGE(PG8_SB(1, 0), b3, voffB);
            PG8_BAR; PG8_WAIT_L(0); PG8_MMA(0, 1, At, B1); PG8_BAR;
            PG8_LDA(At, 1, 1); PG8_STAGE(PG8_SA(1, 0), a3, voffA);
            PG8_BAR; PG8_WAIT_L(0); PG8_MMA(1, 0, At, B0); PG8_BAR; PG8_SCHED;
            PG8_STAGE(PG8_SB(1, 1), b3 + hstep, voffB);
            PG8_WAIT_V(6); PG8_BAR; PG8_MMA(1, 1, At, B1); PG8_BAR;
            }
        }
        if constexpr (ALIGN_EPI) { if (wr == 0) PG8_BAR; }
        if constexpr (!Epi::AFTER_DRAIN) { E(acc, cur, wr, wc, fr, fq); S.done(cur); }
        if (!has_next) break;
#pragma unroll
        for (int a = 0; a < 2; ++a)
#pragma unroll
            for (int b = 0; b < 2; ++b)
#pragma unroll
                for (int m = 0; m < 4; ++m)
#pragma unroll
                    for (int n = 0; n < 2; ++n) acc[a][b][m][n] = (f32x4){0.f, 0.f, 0.f, 0.f};
        cur = nxt; cA = nA; cB = nB; ++ui;
        if constexpr (ALIGN_EPI) { if (wr == 1) PG8_BAR; }
    }
    PG8_WAIT_V(0);
    if constexpr (!ALIGN_EPI) { if (wr == 0) PG8_BAR; }
    PG8_BAR;
    if constexpr (Epi::AFTER_DRAIN) { E.fused(acc, cur, wr, wc, fr, fq, lds, wid, lane); S.done(cur); }
#undef PG8_SA
#undef PG8_SB
#undef PG8_STAGE
#undef PG8_LDA
#undef PG8_LDB
#undef PG8_MMA
#undef PG8_WAIT_V
#undef PG8_WAIT_L
#undef PG8_BAR
#undef PG8_SCHED
}
}
namespace attn_body {
typedef unsigned short bf16;
using bf16x8=__attribute__((ext_vector_type(8)))short;
using s16x4=__attribute__((ext_vector_type(4)))short;
using f32x16=__attribute__((ext_vector_type(16)))float;
using u32x4=__attribute__((ext_vector_type(4)))unsigned;
constexpr int D=64,QP=1024,KVP=256,OP=1024;
constexpr int NW=8,QBLK=32,QB=QBLK*NW,KVBLK=64;
constexpr float NEGB=-1.0e30f;
__device__ __forceinline__ int crow(int r,int hi){return (r&3)+8*(r>>2)+4*hi;}
#define SBAR() __builtin_amdgcn_sched_barrier(0)
__device__ __forceinline__ void cmask(f32x16&p0,f32x16&p1,int jb,int qrel,int hi){
  const float NEG=-INFINITY; int kb=64*jb+4*hi;
  #pragma unroll
  for(int r=0;r<16;++r){int kv=kb+(r&3)+8*(r>>2); if(kv>qrel)p0[r]=NEG; if(kv+32>qrel)p1[r]=NEG;}
}

constexpr int NSLOT=3, SLOTB=8192;
constexpr int LDS_K=0, LDS_V=NSLOT*SLOTB, LDS_WS=2*NSLOT*SLOTB, LDS_OST=LDS_WS+NW*64*4, LDS_BYTES=LDS_OST+NW*4096;
constexpr float C2=0.125f*1.4426950408889634f;
__device__ __forceinline__ void glds16(const void*sbase,unsigned voff,unsigned lds_dst){unsigned keep;
  const unsigned long long sb0=(unsigned long long)sbase; const unsigned long long sb=((unsigned long long)(unsigned)__builtin_amdgcn_readfirstlane((unsigned)(sb0>>32))<<32)|(unsigned)__builtin_amdgcn_readfirstlane((unsigned)sb0);
  asm volatile("s_mov_b32 %0, m0\n\ts_mov_b32 m0, %3\n\ts_nop 0\n\tglobal_load_lds_dwordx4 %1, %2\n\ts_mov_b32 m0, %0":"=&s"(keep):"v"(voff),"s"(sb),"s"(lds_dst):"memory");}
__device__ __forceinline__ float max3f(float a,float b,float c){float r;asm("v_max3_f32 %0, %1, %2, %3":"=v"(r):"v"(a),"v"(b),"v"(c));return r;}
__device__ __forceinline__ float max2f(float a,float b){float r;asm("v_max_f32_e32 %0, %1, %2":"=v"(r):"v"(a),"v"(b));return r;}
__device__ __forceinline__ float fadd_s(float a,float b){float r;asm("v_add_f32_e32 %0, %1, %2":"=v"(r):"v"(a),"v"(b));return r;}
__device__ __forceinline__ float fsub_s(float a,float b){float r;asm("v_sub_f32_e32 %0, %1, %2":"=v"(r):"v"(a),"v"(b));return r;}
typedef float f32x2_t __attribute__((ext_vector_type(2))); typedef float f32x4_t __attribute__((ext_vector_type(4))); typedef __bf16 bf16x2_t __attribute__((ext_vector_type(2)));
__device__ __forceinline__ unsigned cvtpk_s(float lo,float hi){f32x2_t v={lo,hi};bf16x2_t b=__builtin_convertvector(v,bf16x2_t);return __builtin_bit_cast(unsigned,b);}
#define WAIT_BAR(N) asm volatile("s_waitcnt vmcnt(" #N ") lgkmcnt(0)\n\ts_barrier":::"memory")

__device__ __forceinline__ void qkt(f32x16&p0,f32x16&p1,const char*Kslot,const bf16x8*qr,const f32x16&negm,int r32,int hi){
  const char*kb=Kslot+hi*1024+r32*16;
  #pragma unroll
  for(int d0=0;d0<4;++d0){
    const bf16x8 b0=*reinterpret_cast<const bf16x8*>(kb+d0*2048);
    const bf16x8 b1=*reinterpret_cast<const bf16x8*>(kb+d0*2048+512);
    if(d0==0){p0=__builtin_amdgcn_mfma_f32_32x32x16_bf16(b0,qr[0],negm,0,0,0);p1=__builtin_amdgcn_mfma_f32_32x32x16_bf16(b1,qr[0],negm,0,0,0);}
    else{p0=__builtin_amdgcn_mfma_f32_32x32x16_bf16(b0,qr[d0],p0,0,0,0);p1=__builtin_amdgcn_mfma_f32_32x32x16_bf16(b1,qr[d0],p1,0,0,0);}}
}
typedef __attribute__((address_space(3))) const char* lds_cptr;
typedef short v4i16_t __attribute__((ext_vector_type(4)));
__device__ __forceinline__ void kload8(bf16x8*kf,lds_cptr kp){
  kf[0]=*(const __attribute__((address_space(3))) bf16x8*)(kp);      kf[1]=*(const __attribute__((address_space(3))) bf16x8*)(kp+512);
  kf[2]=*(const __attribute__((address_space(3))) bf16x8*)(kp+2048); kf[3]=*(const __attribute__((address_space(3))) bf16x8*)(kp+2560);
  kf[4]=*(const __attribute__((address_space(3))) bf16x8*)(kp+4096); kf[5]=*(const __attribute__((address_space(3))) bf16x8*)(kp+4608);
  kf[6]=*(const __attribute__((address_space(3))) bf16x8*)(kp+6144); kf[7]=*(const __attribute__((address_space(3))) bf16x8*)(kp+6656);
}
__device__ __forceinline__ void kload2(bf16x8*kf,lds_cptr kp,int j){ kf[2*j]=*(const __attribute__((address_space(3))) bf16x8*)(kp+j*2048); kf[2*j+1]=*(const __attribute__((address_space(3))) bf16x8*)(kp+j*2048+512); }
__device__ __forceinline__ s16x4 vtr(lds_cptr p){ return __builtin_bit_cast(s16x4,__builtin_amdgcn_ds_read_tr16_b64_v4i16((__attribute__((address_space(3))) v4i16_t*)p)); }
__device__ __forceinline__ float rowmax(const f32x16&p0,const f32x16&p1){
  float a=max3f(p0[0],p0[1],p1[0]),b=max3f(p0[2],p0[3],p1[1]);a=max3f(a,p1[2],p1[3]);
  #pragma unroll
  for(int r=4;r<16;r+=4){a=max3f(a,p0[r],p0[r+1]);b=max3f(b,p0[r+2],p0[r+3]);a=max3f(a,p1[r],p1[r+1]);b=max3f(b,p1[r+2],p1[r+3]);}
  const float m=max2f(a,b);
  auto rr=__builtin_amdgcn_permlane32_swap(__float_as_uint(m),__float_as_uint(m),false,false);
  return max2f(__uint_as_float(rr[0]),__uint_as_float(rr[1]));
}
__device__ __forceinline__ void pv(f32x16*o,int vb,bf16x8 pa0,bf16x8 pa1,bf16x8 pa2,bf16x8 pa3){
  #pragma unroll
  for(int d0=0;d0<2;++d0){s16x4 lo[4],hi[4];
    #pragma unroll
    for(int ks=0;ks<4;++ks){
      asm volatile("ds_read_b64_tr_b16 %0,%1 offset:%c2":"=&v"(lo[ks]):"v"(vb),"i"(d0*4096+ks*1024):"memory");
      asm volatile("ds_read_b64_tr_b16 %0,%1 offset:%c2":"=&v"(hi[ks]):"v"(vb),"i"(d0*4096+ks*1024+512):"memory");}
    asm volatile("s_waitcnt lgkmcnt(0)":::"memory");SBAR();
    #define PK(k) (bf16x8){lo[k][0],lo[k][1],lo[k][2],lo[k][3],hi[k][0],hi[k][1],hi[k][2],hi[k][3]}
    o[d0]=__builtin_amdgcn_mfma_f32_32x32x16_bf16(pa0,PK(0),o[d0],0,0,0);
    o[d0]=__builtin_amdgcn_mfma_f32_32x32x16_bf16(pa1,PK(1),o[d0],0,0,0);
    o[d0]=__builtin_amdgcn_mfma_f32_32x32x16_bf16(pa2,PK(2),o[d0],0,0,0);
    o[d0]=__builtin_amdgcn_mfma_f32_32x32x16_bf16(pa3,PK(3),o[d0],0,0,0);
    #undef PK
  }
}

#ifndef ATTN_STORE16
#define ATTN_STORE16(p,v) (*(u32x4*)(p)=(v))
#endif
template<int MODE,int THRL> __device__ __forceinline__ void attn_unit(int qb,const bf16*Qu,const bf16*__restrict__ Kh,const bf16*__restrict__ Vh,bf16*Ou,const float*__restrict__ gq,const bf16*__restrict__ kmean,char*shm){
  int tid_=threadIdx.x; asm volatile("":"+v"(tid_));   const int tid=tid_,lane=tid&63,r32=lane&31,hi=lane>>5; const int wid=__builtin_amdgcn_readfirstlane(tid>>6);
  const bf16*Qw=Qu+(long)(wid*QBLK)*QP;
  const unsigned lds0=(unsigned)(uintptr_t)shm;
  float*wsf=(float*)(shm+LDS_WS)+wid*64;
  const int NT=(MODE==1)?4*(qb+1):4;
  const unsigned kvoff=(unsigned)(lane*KVP+wid*8)*2u;
  const unsigned vvoff=(unsigned)((16*(wid&3)+(lane>>2))*KVP+(wid>>2)*32+(lane&3)*8)*2u;
  const unsigned kdst=lds0+LDS_K+wid*1024, vdst=lds0+LDS_V+wid*1024;
  #define TMAP(t) ((MODE==1)?(((t)<4)?(NT-4+(t)):((t)-4)):(t))
  #define DMA_K(t,slot) glds16(Kh+(long)TMAP(t)*KVBLK*KVP,kvoff,(unsigned)__builtin_amdgcn_readfirstlane(kdst+(slot)))
  #define DMA_V(t,slot) glds16(Vh+(long)TMAP(t)*KVBLK*KVP,vvoff,(unsigned)__builtin_amdgcn_readfirstlane(vdst+(slot)))
  const int vb0=(int)(lds0+LDS_V)+((lane>>4)&1)*32+(lane&3)*8+(4*hi+((lane&15)>>2))*64;
  const char*Kbase=shm+LDS_K; bf16x8 kf[8];
  const lds_cptr shm3=(lds_cptr)shm; const lds_cptr kp0=shm3+LDS_K+hi*1024+r32*16; const lds_cptr vp0=shm3+LDS_V+((lane>>4)&1)*32+(lane&3)*8+(4*hi+((lane&15)>>2))*64;
  DMA_K(0,0);DMA_V(0,0);DMA_K(1,SLOTB);
  bf16x8 qr[4]; unsigned sel=0u;
  { bf16x8 qraw[4]; f32x4_t gg[8]; bf16x8 kmf[4];
    #pragma unroll
    for(int d0=0;d0<4;++d0)qraw[d0]=*reinterpret_cast<const bf16x8*>(&Qw[(long)r32*QP+d0*16+hi*8]);
    #pragma unroll
    for(int d0=0;d0<4;++d0){gg[2*d0]=*reinterpret_cast<const f32x4_t*>(gq+d0*16+hi*8);gg[2*d0+1]=*reinterpret_cast<const f32x4_t*>(gq+d0*16+hi*8+4);}
    if(MODE==1){
      #pragma unroll
      for(int d0=0;d0<4;++d0){ kmf[d0]=bf16x8{}; if(r32<16)kmf[d0]=*reinterpret_cast<const bf16x8*>(kmean+(long)r32*KVP+d0*16+hi*8); } }
    float qf[32]; float ss=0.f;
    #pragma unroll
    for(int d0=0;d0<4;++d0){
      #pragma unroll
      for(int e=0;e<8;++e){const float v=__uint_as_float(((unsigned)(unsigned short)qraw[d0][e])<<16); qf[d0*8+e]=v; ss+=v*v;} }
    ss+=__shfl_xor(ss,32);
    const float rs=__builtin_amdgcn_rsqf(ss*(1.0f/64.0f)+1e-6f)*C2;
    #pragma unroll
    for(int d0=0;d0<4;++d0){ u32x4 w;
      w[0]=cvtpk_s(qf[d0*8+0]*rs*gg[2*d0][0],qf[d0*8+1]*rs*gg[2*d0][1]); w[1]=cvtpk_s(qf[d0*8+2]*rs*gg[2*d0][2],qf[d0*8+3]*rs*gg[2*d0][3]);
      w[2]=cvtpk_s(qf[d0*8+4]*rs*gg[2*d0+1][0],qf[d0*8+5]*rs*gg[2*d0+1][1]); w[3]=cvtpk_s(qf[d0*8+6]*rs*gg[2*d0+1][2],qf[d0*8+7]*rs*gg[2*d0+1][3]);
      qr[d0]=__builtin_bit_cast(bf16x8,w); }
    if(MODE==1){ if(qb>0){
      f32x16 ga=f32x16{};
      #pragma unroll
      for(int d0=0;d0<4;++d0)ga=__builtin_amdgcn_mfma_f32_32x32x16_bf16(kmf[d0],qr[d0],ga,0,0,0);
      float gv[8];
      #pragma unroll
      for(int r=0;r<8;++r){const int bi=crow(r,hi); gv[r]=(bi<qb)?ga[r]:-INFINITY;}
      #pragma unroll
      for(int k=0;k<3;++k){
        float best=gv[0]; int bidx=0;
        #pragma unroll
        for(int r=1;r<8;++r){ if(gv[r]>best){best=gv[r];bidx=r;} }
        const int bblk=crow(bidx,hi);
        const float obest=__shfl_xor(best,32); const int oblk=__shfl_xor(bblk,32);
        const bool mine=(best>obest)||(best==obest&&bblk<oblk);
        const float wbest=mine?best:obest; const int wblk=mine?bblk:oblk;
        if(wbest>-INFINITY)sel|=(1u<<wblk);
        #pragma unroll
        for(int r=0;r<8;++r)gv[r]=(mine&&bidx==r)?-INFINITY:gv[r];
      } } }
  }
  float mhat=0.f,l_reg=0.f;f32x16 o[2];o[0]=f32x16{};o[1]=f32x16{};f32x16 negm=f32x16{};asm volatile("":"+v"(negm));
  const int qrel=wid*QBLK+r32;
  #define CMASK(P0,P1,t) do{ if(MODE==1){ const int jb_=(t); if(jb_<4)cmask(P0,P1,jb_,qrel,hi); } }while(0)
  bool resc=false;
  #define START(P0,P1) do{ const float rm=rowmax(P0,P1); resc=false; \
    { const float dl=rm; mhat=fadd_s(mhat,dl); \
      _Pragma("unroll") for(int r=0;r<16;++r){P0[r]=fsub_s(P0[r],dl);P1[r]=fsub_s(P1[r],dl);} \
      _Pragma("unroll") for(int r=0;r<16;++r)negm[r]=-mhat; asm volatile("":"+v"(negm)); } \
    _Pragma("unroll") for(int r=0;r<16;++r)P0[r]=__builtin_amdgcn_exp2f(P0[r]); }while(0)
  #define RESC() do{ if(resc){ asm volatile("s_waitcnt lgkmcnt(0)":::"memory"); \
      _Pragma("unroll") for(int d_=0;d_<2;++d_) _Pragma("unroll") for(int r=0;r<16;++r)o[d_][r]*=wsf[crow(r,hi)]; } }while(0)
  f32x16 pA0,pA1,pB0,pB1;
  int sl_prev=0,sl_cur=0,sl_next=SLOTB;
  #define ROT() do{sl_prev=sl_cur;sl_cur=sl_next;sl_next=(sl_next==(NSLOT-1)*SLOTB)?0:sl_next+SLOTB;}while(0)
  DMA_K(2,2*SLOTB);
  WAIT_BAR(3);
  qkt(pA0,pA1,Kbase,qr,negm,r32,hi);asm volatile("s_nop 15\n\ts_nop 7":"+v"(pA0),"+v"(pA1));CMASK(pA0,pA1,0);
  START(pA0,pA1);
  _Pragma("unroll") for(int r=0;r<16;++r)pA1[r]=__builtin_amdgcn_exp2f(pA1[r]);
  WAIT_BAR(0);
  DMA_K(3,0);DMA_V(1,SLOTB);
  ROT();
  kload8(kf,kp0+sl_cur);
  WAIT_BAR(2);
  s16x4 vlo[8],vhi[8]; u32x4 pw0,pw1,pw2,pw3;
  #define PKW(P,B) cvtpk_s(P[B],P[B+1])
  #define PAF(k) __builtin_bit_cast(bf16x8,pw##k)
  #define VFR(i) (bf16x8){vlo[i][0],vlo[i][1],vlo[i][2],vlo[i][3],vhi[i][0],vhi[i][1],vhi[i][2],vhi[i][3]}
  #define PIN(x) asm volatile("":"+v"(x))
  #define MX3(a,b,c) __builtin_fmaxf(__builtin_fmaxf((a),(b)),(c))
  #define GAPA(MF,A0,A1,A2,A3,W0,W1,PW) do{ MF; sacc+=A0; sacc+=A1; sacc+=A2; sacc+=A3; PIN(sacc); W0; W1; PIN(PW); SBAR(); }while(0)
  #define EX(v) __builtin_amdgcn_exp2f(v)
  #define GAPB(MF,X,B) do{ MF; X[B]=EX(X[B]); X[B+1]=EX(X[B+1]); X[B+2]=EX(X[B+2]); X[B+3]=EX(X[B+3]); PIN(X); SBAR(); }while(0)
  #define VRD(i) do{ vlo[i]=vtr(vp_+(((i)>>2)*4096+((i)&3)*1024)); vhi[i]=vtr(vp_+(((i)>>2)*4096+((i)&3)*1024+512)); }while(0)
  #define KRD(G,j) do{ if(G){ kload2(kf,kp0+sl_next,j); SBAR(); } }while(0)
  #define STEP(C0,C1,P0,P1,t,GK,GV,GL) do{ SBAR(); \
    const lds_cptr vp_=vp0+sl_prev; \
    VRD(0); SBAR(); float sacc=(P0[0]+P0[1]); \
    GAPA(C0=__builtin_amdgcn_mfma_f32_32x32x16_bf16(kf[0],qr[0],negm,0,0,0), P0[2],P0[3],P0[4],P0[5],     pw0[0]=PKW(P0,0), pw0[1]=PKW(P0,2), pw0); \
    VRD(4); SBAR(); GAPA(C1=__builtin_amdgcn_mfma_f32_32x32x16_bf16(kf[1],qr[0],negm,0,0,0), P0[6],P0[7],P0[8],P0[9],     pw0[2]=PKW(P0,4), pw0[3]=PKW(P0,6), pw0); \
    VRD(1); SBAR(); GAPA(C0=__builtin_amdgcn_mfma_f32_32x32x16_bf16(kf[2],qr[1],C0,0,0,0),   P0[10],P0[11],P0[12],P0[13], pw1[0]=PKW(P0,8), pw1[1]=PKW(P0,10), pw1); \
    VRD(5); SBAR(); GAPA(C1=__builtin_amdgcn_mfma_f32_32x32x16_bf16(kf[3],qr[1],C1,0,0,0),   P0[14],P0[15],P1[0],P1[1],   pw1[2]=PKW(P0,12),pw1[3]=PKW(P0,14), pw1); \
    VRD(2); SBAR(); GAPA(C0=__builtin_amdgcn_mfma_f32_32x32x16_bf16(kf[4],qr[2],C0,0,0,0),   P1[2],P1[3],P1[4],P1[5],     pw2[0]=PKW(P1,0), pw2[1]=PKW(P1,2), pw2); \
    VRD(6); SBAR(); GAPA(C1=__builtin_amdgcn_mfma_f32_32x32x16_bf16(kf[5],qr[2],C1,0,0,0),   P1[6],P1[7],P1[8],P1[9],     pw2[2]=PKW(P1,4), pw2[3]=PKW(P1,6), pw2); \
    VRD(3); SBAR(); GAPA(C0=__builtin_amdgcn_mfma_f32_32x32x16_bf16(kf[6],qr[3],C0,0,0,0),   P1[10],P1[11],P1[12],P1[13], pw3[0]=PKW(P1,8), pw3[1]=PKW(P1,10), pw3); \
    VRD(7); SBAR(); GAPA(C1=__builtin_amdgcn_mfma_f32_32x32x16_bf16(kf[7],qr[3],C1,0,0,0),   P1[14],P1[15],0.f,0.f,       pw3[2]=PKW(P1,12),pw3[3]=PKW(P1,14), pw3); \
    l_reg+=sacc; \
    if(GK){DMA_K((t)+3,sl_cur);} if(GV){DMA_V((t)+1,sl_next);} \
    CMASK(C0,C1,t); \
    { float a=MX3(C0[0],C0[1],C1[0]),b=MX3(C0[2],C0[3],C1[1]); a=MX3(a,C1[2],C1[3]); \
      _Pragma("unroll") for(int r=4;r<16;r+=4){a=MX3(a,C0[r],C0[r+1]);b=MX3(b,C0[r+2],C0[r+3]);a=MX3(a,C1[r],C1[r+1]);b=MX3(b,C1[r+2],C1[r+3]);} \
      float rm=__builtin_fmaxf(a,b); { auto rr=__builtin_amdgcn_permlane32_swap(__float_as_uint(rm),__float_as_uint(rm),false,false); rm=__builtin_fmaxf(__uint_as_float(rr[0]),__uint_as_float(rr[1])); } \
      resc=false; \
      if(__builtin_expect(__any(rm>(float)THRL),0)){ const float dl=__builtin_fmaxf(rm,0.f); mhat+=dl; \
        _Pragma("unroll") for(int r=0;r<16;++r){C0[r]-=dl;C1[r]-=dl;} \
        { const bool ro_=(MODE!=1)||((t)<4)||(((sel>>(((t)-4)>>2))&1u)!=0u); const float nm_=ro_?-mhat:NEGB; _Pragma("unroll") for(int r=0;r<16;++r)negm[r]=nm_; } asm volatile("":"+v"(negm)); \
        const float f=__builtin_amdgcn_exp2f(-dl); l_reg*=f; if(hi==0)wsf[r32]=f; resc=true; } } \
    SBAR(); \
    GAPB(o[0]=__builtin_amdgcn_mfma_f32_32x32x16_bf16(PAF(0),VFR(0),o[0],0,0,0), C0,0); \
    GAPB(o[1]=__builtin_amdgcn_mfma_f32_32x32x16_bf16(PAF(0),VFR(4),o[1],0,0,0), C0,4); \
    KRD(GL,0); GAPB(o[0]=__builtin_amdgcn_mfma_f32_32x32x16_bf16(PAF(1),VFR(1),o[0],0,0,0), C0,8); \
    KRD(GL,1); GAPB(o[1]=__builtin_amdgcn_mfma_f32_32x32x16_bf16(PAF(1),VFR(5),o[1],0,0,0), C0,12); \
    KRD(GL,2); GAPB(o[0]=__builtin_amdgcn_mfma_f32_32x32x16_bf16(PAF(2),VFR(2),o[0],0,0,0), C1,0); \
    KRD(GL,3); GAPB(o[1]=__builtin_amdgcn_mfma_f32_32x32x16_bf16(PAF(2),VFR(6),o[1],0,0,0), C1,4); \
    GAPB(o[0]=__builtin_amdgcn_mfma_f32_32x32x16_bf16(PAF(3),VFR(3),o[0],0,0,0), C1,8); \
    GAPB(o[1]=__builtin_amdgcn_mfma_f32_32x32x16_bf16(PAF(3),VFR(7),o[1],0,0,0), C1,12); \
    }while(0)
  int t=1;
  #define PRE(tt) do{ if(MODE==1){ const int t_=(tt); if(t_>=4&&(t_&3)==0){ const bool ro_=((sel>>((t_-4)>>2))&1u)!=0u; const float nm_=ro_?-mhat:NEGB; _Pragma("unroll") for(int r=0;r<16;++r)negm[r]=nm_; asm volatile("":"+v"(negm)); } } }while(0)
  #define ENDW(tt) do{ if((tt)+3<NT){WAIT_BAR(2);} else if((tt)+2<NT){WAIT_BAR(1);} else {WAIT_BAR(0);} }while(0)
  for(;t+1<NT;t+=2){
    PRE(t);   STEP(pB0,pB1,pA0,pA1,t,(t+3<NT),(t+1<NT),(t+1<NT));       ENDW(t);   RESC(); ROT();
    PRE(t+1); STEP(pA0,pA1,pB0,pB1,t+1,(t+4<NT),(t+2<NT),(t+2<NT));     ENDW(t+1); RESC(); ROT();
  }
  PRE(NT-1); STEP(pB0,pB1,pA0,pA1,NT-1,false,false,false); RESC();
  { float sacc=pB0[0]+pB0[1]; _Pragma("unroll") for(int r=2;r<16;++r)sacc+=pB0[r]; _Pragma("unroll") for(int r=0;r<16;++r)sacc+=pB1[r]; l_reg+=sacc;
    pw0=(u32x4){PKW(pB0,0),PKW(pB0,2),PKW(pB0,4),PKW(pB0,6)};pw1=(u32x4){PKW(pB0,8),PKW(pB0,10),PKW(pB0,12),PKW(pB0,14)};pw2=(u32x4){PKW(pB1,0),PKW(pB1,2),PKW(pB1,4),PKW(pB1,6)};pw3=(u32x4){PKW(pB1,8),PKW(pB1,10),PKW(pB1,12),PKW(pB1,14)};
    SBAR(); pv(o,vb0+sl_cur,PAF(0),PAF(1),PAF(2),PAF(3)); }
  #undef PKW
  #undef PAF
  #undef VFR
  #undef PIN
  #undef MX3
  #undef GAPA
  #undef GAPB
  #undef EX
  #undef VRD
  #undef KRD
  #undef STEP
  #undef ENDW
  {auto rr=__builtin_amdgcn_permlane32_swap(__float_as_uint(l_reg),__float_as_uint(l_reg),false,false);l_reg=__uint_as_float(rr[0])+__uint_as_float(rr[1]);}
  if(hi==0)wsf[32+r32]=l_reg;asm volatile("s_waitcnt lgkmcnt(0)":::"memory");
  float rli[16];
  #pragma unroll
  for(int r=0;r<16;++r)rli[r]=__builtin_amdgcn_rcpf(wsf[32+crow(r,hi)]);
  bf16*Ow=Ou+(long)(wid*QBLK)*OP;
  { bf16*stg=(bf16*)(shm+LDS_OST)+wid*2048;
    #pragma unroll
    for(int r=0;r<16;++r){const int orow=crow(r,hi);
      #pragma unroll
      for(int d0=0;d0<2;++d0)stg[orow*64+d0*32+r32]=(bf16)cvtpk_s(o[d0][r]*rli[r],0.f);}
    asm volatile("s_waitcnt lgkmcnt(0)":::"memory");
    #pragma unroll
    for(int i=0;i<4;++i){const int row=i*8+(lane>>3),ch=lane&7; const u32x4 v=*(const u32x4*)(stg+row*64+ch*8); ATTN_STORE16(Ow+(long)row*OP+ch*8,v);} }
  asm volatile("s_waitcnt lgkmcnt(0)\n\ts_barrier":::"memory");
  #undef DMA_K
  #undef TMAP
  #undef PRE
  #undef DMA_V
  #undef CMASK
  #undef START
  #undef RESC
  #undef ROT
}
constexpr int ATTN_LDS_BYTES=LDS_BYTES;
#undef SBAR
#undef WAIT_BAR
}
constexpr int NWAVES = 8;
constexpr int DM = 1024, NBATCH = 4, SEQ = 4096, MP = NBATCH * SEQ, NS = 128, MT = MP + NS, MROWS = 16640, NPT = MROWS / 256, NPP = MP / 256, MEMR = 1024, AROWS = MROWS + MEMR;
constexpr int MIXW = 768, NG = 48, NST = 64, DFF = 2816, NKVH = 4, NQH = 12;
constexpr float EPS = 1e-6f;
constexpr float C2 = 0.125f * 1.4426950408889634f;
constexpr size_t OFF_Y = 0, OFF_PSR = 16908288, OFF_PSI = 16932864, OFF_PK = 16957440, OFF_PV = 21151744, OFF_PMK = 25346048, OFF_PMV = 26394624,
                 OFF_SSR = 27443200, OFF_SSI = 28229632, OFF_SK = 29016064, OFF_SV = 29048832, OUT_TOTAL = 29081600;
constexpr size_t MiB = 1u << 20;
constexpr size_t WS_CTL = 0, CTL_ZERO_BYTES = 1 * MiB;
constexpr size_t WS_WCAT0 = 2 * MiB, WS_WCAT1 = 8 * MiB, WS_WCAT2 = 10 * MiB, WS_WCAT3 = 13 * MiB;
constexpr size_t WS_WOUT = 15 * MiB;
constexpr size_t WS_WGLU = 23 * MiB, WGLU_STRIDE = 3 * MiB / 2;
constexpr size_t WS_WGU = 26 * MiB, WGU_STRIDE = 11 * MiB;
constexpr size_t WS_WDOWN = 70 * MiB, WDOWN_STRIDE = 11 * MiB / 2;
constexpr size_t WS_HB0 = 92 * MiB;
constexpr size_t WS_SSQ0 = 127 * MiB;
constexpr size_t WS_LAYER = 130 * MiB, LSTRIDE = 226 * MiB;
constexpr size_t LO_PROJ = 0, LO_MIXO = 33 * MiB, LO_HBA = 66 * MiB, LO_HBB = 99 * MiB, LO_FFH = 132 * MiB, LO_SSQA = 222 * MiB, LO_SSQB = 224 * MiB;
constexpr size_t WS_YBUF = 1034 * MiB, YBUF_STRIDE = 25 * MiB;
constexpr size_t WS_KVRAW = 1084 * MiB;
constexpr size_t WS_KBUF = 1117 * MiB, WS_VBUF = 1126 * MiB;
constexpr size_t WS_MEMKB = 1135 * MiB, WS_MEMVB = 1137 * MiB;
constexpr size_t WS_E = 1139 * MiB;
constexpr size_t WS_TAB = 1142 * MiB;
constexpr size_t WS_KMEANP = 1143 * MiB;
constexpr size_t WS_KMEANS = 1144 * MiB;
constexpr size_t WS_KMRAW = 1146 * MiB;
constexpr size_t WS_END = 1150 * MiB;
static_assert(WS_WCAT0 + 3072 * 2048 <= WS_WCAT1 && WS_WCAT2 + 1536 * 2048 <= WS_WCAT3 && WS_WGU + 4 * WGU_STRIDE <= WS_WDOWN && WS_WDOWN + 4 * WDOWN_STRIDE <= WS_HB0, "ws map (weights)");
static_assert(WS_HB0 + (size_t)AROWS * 2048 <= WS_SSQ0 && WS_SSQ0 + (size_t)AROWS * 64 <= WS_LAYER && WS_LAYER + 4 * LSTRIDE <= WS_YBUF && WS_YBUF + 2 * YBUF_STRIDE <= WS_KVRAW, "ws map (1)");
static_assert((size_t)MROWS * 2048 <= 33 * MiB && LO_FFH + (size_t)MROWS * 5632 <= LO_SSQA && LO_SSQA + (size_t)MROWS * 64 <= LO_SSQB && LO_SSQB + (size_t)MROWS * 64 <= LSTRIDE && (size_t)MROWS * 1536 <= YBUF_STRIDE, "ws map (layer)");
static_assert(WS_KVRAW + (size_t)MROWS * 2048 <= WS_KBUF && WS_KBUF + (size_t)MROWS * 512 <= WS_VBUF && WS_VBUF + (size_t)MROWS * 512 <= WS_MEMKB && WS_KMRAW + 4u * 1024 * 256 * 4 <= WS_END, "ws map (2)");
constexpr int CW_QUEUE = 131072;
#ifndef ND_FIRST
#define ND_FIRST 96
#endif
constexpr int CW_BAR = 4096;
constexpr int RING_BYTES = 131072, LDSCTL_OFF = RING_BYTES, MISC_OFF = LDSCTL_OFF + 320, LDS_BYTES = 147456;

#define GAS __attribute__((address_space(1)))
#define LAS __attribute__((address_space(3)))
typedef unsigned short bf16;
typedef unsigned v4u __attribute__((ext_vector_type(4)));
typedef float f32x4 __attribute__((ext_vector_type(4)));
typedef short bf16x8 __attribute__((ext_vector_type(8)));
typedef GAS unsigned gu32;
typedef GAS unsigned long long gu64;
#define RLX_AGENT __ATOMIC_RELAXED, __HIP_MEMORY_SCOPE_AGENT
#define LDS_WAIT() asm volatile("s_waitcnt lgkmcnt(0)" ::: "memory")
#define VM_WAIT() asm volatile("s_waitcnt vmcnt(0)" ::: "memory")
__device__ __forceinline__ unsigned long long rt() { return __builtin_amdgcn_s_memrealtime(); }
__device__ __forceinline__ unsigned f2bf(float f) { unsigned u = __builtin_bit_cast(unsigned, f); return (u + 0x7fffu + ((u >> 16) & 1u)) >> 16; }
__device__ __forceinline__ unsigned pk2(float lo, float hi) { return f2bf(lo) | (f2bf(hi) << 16); }

#define XB_TMO      128
#define XB_XCNT(j)  (256  + 64 * (j))
#define XB_XSUB(j)  (1280 + 64 * (j))
#define XB_XGEN(j)  (2304 + 64 * (j))
#define XB_TOP      3328
#define XB_TOPGEN   3392
#define XCD_BAR_WORDS 3456
#define XB_SPIN_CAP (1u << 18)

__device__ __forceinline__ unsigned xb_ld(unsigned* p)              { return __hip_atomic_load(p, __ATOMIC_RELAXED, __HIP_MEMORY_SCOPE_AGENT); }
__device__ __forceinline__ unsigned xb_add(unsigned* p, unsigned v) { return __hip_atomic_fetch_add(p, v, __ATOMIC_RELAXED, __HIP_MEMORY_SCOPE_AGENT); }
__device__ __forceinline__ unsigned xb_xcc_id() { return (unsigned)__builtin_amdgcn_s_getreg((3 << 11) | 20) & 0xFu; }
#define XB_SPIN(cond, bar) do { unsigned _sp = 0; while (cond) { __builtin_amdgcn_s_sleep(1); \
    if ((++_sp & 255u) == 0u) { if (xb_ld(&(bar)[XB_TMO])) break; if (_sp > XB_SPIN_CAP) { atomicAdd(&(bar)[XB_TMO], 1u); break; } } } } while (0)

struct XcdBarrier {
    unsigned* bar; unsigned x;
    volatile LAS unsigned* st;
};

__device__ __forceinline__ XcdBarrier xcd_barrier_post(unsigned* bar, volatile LAS unsigned* st) {
    XcdBarrier b; b.bar = bar; b.x = xb_xcc_id(); b.st = st;
    if (threadIdx.x == 0) (void)xb_add(&bar[XB_XCNT(b.x)], 1u);
    return b;
}
__device__ __forceinline__ void xcd_barrier_complete(unsigned* bar, unsigned x, unsigned& nloc, unsigned& nx) {
    const unsigned G = gridDim.x * gridDim.y * gridDim.z;
    unsigned sum, cnt, mine, sp = 0u;
    for (;;) {
        sum = 0u; cnt = 0u; mine = 0u;
#pragma unroll
        for (unsigned j = 0; j < 16; ++j) { const unsigned c = xb_ld(&bar[XB_XCNT(j)]); sum += c; cnt += (c > 0u) ? 1u : 0u; mine = (j == x) ? c : mine; }
        if (sum == G) break;
        __builtin_amdgcn_s_sleep(1);
        if ((++sp & 255u) == 0u) { if (xb_ld(&bar[XB_TMO])) break; if (sp > XB_SPIN_CAP) { atomicAdd(&bar[XB_TMO], 1u); break; } }
    }
    nloc = mine > 0u ? mine : 1u; nx = cnt > 0u ? cnt : 1u;
}

__device__ __forceinline__ void xcd_barrier(const XcdBarrier& b) {
    asm volatile("s_waitcnt vmcnt(0)" ::: "memory");
    __syncthreads();
    if (threadIdx.x == 0) {
        unsigned* bar = b.bar;
        __builtin_amdgcn_s_waitcnt(0);
        unsigned nloc = b.st[0], nx = b.st[1];
        if (nloc == 0u) { xcd_barrier_complete(bar, b.x, nloc, nx); b.st[0] = nloc; b.st[1] = nx; }
        const unsigned old = xb_add(&bar[XB_XSUB(b.x)], 1u);
        const unsigned gen = old / nloc;
        if (old + 1u == (gen + 1u) * nloc) {
            __builtin_amdgcn_fence(__ATOMIC_RELEASE, "agent");
            asm volatile("s_waitcnt vmcnt(0)" ::: "memory");
            const unsigned og = xb_add(&bar[XB_TOP], 1u);
            const unsigned tg = og / nx;
            __builtin_amdgcn_fence(__ATOMIC_ACQUIRE, "agent");
            if (og + 1u == (tg + 1u) * nx) xb_add(&bar[XB_TOPGEN], 1u);
            else XB_SPIN(xb_ld(&bar[XB_TOPGEN]) == tg, bar);
            xb_add(&bar[XB_XGEN(b.x)], 1u);
            asm volatile("s_waitcnt vmcnt(0)" ::: "memory");
        } else {
            __builtin_amdgcn_fence(__ATOMIC_ACQUIRE, "agent");
            XB_SPIN(xb_ld(&bar[XB_XGEN(b.x)]) == gen, bar);
            asm volatile("s_waitcnt vmcnt(0)" ::: "memory");
        }
    }
    __syncthreads();
}

typedef float f32x16 __attribute__((ext_vector_type(16)));
typedef unsigned u32x2 __attribute__((ext_vector_type(2)));
struct Args { const void* in[33]; float* out; unsigned char* ws; int ph_lo, ph_hi, li, pad; };
struct Frame {
    LAS unsigned char* lds; volatile LAS unsigned* MISC; gu32* ctl; const __attribute__((address_space(4))) Args* ap;
    int tid, lane, wave, vcu, G;
    __device__ __forceinline__ int otid() const { int t = threadIdx.x; asm volatile("" : "+v"(t)); return t; }
    __device__ __forceinline__ const __attribute__((address_space(4))) Args* A() const { const __attribute__((address_space(4))) Args* p = ap; asm volatile("" : "+s"(p)); return p; }
    __device__ __forceinline__ unsigned char* wsb() const { return A()->ws; }
    __device__ __forceinline__ float* out() const { return A()->out; }
#define FIN(name, idx, T) __device__ __forceinline__ const T* name() const { return (const T*)A()->in[idx]; }
    FIN(x_prompt, 0, float) FIN(x_sample, 1, float) FIN(mem_prompt, 2, float) FIN(st_re, 3, float) FIN(st_im, 4, float) FIN(cache_k, 5, float) FIN(cache_v, 6, float) FIN(page_table, 7, int) FIN(cache_mem_k, 8, float) FIN(cache_mem_v, 9, float)
    FIN(g_mix, 10, float) FIN(w_in, 11, float) FIN(w_out, 12, float) FIN(g_ffn, 13, float) FIN(w_gu, 14, float) FIN(w_down, 15, float) FIN(ssm_a_re, 16, float) FIN(ssm_a_im, 17, float) FIN(ssm_log_dt, 18, float) FIN(ssm_b_re, 19, float)
    FIN(ssm_b_im, 20, float) FIN(ssm_c_re, 21, float) FIN(ssm_c_im, 22, float) FIN(ssm_d, 23, float) FIN(w_glu, 24, float) FIN(g_q, 25, float) FIN(g_mq, 26, float) FIN(g_mem, 27, float) FIN(w_mem_kv, 28, float) FIN(g_mk, 29, float)
    FIN(g_kv, 30, float) FIN(w_kv, 31, float) FIN(g_k, 32, float)
#undef FIN
#define FWS(name, off, T) __device__ __forceinline__ T* name() const { return (T*)(wsb() + (off)); }
    FWS(hb0, WS_HB0, bf16) FWS(ssq0, WS_SSQ0, float) FWS(kvraw, WS_KVRAW, float) FWS(kbuf, WS_KBUF, bf16) FWS(vbuf, WS_VBUF, bf16)
    FWS(memkb, WS_MEMKB, bf16) FWS(memvb, WS_MEMVB, bf16) FWS(tab, WS_TAB, f32x4) FWS(kmeanp, WS_KMEANP, bf16) FWS(kmeans, WS_KMEANS, float) FWS(kmraw, WS_KMRAW, float)
#define FWL(name, off, T) __device__ __forceinline__ T* name(int l) const { return (T*)(wsb() + WS_LAYER + (size_t)l * LSTRIDE + (off)); }
    FWL(proj, LO_PROJ, bf16) FWL(mixo, LO_MIXO, bf16) FWL(hba, LO_HBA, bf16) FWL(hbb, LO_HBB, bf16) FWL(ffh, LO_FFH, bf16) FWL(ssqa, LO_SSQA, float) FWL(ssqb, LO_SSQB, float)
#undef FWL
    __device__ __forceinline__ bf16* ybuf(int l) const { return (bf16*)(wsb() + WS_YBUF + (size_t)l * YBUF_STRIDE); }
#undef FWS
};
__device__ __forceinline__ bf16* wcat(const Frame& F, int l) { return (bf16*)(F.wsb() + (l == 0 ? WS_WCAT0 : l == 1 ? WS_WCAT1 : l == 2 ? WS_WCAT2 : WS_WCAT3)); }
__device__ __forceinline__ float wave_sum(float v) {
#pragma unroll
    for (int o = 1; o < 64; o <<= 1) v += __shfl_xor(v, o);
    return v;
}
__device__ __forceinline__ float wave_max(float v) {
#pragma unroll
    for (int o = 1; o < 64; o <<= 1) v = fmaxf(v, __shfl_xor(v, o));
    return v;
}
__device__ __forceinline__ float sum16(float v) { v += __shfl_xor(v, 1); v += __shfl_xor(v, 2); v += __shfl_xor(v, 4); v += __shfl_xor(v, 8); return v; }
__device__ __forceinline__ float wave_sum_dpp(float v) {
    v += __builtin_bit_cast(float, __builtin_amdgcn_update_dpp(0, __builtin_bit_cast(int, v), 0x111, 0xf, 0xf, true));
    v += __builtin_bit_cast(float, __builtin_amdgcn_update_dpp(0, __builtin_bit_cast(int, v), 0x112, 0xf, 0xf, true));
    v += __builtin_bit_cast(float, __builtin_amdgcn_update_dpp(0, __builtin_bit_cast(int, v), 0x114, 0xf, 0xf, true));
    v += __builtin_bit_cast(float, __builtin_amdgcn_update_dpp(0, __builtin_bit_cast(int, v), 0x118, 0xf, 0xf, true));
    v += __builtin_bit_cast(float, __builtin_amdgcn_update_dpp(0, __builtin_bit_cast(int, v), 0x142, 0xa, 0xf, false));
    v += __builtin_bit_cast(float, __builtin_amdgcn_update_dpp(0, __builtin_bit_cast(int, v), 0x143, 0xc, 0xf, false));
    return __builtin_bit_cast(float, __builtin_amdgcn_readlane(__builtin_bit_cast(int, v), 63));
}
__device__ __forceinline__ float bflo(unsigned w) { return __builtin_bit_cast(float, w << 16); }
__device__ __forceinline__ float bfhi(unsigned w) { return __builtin_bit_cast(float, w & 0xffff0000u); }
__device__ __forceinline__ unsigned cvtpk(float lo, float hi) { return pg8::cvt_pk_bf16(lo, hi); }
typedef float f32x2q __attribute__((ext_vector_type(2)));
__device__ __forceinline__ f32x2q gelu_tanh2(f32x2q y) {
    const float k0 = -2.0f * 1.4426950408889634f * 0.7978845608028654f, k1 = k0 * 0.044715f;
    const f32x2q t = y * ((y * y) * k1 + k0); f32x2q a; a.x = __builtin_amdgcn_exp2f(t.x); a.y = __builtin_amdgcn_exp2f(t.y); a = a + 1.0f;
    f32x2q s; s.x = __builtin_amdgcn_rcpf(a.x); s.y = __builtin_amdgcn_rcpf(a.y); return y * s;
}
__device__ __forceinline__ float gelu_tanh(float y) {
    const float z = 0.7978845608028654f * (y + 0.044715f * y * y * y);
    return y * __builtin_amdgcn_rcpf(1.0f + __builtin_amdgcn_exp2f(-2.0f * 1.4426950408889634f * z));
}

__device__ __forceinline__ void tr_item(const float* W, int K, int N, const float* gain, bf16* WT, int R0, int k0, int n0, LAS float* scr, int lane) {
    float wv[32];
#pragma unroll
    for (int i = 0; i < 32; ++i) wv[i] = W[(size_t)(k0 + 2 * i + (lane >> 5)) * N + n0 + (lane & 31)];
    if (gain) {
#pragma unroll
        for (int i = 0; i < 32; ++i) wv[i] *= gain[k0 + 2 * i + (lane >> 5)]; }
#pragma unroll
    for (int i = 0; i < 32; ++i) scr[(2 * i + (lane >> 5)) * 33 + (lane & 31)] = wv[i];
    LDS_WAIT(); asm volatile("" ::: "memory");
    const int c = lane & 7;
#pragma unroll
    for (int j = 0; j < 4; ++j) { const int n = (lane >> 3) + 8 * j; const LAS float* s = scr + (8 * c) * 33 + n;
        v4u o; o.x = pk2(s[0 * 33], s[1 * 33]); o.y = pk2(s[2 * 33], s[3 * 33]); o.z = pk2(s[4 * 33], s[5 * 33]); o.w = pk2(s[6 * 33], s[7 * 33]);
        *(GAS v4u*)(WT + (size_t)(R0 + n) * K + k0 + 8 * c) = o; }
    LDS_WAIT(); asm volatile("" ::: "memory");
}
__device__ __forceinline__ double dexp_small(double x) {
    const double k = __builtin_rint(x * 1.4426950408889634); const double r = __builtin_fma(-k, 0.6931471805599453, x) - k * 2.3190468138462996e-17;
    double s = 1.0;
#pragma unroll
    for (int n = 14; n >= 1; --n) s = 1.0 + s * r * (1.0 / n);
    const long long ki = (long long)k; return s * __builtin_bit_cast(double, (ki + 1023) << 52);
}
__device__ __forceinline__ void dsincos(double x, double& sn, double& cs) {
    const double k = __builtin_rint(x * 0.15915494309189535); double r = __builtin_fma(-k, 6.283185307179586, x); r = __builtin_fma(-k, 2.4492935982947064e-16, r);
    const double y = 0.25 * r, y2 = y * y;
    double s = 1.0, c = 1.0;
#pragma unroll
    for (int n = 8; n >= 1; --n) { s = 1.0 - s * y2 * (1.0 / ((2 * n) * (2 * n + 1))); c = 1.0 - c * y2 * (1.0 / ((2 * n - 1) * (2 * n))); }
    s *= y;
    const double s2 = 2.0 * s * c, c2 = 1.0 - 2.0 * s * s;
    sn = 2.0 * s2 * c2; cs = 1.0 - 2.0 * s2 * s2;
}
constexpr int IT_IN = 512, IT_OUT = 512, IT_GU = 2816, IT_DN = 1408, IT_L = IT_IN + IT_OUT + IT_GU + IT_DN, IT_GLU = 288, IT_KV = 256, IT_MKV = 256;
constexpr int IT_TOTAL = 4 * IT_L + 2 * IT_GLU + IT_KV + 4 * IT_MKV;
constexpr int IT_FIRST_LO = 4 * IT_L + 2 * IT_GLU + IT_KV;
__device__ __forceinline__ void convert_items(const Frame& F, int it_lo, int it_hi, int widx, int nw) {
    LAS float* scr = (LAS float*)(F.lds + F.wave * 8448); const int lane = F.otid() & 63;
    for (int it = it_lo + widx; it < it_hi; it += nw) {
        const float* W; const float* gain = nullptr; bf16* WT; int K, N, r, mode = 0;
        if (it < 4 * IT_L) { const int l = it / IT_L; r = it % IT_L;
            if (r < IT_IN) { W = F.w_in() + (size_t)l * 1048576; K = 1024; N = 1024; gain = F.g_mix() + l * 1024; WT = wcat(F, l); }
            else if ((r -= IT_IN) < IT_OUT) { W = F.w_out() + (size_t)l * 1048576; K = 1024; N = 1024; WT = (bf16*)(F.wsb() + WS_WOUT + (size_t)l * 2 * MiB); }
            else if ((r -= IT_OUT) < IT_GU) { W = F.w_gu() + (size_t)l * 1024 * 5632; K = 1024; N = 5632; gain = F.g_ffn() + l * 1024; WT = (bf16*)(F.wsb() + WS_WGU + (size_t)l * WGU_STRIDE); mode = 1; }
            else { r -= IT_GU; W = F.w_down() + (size_t)l * 2816 * 1024; K = 2816; N = 1024; WT = (bf16*)(F.wsb() + WS_WDOWN + (size_t)l * WDOWN_STRIDE); }
        } else { r = it - 4 * IT_L;
            if (r < 2 * IT_GLU) { const int l = r / IT_GLU; r %= IT_GLU; W = F.w_glu() + (size_t)l * 768 * 768; K = 768; N = 768; WT = (bf16*)(F.wsb() + WS_WGLU + (size_t)l * WGLU_STRIDE); }
            else if ((r -= 2 * IT_GLU) < IT_KV) { W = F.w_kv(); K = 1024; N = 512; gain = F.g_kv(); WT = wcat(F, 2) + (size_t)1024 * 1024; }
            else { r -= IT_KV; const int L = r / IT_MKV; r %= IT_MKV; W = F.w_mem_kv() + (size_t)L * 1024 * 512; K = 1024; N = 512; gain = F.g_mem() + L * 1024; WT = wcat(F, 0) + (size_t)(1024 + 512 * L) * 1024; }
        }
        const int nblk = N / 32, kb = r / nblk, nb = r % nblk, k0 = 64 * kb, n0 = 32 * nb;
        int R0 = n0;
        if (mode == 1) { const int j0 = n0 < DFF ? n0 : n0 - DFF; R0 = 256 * (j0 >> 7) + (j0 & 127) + (n0 < DFF ? 0 : 128); }
        tr_item(W, K, N, gain, WT, R0, k0, n0, scr, lane);
    }
}
__device__ __forceinline__ void p0_prologue(Frame& F) {
    const int gw = F.vcu * NWAVES + F.wave, NGW = F.G * NWAVES, lane = F.otid() & 63;
    convert_items(F, 0, IT_TOTAL, gw, NGW);
    for (int m = gw; m < AROWS; m += NGW) {
        const float* src = m < MP ? F.x_prompt() + (size_t)m * DM : m < MT ? F.x_sample() + (size_t)(m - MP) * DM : m < MROWS ? nullptr : F.mem_prompt() + (size_t)(m - MROWS) * DM;
        f32x4 v[4]; float s = 0.f;
#pragma unroll
        for (int j = 0; j < 4; ++j) { v[j] = src ? *((const GAS f32x4*)src + lane + 64 * j) : (f32x4){0.f, 0.f, 0.f, 0.f}; s += (v[j].x * v[j].x + v[j].y * v[j].y) + (v[j].z * v[j].z + v[j].w * v[j].w); }
        s = wave_sum(s);
#pragma unroll
        for (int j = 0; j < 4; ++j) {
            u32x2 w; w.x = pk2(v[j].x, v[j].y); w.y = pk2(v[j].z, v[j].w); *((GAS u32x2*)(F.hb0() + (size_t)m * DM) + lane + 64 * j) = w; }
        if (lane < 16) F.ssq0()[(size_t)m * 16 + lane] = lane == 0 ? s : 0.f;
    }
    for (int e = blockIdx.x * (NWAVES * 64) + F.tid; e < 2 * NG * NST; e += F.G * NWAVES * 64) {
        const int lg = e / NST;
        const double dt = dexp_small((double)F.ssm_log_dt()[lg]);
        const double lre = fmin((double)F.ssm_a_re()[e], -1e-4), lim = (double)F.ssm_a_im()[e];
        const double mag = dexp_small(dt * lre); double sn, cs; dsincos(dt * lim, sn, cs);
        const double are = mag * cs, aim = mag * sn, den = lre * lre + lim * lim, nre = are - 1.0;
        const double fre = (nre * lre + aim * lim) / den, fim = (aim * lre - nre * lim) / den;
        F.tab()[e] = (f32x4){(float)are, (float)aim, (float)fre, (float)fim};
    }
}
__device__ __forceinline__ void sample_kmeans(const Frame& F, int it0, int it1, int sh, int nsh) {
    LAS float* red = (LAS float*)F.lds; const int tid = F.otid(), c4 = tid & 63, rgp = tid >> 6;
    for (int it = it0 + sh; it < it1; it += nsh) { const int s = it >> 3, blk = it & 7;
        const int pg0 = F.page_table()[s * 16 + 2 * blk], pg1 = F.page_table()[s * 16 + 2 * blk + 1];
        const float* p0 = F.cache_k() + ((size_t)pg0 * 128 + rgp) * 256 + 4 * c4; const float* p1 = F.cache_k() + ((size_t)pg1 * 128 + rgp) * 256 + 4 * c4;
        f32x4 va[16], vb[16];
#pragma unroll
        for (int i = 0; i < 16; ++i) { va[i] = *(const f32x4*)(p0 + (size_t)i * 8 * 256); vb[i] = *(const f32x4*)(p1 + (size_t)i * 8 * 256); }
        f32x4 a = (f32x4){0.f, 0.f, 0.f, 0.f};
#pragma unroll
        for (int i = 0; i < 16; ++i) a += va[i] + vb[i];
        __syncthreads();
        *(LAS f32x4*)(red + rgp * 256 + 4 * c4) = a;
        __syncthreads();
        if (tid < 256) { float t = 0.f;
#pragma unroll
            for (int w = 0; w < 8; ++w) t += red[w * 256 + tid];
            F.kmeans()[(size_t)it * 256 + tid] = t * (1.0f / 256.0f); } }
    __syncthreads();
}

__device__ __forceinline__ bf16x8 pack8(const float (&v)[8]) { v4u w; w.x = cvtpk(v[0], v[1]); w.y = cvtpk(v[2], v[3]); w.z = cvtpk(v[4], v[5]); w.w = cvtpk(v[6], v[7]); return __builtin_bit_cast(bf16x8, w); }
constexpr int XS_ROW = 272, XS_CH = 16 * XS_ROW, XS_WAVE = 2 * XS_CH;
template <bool PC>
__device__ __forceinline__ void s5_item(const Frame& F, int l, int b, int g, int cp, LAS unsigned char* xs, LAS float* elds) {
    const int lane = F.otid() & 63, j = lane & 31, hi = lane >> 5, lg = l * NG + g;
    const f32x4 t0 = F.tab()[lg * NST + j], t1 = F.tab()[lg * NST + j + 32];
    bf16x8 Bop[4];
#pragma unroll
    for (int s = 0; s < 2; ++s) { const f32x4 tt = s ? t1 : t0; const int p = j + 32 * s;
        const float* br = F.ssm_b_re() + ((size_t)lg * NST + p) * 16 + 8 * hi; const float* bi = F.ssm_b_im() + ((size_t)lg * NST + p) * 16 + 8 * hi;
        const f32x4 r0 = *(const f32x4*)br, r1 = *(const f32x4*)(br + 4), i0 = *(const f32x4*)bi, i1 = *(const f32x4*)(bi + 4);
        float re[8], im[8];
#pragma unroll
        for (int e = 0; e < 4; ++e) { re[e] = tt[2] * r0[e] - tt[3] * i0[e]; im[e] = tt[2] * i0[e] + tt[3] * r0[e]; re[4 + e] = tt[2] * r1[e] - tt[3] * i1[e]; im[4 + e] = tt[2] * i1[e] + tt[3] * r1[e]; }
        Bop[2 * s] = pack8(re); Bop[2 * s + 1] = pack8(im); }
    const int hh = (j >> 2) & 1, rr0 = (j & 3) + 4 * (j >> 3);
    const bf16* ap = F.proj(l) + ((size_t)(b * SEQ + (cp + 8 * hh) * 256 + rr0)) * DM + 16 * g + 8 * hi;
    const float a0r = t0[0], a0i = t0[1], a1r = t1[0], a1i = t1[1];
    float x0r = 0.f, x0i = 0.f, x1r = 0.f, x1i = 0.f;
    const int c = cp + 8 * hi;
    bf16x8 Cop[4]; f32x4 dsk; const int hq = lane >> 4, tk = lane & 15;
    if (PC) {
        float p0r = a0r, p0i = a0i, p1r = a1r, p1i = a1i;
#pragma unroll
        for (int q = 0; q < 8; ++q) { const float n0r = p0r * p0r - p0i * p0i, n0i = 2.f * p0r * p0i, n1r = p1r * p1r - p1i * p1i, n1i = 2.f * p1r * p1i; p0r = n0r; p0i = n0i; p1r = n1r; p1i = n1i; }
        { typedef float f32x2e __attribute__((ext_vector_type(2))); f32x2e ea[15], eb[15];
          const LAS f32x2e* e = (const LAS f32x2e*)elds;
#pragma unroll
          for (int cc = 0; cc < 15; ++cc) { ea[cc] = (f32x2e){0.f, 0.f}; eb[cc] = (f32x2e){0.f, 0.f}; if (cc < c) { ea[cc] = e[cc * NST + j]; eb[cc] = e[cc * NST + j + 32]; } }
#pragma unroll
          for (int cc = 0; cc < 15; ++cc) { if (cc < c) {
            const float n0r = p0r * x0r - p0i * x0i + ea[cc].x, n0i = p0r * x0i + p0i * x0r + ea[cc].y, n1r = p1r * x1r - p1i * x1i + eb[cc].x, n1i = p1r * x1i + p1i * x1r + eb[cc].y; x0r = n0r; x0i = n0i; x1r = n1r; x1i = n1i; } } }
#pragma unroll
        for (int kk = 0; kk < 4; ++kk) { const f32x4 cr = *(const f32x4*)(F.ssm_c_re() + ((size_t)lg * 16 + tk) * NST + 16 * kk + 4 * hq), ci = *(const f32x4*)(F.ssm_c_im() + ((size_t)lg * 16 + tk) * NST + 16 * kk + 4 * hq);
            const float cv[8] = {cr[0], -ci[0], cr[1], -ci[1], cr[2], -ci[2], cr[3], -ci[3]}; Cop[kk] = pack8(cv); }
        dsk = *(const f32x4*)(F.ssm_d() + (size_t)lg * 16 + 4 * hq);
    }
    constexpr int PD = 3;
    bf16x8 a_q[PD];
#pragma unroll
    for (int d = 0; d < PD; ++d) a_q[d] = *(const bf16x8*)(ap + (size_t)d * 16 * DM);
    const bf16* up0 = F.proj(l) + ((size_t)(b * SEQ + cp * 256 + tk)) * DM + 16 * g + 4 * hq;
    u32x2 u_q[PD][2];
    if (PC) {
#pragma unroll
        for (int d = 0; d < PD; ++d) { u_q[d][0] = *(const u32x2*)(up0 + (size_t)d * 16 * DM); u_q[d][1] = *(const u32x2*)(up0 + (size_t)(8 * 256 + d * 16) * DM); } }
    bf16* const ybp = F.ybuf(l) + (size_t)(b * SEQ + cp * 256 + tk) * MIXW + 16 * g + 4 * hq;
    for (int st = 0; st < 16; ++st) {
        const bf16x8 a = a_q[0]; const int sp = (st + PD < 16) ? st + PD : 15;
#pragma unroll
        for (int d = 0; d + 1 < PD; ++d) a_q[d] = a_q[d + 1];
        a_q[PD - 1] = *(const bf16x8*)(ap + (size_t)sp * 16 * DM);
        u32x2 u_cur[2];
        if (PC) { u_cur[0] = u_q[0][0]; u_cur[1] = u_q[0][1];
#pragma unroll
            for (int d = 0; d + 1 < PD; ++d) { u_q[d][0] = u_q[d + 1][0]; u_q[d][1] = u_q[d + 1][1]; }
            u_q[PD - 1][0] = *(const u32x2*)(up0 + (size_t)sp * 16 * DM); u_q[PD - 1][1] = *(const u32x2*)(up0 + (size_t)(8 * 256 + sp * 16) * DM); }
        const f32x16 z = {};
        const f32x16 br0 = __builtin_amdgcn_mfma_f32_32x32x16_bf16(a, Bop[0], z, 0, 0, 0), bi0 = __builtin_amdgcn_mfma_f32_32x32x16_bf16(a, Bop[1], z, 0, 0, 0);
        const f32x16 br1 = __builtin_amdgcn_mfma_f32_32x32x16_bf16(a, Bop[2], z, 0, 0, 0), bi1 = __builtin_amdgcn_mfma_f32_32x32x16_bf16(a, Bop[3], z, 0, 0, 0);
#pragma unroll
        for (int r = 0; r < 16; ++r) {
            const float n0r = __builtin_fmaf(a0r, x0r, __builtin_fmaf(-a0i, x0i, br0[r])), n0i = __builtin_fmaf(a0r, x0i, __builtin_fmaf(a0i, x0r, bi0[r]));
            const float n1r = __builtin_fmaf(a1r, x1r, __builtin_fmaf(-a1i, x1i, br1[r])), n1i = __builtin_fmaf(a1r, x1i, __builtin_fmaf(a1i, x1r, bi1[r]));
            x0r = n0r; x0i = n0i; x1r = n1r; x1i = n1i;
            if (PC) { LAS unsigned* xr = (LAS unsigned*)(xs + hi * XS_CH + r * XS_ROW); xr[j] = cvtpk(x0r, x0i); xr[j + 32] = cvtpk(x1r, x1i); }
        }
        if (PC) {
#pragma unroll
            for (int h2 = 0; h2 < 2; ++h2) {
                f32x4 ya = (f32x4){0.f, 0.f, 0.f, 0.f};
#pragma unroll
                for (int kk = 0; kk < 4; ++kk) { const bf16x8 xb = *(const LAS bf16x8*)(xs + h2 * XS_CH + tk * XS_ROW + kk * 64 + hq * 16); ya = __builtin_amdgcn_mfma_f32_16x16x32_bf16(Cop[kk], xb, ya, 0, 0, 0); }
                const size_t tok = (size_t)(b * SEQ + (cp + 8 * h2) * 256 + st * 16 + tk);
                const u32x2 uw = u_cur[h2];
                const f32x2q g01 = gelu_tanh2((f32x2q){ya[0] + dsk[0] * bflo(uw.x), ya[1] + dsk[1] * bfhi(uw.x)}), g23 = gelu_tanh2((f32x2q){ya[2] + dsk[2] * bflo(uw.y), ya[3] + dsk[3] * bfhi(uw.y)});
                u32x2 ow; ow.x = cvtpk(g01.x, g01.y); ow.y = cvtpk(g23.x, g23.y); *(u32x2*)(ybp + (size_t)(h2 * 8 * 256 + st * 16) * MIXW) = ow;
            }
        }
    }
    if (!PC) { LAS float* e = elds + (size_t)c * NST * 2; e[2 * j] = x0r; e[2 * j + 1] = x0i; e[2 * (j + 32)] = x1r; e[2 * (j + 32) + 1] = x1i; }
    else if (c == 15) { const size_t o = ((size_t)(l * NBATCH + b) * NG + g) * NST; F.out()[OFF_PSR + o + j] = x0r; F.out()[OFF_PSI + o + j] = x0i; F.out()[OFF_PSR + o + j + 32] = x1r; F.out()[OFF_PSI + o + j + 32] = x1i; }
}
__device__ __forceinline__ void s5_sample(const Frame& F, int l, int s, int g) {
    const int p = F.otid() & 63, lg = l * NG + g; const size_t row = MP + s;
    const f32x4 tt = F.tab()[lg * NST + p];
    const v4u ua = *(const v4u*)(F.proj(l) + row * DM + 16 * g), ub = *(const v4u*)(F.proj(l) + row * DM + 16 * g + 8);
    const float u[16] = {bflo(ua.x), bfhi(ua.x), bflo(ua.y), bfhi(ua.y), bflo(ua.z), bfhi(ua.z), bflo(ua.w), bfhi(ua.w), bflo(ub.x), bfhi(ub.x), bflo(ub.y), bfhi(ub.y), bflo(ub.z), bfhi(ub.z), bflo(ub.w), bfhi(ub.w)};
    const float* br = F.ssm_b_re() + ((size_t)lg * NST + p) * 16; const float* bi = F.ssm_b_im() + ((size_t)lg * NST + p) * 16;
    float sr = 0.f, si = 0.f;
#pragma unroll
    for (int q = 0; q < 4; ++q) { const f32x4 r4 = *(const f32x4*)(br + 4 * q), i4 = *(const f32x4*)(bi + 4 * q);
#pragma unroll
        for (int e = 0; e < 4; ++e) { sr += r4[e] * u[4 * q + e]; si += i4[e] * u[4 * q + e]; } }
    const float bur = tt[2] * sr - tt[3] * si, bui = tt[2] * si + tt[3] * sr;
    const size_t so = ((size_t)(l * NS + s) * NG + g) * NST + p;
    const float h0r = F.st_re()[so], h0i = F.st_im()[so];
    const float xr = tt[0] * h0r - tt[1] * h0i + bur, xi = tt[0] * h0i + tt[1] * h0r + bui;
    F.out()[OFF_SSR + so] = xr; F.out()[OFF_SSI + so] = xi;
    float my = 0.f;
    { float cr[16], ci[16];
      const float* ccr = F.ssm_c_re() + (size_t)lg * 16 * NST + p; const float* cci = F.ssm_c_im() + (size_t)lg * 16 * NST + p;
#pragma unroll
      for (int hh = 0; hh < 16; ++hh) { cr[hh] = ccr[hh * NST]; ci[hh] = cci[hh * NST]; }
      const float dsk = p < 16 ? F.ssm_d()[lg * 16 + p] : 0.f;
#pragma unroll
      for (int hh = 0; hh < 16; ++hh) { const float tv = wave_sum_dpp(cr[hh] * xr - ci[hh] * xi); if (p == hh) my = tv + dsk * u[hh]; } }
    if (p < 16) F.ybuf(l)[row * MIXW + 16 * g + p] = (bf16)cvtpk(gelu_tanh(my), 0.f);
}
__device__ __forceinline__ void s5_sample3(const Frame& F, int l, int g, int s0) {
    const int p = F.otid() & 63, lg = l * NG + g;
    const f32x4 tt = F.tab()[lg * NST + p];
    const float* br = F.ssm_b_re() + ((size_t)lg * NST + p) * 16; const float* bi = F.ssm_b_im() + ((size_t)lg * NST + p) * 16;
    f32x4 r4[4], i4[4];
#pragma unroll
    for (int q = 0; q < 4; ++q) { r4[q] = *(const f32x4*)(br + 4 * q); i4[q] = *(const f32x4*)(bi + 4 * q); }
    v4u ua[3], ub[3]; float h0r[3], h0i[3];
    { const bf16* const pj = F.proj(l); const float* const sre = F.st_re(); const float* const sim = F.st_im();
#pragma unroll
      for (int k = 0; k < 3; ++k) { const int s = s0 + 42 * k; const size_t row = MP + s, so = ((size_t)(l * NS + s) * NG + g) * NST + p;
        ua[k] = *(const v4u*)(pj + row * DM + 16 * g); ub[k] = *(const v4u*)(pj + row * DM + 16 * g + 8); h0r[k] = sre[so]; h0i[k] = sim[so]; } }
    float cr[16], ci[16];
    { const float* ccr = F.ssm_c_re() + (size_t)lg * 16 * NST + p; const float* cci = F.ssm_c_im() + (size_t)lg * 16 * NST + p;
#pragma unroll
      for (int hh = 0; hh < 16; ++hh) { cr[hh] = ccr[hh * NST]; ci[hh] = cci[hh * NST]; } }
    const float dsk = p < 16 ? F.ssm_d()[lg * 16 + p] : 0.f;
    float* const outp = F.out(); bf16* const ybp = F.ybuf(l);
#pragma unroll
    for (int k = 0; k < 3; ++k) { const int s = s0 + 42 * k; const size_t row = MP + s, so = ((size_t)(l * NS + s) * NG + g) * NST + p;
        const float u[16] = {bflo(ua[k].x), bfhi(ua[k].x), bflo(ua[k].y), bfhi(ua[k].y), bflo(ua[k].z), bfhi(ua[k].z), bflo(ua[k].w), bfhi(ua[k].w), bflo(ub[k].x), bfhi(ub[k].x), bflo(ub[k].y), bfhi(ub[k].y), bflo(ub[k].z), bfhi(ub[k].z), bflo(ub[k].w), bfhi(ub[k].w)};
        float sr = 0.f, si = 0.f;
#pragma unroll
        for (int q = 0; q < 4; ++q)
#pragma unroll
            for (int e = 0; e < 4; ++e) { sr += r4[q][e] * u[4 * q + e]; si += i4[q][e] * u[4 * q + e]; }
        const float bur = tt[2] * sr - tt[3] * si, bui = tt[2] * si + tt[3] * sr;
        const float xr = tt[0] * h0r[k] - tt[1] * h0i[k] + bur, xi = tt[0] * h0i[k] + tt[1] * h0r[k] + bui;
        outp[OFF_SSR + so] = xr; outp[OFF_SSI + so] = xi;
        float my = 0.f;
#pragma unroll
        for (int hh = 0; hh < 16; ++hh) { const float tv = wave_sum_dpp(cr[hh] * xr - ci[hh] * xi); if (p == hh) my = tv + dsk * u[hh]; }
        if (p < 16) ybp[row * MIXW + 16 * g + p] = (bf16)cvtpk(gelu_tanh(my), 0.f); }
}

__device__ __forceinline__ void memkv_norm(const Frame& F) {
    const int gw = F.vcu * NWAVES + F.wave, NGW = F.G * NWAVES, lane = F.otid() & 63;
    for (int it0 = gw; it0 < 4 * MEMR; it0 += 2 * NGW) {
        f32x4 k[2], v[2], gk[2];
#pragma unroll
        for (int r = 0; r < 2; ++r) { const int it = it0 + r * NGW < 4 * MEMR ? it0 + r * NGW : it0, L = it / MEMR;
            k[r] = *(const f32x4*)(F.kmraw() + (size_t)it * 256 + 4 * lane); v[r] = *(const f32x4*)(F.out() + OFF_PMV + (size_t)it * 256 + 4 * lane); gk[r] = *(const f32x4*)(F.g_mk() + L * 64 + ((4 * lane) & 63)); }
#pragma unroll
        for (int r = 0; r < 2; ++r) { const int it = it0 + r * NGW; if (it < 4 * MEMR) {
            const float ss = sum16((k[r][0] * k[r][0] + k[r][1] * k[r][1]) + (k[r][2] * k[r][2] + k[r][3] * k[r][3])); const float rs = __builtin_amdgcn_rsqf(ss * (1.0f / 64.0f) + EPS);
            const f32x4 kn = k[r] * rs * gk[r]; *(f32x4*)(F.out() + OFF_PMK + (size_t)it * 256 + 4 * lane) = kn;
            u32x2 w; w.x = cvtpk(kn[0], kn[1]); w.y = cvtpk(kn[2], kn[3]); *(u32x2*)(F.memkb() + (size_t)it * 256 + 4 * lane) = w;
            w.x = cvtpk(v[r][0], v[r][1]); w.y = cvtpk(v[r][2], v[r][3]); *(u32x2*)(F.memvb() + (size_t)it * 256 + 4 * lane) = w; } }
    }
}
__device__ __forceinline__ void kv_norm(const Frame& F) {
    LAS float* red = (LAS float*)F.lds; const int lane = F.otid() & 63, wave = F.wave;
    const f32x4 gk = *(const f32x4*)(F.g_k() + ((4 * lane) & 63));
    const float* const kvr = F.kvraw(); float* const outp = F.out(); bf16* const kbp = F.kbuf(); bf16* const vbp = F.vbuf();
    for (int it2 = F.vcu; it2 < 256; it2 += F.G) {
        const int it = (it2 >> 5) * 8 + (it2 & 7), sub = (it2 >> 3) & 3;
        f32x4 acc = (f32x4){0.f, 0.f, 0.f, 0.f};
#pragma unroll
        for (int bt2 = 0; bt2 < 2; ++bt2) {
            f32x4 kq[2][8], v[8];
#pragma unroll
            for (int h = 0; h < 2; ++h)
#pragma unroll
                for (int i = 0; i < 8; ++i) kq[h][i] = *(const f32x4*)(kvr + ((size_t)it * 256 + wave * 32 + (2 * bt2 + h) * 8 + i) * 512 + 4 * lane);
            if ((sub >> 1) == bt2) {
#pragma unroll
                for (int i = 0; i < 8; ++i) v[i] = *(const f32x4*)(kvr + ((size_t)it * 256 + wave * 32 + sub * 8 + i) * 512 + 256 + 4 * lane); }
#pragma unroll
            for (int h = 0; h < 2; ++h) { const int bt = 2 * bt2 + h; const size_t r0 = (size_t)it * 256 + wave * 32 + bt * 8; f32x4 k[8];
#pragma unroll
                for (int i = 0; i < 8; ++i) { k[i] = kq[h][i]; const float ss = sum16((k[i][0] * k[i][0] + k[i][1] * k[i][1]) + (k[i][2] * k[i][2] + k[i][3] * k[i][3])); const float rs = __builtin_amdgcn_rsqf(ss * (1.0f / 64.0f) + EPS);
                    k[i] = k[i] * rs * gk; acc += k[i]; }
                if (bt == sub) {
#pragma unroll
                    for (int i = 0; i < 8; ++i) { const size_t row = r0 + i;
                        *(f32x4*)(outp + OFF_PK + row * 256 + 4 * lane) = k[i]; *(f32x4*)(outp + OFF_PV + row * 256 + 4 * lane) = v[i];
                        u32x2 w; w.x = cvtpk(k[i][0], k[i][1]); w.y = cvtpk(k[i][2], k[i][3]); *(u32x2*)(kbp + row * 256 + 4 * lane) = w;
                        w.x = cvtpk(v[i][0], v[i][1]); w.y = cvtpk(v[i][2], v[i][3]); *(u32x2*)(vbp + row * 256 + 4 * lane) = w; } }
            }
        }
        *(LAS f32x4*)(red + wave * 256 + 4 * lane) = acc;
        __syncthreads();
        if (sub == 0 && F.tid < 256) { float t = 0.f;
#pragma unroll
            for (int w = 0; w < 8; ++w) t += red[w * 256 + F.tid];
            F.kmeanp()[(size_t)it * 256 + F.tid] = (bf16)cvtpk(t * (1.0f / 256.0f), 0.f); }
        __syncthreads(); }
    for (int r = F.vcu * NWAVES + wave; r < NS; r += F.G * NWAVES) {
        const size_t row = (size_t)MP + r;
        f32x4 k = *(const f32x4*)(kvr + row * 512 + 4 * lane); const f32x4 v = *(const f32x4*)(kvr + row * 512 + 256 + 4 * lane);
        const float ss = sum16((k[0] * k[0] + k[1] * k[1]) + (k[2] * k[2] + k[3] * k[3])); const float rs = __builtin_amdgcn_rsqf(ss * (1.0f / 64.0f) + EPS);
        k = k * rs * gk;
        *(f32x4*)(outp + OFF_SK + (size_t)r * 256 + 4 * lane) = k; *(f32x4*)(outp + OFF_SV + (size_t)r * 256 + 4 * lane) = v;
        u32x2 w; w.x = cvtpk(k[0], k[1]); w.y = cvtpk(k[2], k[3]); *(u32x2*)(kbp + row * 256 + 4 * lane) = w;
        w.x = cvtpk(v[0], v[1]); w.y = cvtpk(v[2], v[3]); *(u32x2*)(vbp + row * 256 + 4 * lane) = w; }
}

template <bool MOBA>
__device__ __forceinline__ void decode_item(const Frame& F, int l, int s, int hd) {
    LAS float* sc = (LAS float*)F.lds; LAS float* red = (LAS float*)(F.lds + 4096); LAS float* misc = (LAS float*)(F.lds + 12288); LAS int* segs = (LAS int*)(F.lds + 12288 + 256);
    const int t = F.otid(), rg = t >> 4, lq = t & 15, wave = F.wave;
    const size_t row = MP + s; const int qcol = MOBA ? hd * 64 : MIXW + hd * 64, kvh = MOBA ? hd / 3 : hd;
    const float* gq = MOBA ? F.g_q() + (l - 2) * 64 : F.g_mq() + l * 64;
    const u32x2 qw = *(const u32x2*)(F.proj(l) + row * DM + qcol + 4 * lq);
    float q0 = bflo(qw.x), q1 = bfhi(qw.x), q2 = bflo(qw.y), q3 = bfhi(qw.y);
    { const float ss = sum16((q0 * q0 + q1 * q1) + (q2 * q2 + q3 * q3)); const float rs = __builtin_amdgcn_rsqf(ss * (1.0f / 64.0f) + EPS) * C2; const f32x4 g4 = *(const f32x4*)(gq + 4 * lq);
      q0 *= rs * g4[0]; q1 *= rs * g4[1]; q2 *= rs * g4[2]; q3 *= rs * g4[3]; }
    __syncthreads();
    if (MOBA) {
        if (rg < 8) { const f32x4 km = *(const f32x4*)(F.kmeans() + ((size_t)(s * 8 + rg)) * 256 + kvh * 64 + 4 * lq); const float d = sum16((q0 * km[0] + q1 * km[1]) + (q2 * km[2] + q3 * km[3])); if (lq == 0) misc[rg] = d; }
        __syncthreads();
        if (t == 0) { float g0 = misc[0], g1 = misc[1], g2 = misc[2], g3 = misc[3], g4 = misc[4], g5 = misc[5], g6 = misc[6], g7 = misc[7]; unsigned selm = 0u;
#pragma unroll
            for (int k = 0; k < 3; ++k) { float best = g0; int bi = 0;
                if (g1 > best) { best = g1; bi = 1; } if (g2 > best) { best = g2; bi = 2; } if (g3 > best) { best = g3; bi = 3; } if (g4 > best) { best = g4; bi = 4; } if (g5 > best) { best = g5; bi = 5; } if (g6 > best) { best = g6; bi = 6; } if (g7 > best) { best = g7; bi = 7; }
                selm |= 1u << bi; const float NI = -INFINITY;
                g0 = bi == 0 ? NI : g0; g1 = bi == 1 ? NI : g1; g2 = bi == 2 ? NI : g2; g3 = bi == 3 ? NI : g3; g4 = bi == 4 ? NI : g4; g5 = bi == 5 ? NI : g5; g6 = bi == 6 ? NI : g6; g7 = bi == 7 ? NI : g7; }
            int n = 0;
            for (int jb = 0; jb < 8; ++jb) if ((selm >> jb) & 1u) { segs[n++] = F.page_table()[s * 16 + 2 * jb]; segs[n++] = F.page_table()[s * 16 + 2 * jb + 1]; } }
        __syncthreads();
    }
    constexpr int NSEG = MOBA ? 6 : 2;
#pragma unroll
    for (int sg = 0; sg < NSEG; ++sg) {
        const float* kb = MOBA ? F.cache_k() + (size_t)segs[sg] * 32768 + kvh * 64 : F.cache_mem_k() + ((size_t)((l * NS + s) * 256 + sg * 128)) * 256 + hd * 64;
        f32x4 kv[4];
#pragma unroll
        for (int i = 0; i < 4; ++i) kv[i] = *(const f32x4*)(kb + (size_t)(i * 32 + rg) * 256 + 4 * lq);
#pragma unroll
        for (int i = 0; i < 4; ++i) { const float d = sum16((q0 * kv[i][0] + q1 * kv[i][1]) + (q2 * kv[i][2] + q3 * kv[i][3])); if (lq == 0) sc[sg * 128 + i * 32 + rg] = d; }
    }
    constexpr int NKEY = NSEG * 128 + (MOBA ? 1 : 0);
    if (MOBA && rg == 0) { const f32x4 kn = *(const f32x4*)(F.out() + OFF_SK + (size_t)s * 256 + kvh * 64 + 4 * lq); const float d = sum16((q0 * kn[0] + q1 * kn[1]) + (q2 * kn[2] + q3 * kn[3])); if (lq == 0) sc[NSEG * 128] = d; }
    __syncthreads();
    float m = -INFINITY;
    for (int i = t; i < NKEY; i += NWAVES * 64) m = fmaxf(m, sc[i]);
    m = wave_max(m); if (F.lane == 0) misc[16 + wave] = m;
    __syncthreads();
    m = fmaxf(fmaxf(fmaxf(misc[16], misc[17]), fmaxf(misc[18], misc[19])), fmaxf(fmaxf(misc[20], misc[21]), fmaxf(misc[22], misc[23])));
    float sm = 0.f;
    for (int i = t; i < NKEY; i += NWAVES * 64) { const float p = __builtin_amdgcn_exp2f(sc[i] - m); sc[i] = p; sm += p; }
    sm = wave_sum(sm); if (F.lane == 0) misc[24 + wave] = sm;
    __syncthreads();
    const float tot = ((misc[24] + misc[25]) + (misc[26] + misc[27])) + ((misc[28] + misc[29]) + (misc[30] + misc[31]));
    f32x4 acc = (f32x4){0.f, 0.f, 0.f, 0.f};
#pragma unroll
    for (int sg = 0; sg < NSEG; ++sg) {
        const float* vb = MOBA ? F.cache_v() + (size_t)segs[sg] * 32768 + kvh * 64 : F.cache_mem_v() + ((size_t)((l * NS + s) * 256 + sg * 128)) * 256 + hd * 64;
        f32x4 vv[4];
#pragma unroll
        for (int i = 0; i < 4; ++i) vv[i] = *(const f32x4*)(vb + (size_t)(i * 32 + rg) * 256 + 4 * lq);
#pragma unroll
        for (int i = 0; i < 4; ++i) acc += vv[i] * sc[sg * 128 + i * 32 + rg];
    }
    if (MOBA && rg == 0) { const f32x4 vn = *(const f32x4*)(F.out() + OFF_SV + (size_t)s * 256 + kvh * 64 + 4 * lq); acc += vn * sc[NSEG * 128]; }
    *(LAS f32x4*)(red + rg * 64 + 4 * lq) = acc;
    __syncthreads();
    if (t < 64) { float o = 0.f;
#pragma unroll 8
        for (int r = 0; r < 32; ++r) o += red[r * 64 + t];
        F.mixo(l)[row * DM + qcol + t] = (bf16)cvtpk(o * __builtin_amdgcn_rcpf(tot), 0.f); }
}

template <int NQ>
__device__ __forceinline__ f32x4 skinny_tile(const bf16* __restrict__ A, const bf16* __restrict__ Bt, int K, int row0, int n0, LAS unsigned char* lds, int tid) {
    const int lane = tid & 63, wave = __builtin_amdgcn_readfirstlane(tid >> 6), fr = lane & 15, fq = lane >> 4;
    const int kw = K >> 3, nks = kw >> 5;
    const bf16* ap = A + (size_t)(row0 + fr) * K + wave * kw + 8 * fq;
    const bf16* bp = Bt + (size_t)(n0 + fr) * K + wave * kw + 8 * fq;
    f32x4 acc[4];
#pragma unroll
    for (int c = 0; c < 4; ++c) acc[c] = (f32x4){0.f, 0.f, 0.f, 0.f};
    for (int ks0 = 0; ks0 < nks; ks0 += NQ) {
        bf16x8 a[NQ], b[NQ][4];
#pragma unroll
        for (int q = 0; q < NQ; ++q) { const int ks = (ks0 + q < nks) ? ks0 + q : nks - 1; a[q] = *(const bf16x8*)(ap + ks * 32);
#pragma unroll
            for (int c = 0; c < 4; ++c) b[q][c] = *(const bf16x8*)(bp + (size_t)(16 * c) * K + ks * 32); }
#pragma unroll
        for (int q = 0; q < NQ; ++q) { if (ks0 + q < nks) {
#pragma unroll
            for (int c = 0; c < 4; ++c) acc[c] = __builtin_amdgcn_mfma_f32_16x16x32_bf16(b[q][c], a[q], acc[c], 0, 0, 0); } }
    }
    __syncthreads();
#pragma unroll
    for (int c = 0; c < 4; ++c) *(LAS f32x4*)(lds + wave * 4096 + c * 1024 + lane * 16) = acc[c];
    __syncthreads();
    f32x4 r = (f32x4){0.f, 0.f, 0.f, 0.f};
    if (tid < 256) { const int row = tid >> 4, c4 = tid & 15, L = (c4 & 3) * 16 + row, cg = c4 >> 2;
#pragma unroll
        for (int w = 0; w < 8; ++w) r += *(const LAS f32x4*)(lds + w * 4096 + cg * 1024 + L * 16); }
    return r;
}
__device__ __forceinline__ void skinny_proj(const Frame& F, int l, int tile) {
    const int tid = F.otid(), rg = tile & 7, cs = tile >> 3, row0 = MP + 16 * rg, n0 = 64 * cs;
    const f32x4 v = skinny_tile<4>(l == 0 ? F.hb0() : F.hbb(l - 1), wcat(F, l), DM, row0, n0, F.lds, tid);
    if (tid < 256) { const int row = row0 + (tid >> 4), c4 = tid & 15;
        const float rs = __builtin_amdgcn_rsqf(sum16((l == 0 ? F.ssq0() : F.ssqa(l - 1))[(size_t)row * 16 + c4]) * (1.0f / 1024.0f) + EPS);
        if (n0 < DM) { u32x2 w; w.x = cvtpk(v[0] * rs, v[1] * rs); w.y = cvtpk(v[2] * rs, v[3] * rs); *(u32x2*)(F.proj(l) + (size_t)row * DM + n0 + 4 * c4) = w; }
        else *(f32x4*)(F.kvraw() + (size_t)row * 512 + (n0 - DM) + 4 * c4) = v * rs; }
}
__device__ __forceinline__ void skinny_resid(const Frame& F, const bf16* A, const bf16* Bt, int K, const float* xin, const bf16* hin, bf16* hout, float* ssq_out, bool last, int tile) {
    const int tid = F.otid(), rg = tile & 7, cs = tile >> 3, row0 = MP + 16 * rg, n0 = 64 * cs;
    const f32x4 v = K > 1024 ? skinny_tile<6>(A, Bt, K, row0, n0, F.lds, tid) : skinny_tile<4>(A, Bt, K, row0, n0, F.lds, tid);
    if (tid < 256) { const int row = row0 + (tid >> 4), c4 = tid & 15; const size_t off = (size_t)row * DM + n0 + 4 * c4; f32x4 hn;
        if (xin) hn = *(const f32x4*)(xin + off - (size_t)MP * DM); else { const u32x2 hw = *(const u32x2*)(hin + off); hn = (f32x4){bflo(hw.x), bfhi(hw.x), bflo(hw.y), bfhi(hw.y)}; }
        hn += v;
        if (last) *(f32x4*)(F.out() + OFF_Y + off) = hn;
        u32x2 w; w.x = cvtpk(hn[0], hn[1]); w.y = cvtpk(hn[2], hn[3]); *(u32x2*)(hout + off) = w;
        const float ss = sum16((hn[0] * hn[0] + hn[1] * hn[1]) + (hn[2] * hn[2] + hn[3] * hn[3]));
        if (c4 == 0) ssq_out[(size_t)row * 16 + cs] = ss; }
}

__device__ __forceinline__ float row16_sum_to_lane15(float v) {
    v += __builtin_bit_cast(float, __builtin_amdgcn_update_dpp(0, __builtin_bit_cast(int, v), 0x111, 0xf, 0xf, true));
    v += __builtin_bit_cast(float, __builtin_amdgcn_update_dpp(0, __builtin_bit_cast(int, v), 0x112, 0xf, 0xf, true));
    v += __builtin_bit_cast(float, __builtin_amdgcn_update_dpp(0, __builtin_bit_cast(int, v), 0x114, 0xf, 0xf, true));
    v += __builtin_bit_cast(float, __builtin_amdgcn_update_dpp(0, __builtin_bit_cast(int, v), 0x118, 0xf, 0xf, true));
    return v;
}
template <bool MOBA>
__device__ __forceinline__ void decode_wave(const Frame& F, int l, int s, int hd, LAS unsigned char* wl) {
    LAS float* sc = (LAS float*)wl; LAS float* gate = (LAS float*)(wl + 3200); LAS int* segs = (LAS int*)(wl + 3264);
    const int lane = F.otid() & 63, rg = lane >> 4, lq = lane & 15; const bool wr15 = lq == 15;
    const size_t row = MP + s; const int qcol = MOBA ? hd * 64 : MIXW + hd * 64, kvh = MOBA ? hd / 3 : hd;
    const float* gq = MOBA ? F.g_q() + (l - 2) * 64 : F.g_mq() + l * 64;
    const u32x2 qw = *(const u32x2*)(F.proj(l) + row * DM + qcol + 4 * lq);
    float q0 = bflo(qw.x), q1 = bfhi(qw.x), q2 = bflo(qw.y), q3 = bfhi(qw.y);
    { const float ss = sum16((q0 * q0 + q1 * q1) + (q2 * q2 + q3 * q3)); const float rs = __builtin_amdgcn_rsqf(ss * (1.0f / 64.0f) + EPS) * C2; const f32x4 g4 = *(const f32x4*)(gq + 4 * lq);
      q0 *= rs * g4[0]; q1 *= rs * g4[1]; q2 *= rs * g4[2]; q3 *= rs * g4[3]; }
    constexpr int NSEG = MOBA ? 6 : 2, NKEY = NSEG * 128 + (MOBA ? 1 : 0);
    if (MOBA) {
#pragma unroll
        for (int h2 = 0; h2 < 2; ++h2) { const int blk = rg + 4 * h2; const f32x4 km = *(const f32x4*)(F.kmeans() + ((size_t)(s * 8 + blk)) * 256 + kvh * 64 + 4 * lq);
            const float d = row16_sum_to_lane15((q0 * km[0] + q1 * km[1]) + (q2 * km[2] + q3 * km[3])); if (wr15) gate[blk] = d; }
        float g0 = gate[0], g1 = gate[1], g2 = gate[2], g3 = gate[3], g4 = gate[4], g5 = gate[5], g6 = gate[6], g7 = gate[7]; unsigned selm = 0u;
#pragma unroll
        for (int k = 0; k < 3; ++k) { float best = g0; int bi = 0;
            if (g1 > best) { best = g1; bi = 1; } if (g2 > best) { best = g2; bi = 2; } if (g3 > best) { best = g3; bi = 3; } if (g4 > best) { best = g4; bi = 4; } if (g5 > best) { best = g5; bi = 5; } if (g6 > best) { best = g6; bi = 6; } if (g7 > best) { best = g7; bi = 7; }
            selm |= 1u << bi; const float NI = -INFINITY;
            g0 = bi == 0 ? NI : g0; g1 = bi == 1 ? NI : g1; g2 = bi == 2 ? NI : g2; g3 = bi == 3 ? NI : g3; g4 = bi == 4 ? NI : g4; g5 = bi == 5 ? NI : g5; g6 = bi == 6 ? NI : g6; g7 = bi == 7 ? NI : g7; }
        if (lane == 0) { int n = 0; for (int jb = 0; jb < 8; ++jb) if ((selm >> jb) & 1u) { segs[n++] = F.page_table()[s * 16 + 2 * jb]; segs[n++] = F.page_table()[s * 16 + 2 * jb + 1]; } }
    }
    const float* const kc = MOBA ? F.cache_k() : F.cache_mem_k(); const float* const vc = MOBA ? F.cache_v() : F.cache_mem_v();
#pragma unroll 1
    for (int sg = 0; sg < NSEG; ++sg) {
        const float* kb = (MOBA ? kc + (size_t)segs[sg] * 32768 + kvh * 64 : kc + ((size_t)((l * NS + s) * 256 + sg * 128)) * 256 + hd * 64) + (size_t)rg * 256 + 4 * lq;
        constexpr int NB = MOBA ? 16 : 32;
#pragma unroll
        for (int hb2 = 0; hb2 < 32 / NB; ++hb2) { f32x4 kv[NB];
#pragma unroll
            for (int i = 0; i < NB; ++i) kv[i] = *(const f32x4*)(kb + (size_t)(hb2 * 64 + 4 * i) * 256);
#pragma unroll
            for (int i = 0; i < NB; ++i) { const float d = row16_sum_to_lane15((q0 * kv[i][0] + q1 * kv[i][1]) + (q2 * kv[i][2] + q3 * kv[i][3])); if (wr15) sc[sg * 128 + hb2 * 64 + 4 * i + rg] = d; } }
    }
    if (MOBA) { const f32x4 kn = *(const f32x4*)(F.out() + OFF_SK + (size_t)s * 256 + kvh * 64 + 4 * lq); const float d = row16_sum_to_lane15((q0 * kn[0] + q1 * kn[1]) + (q2 * kn[2] + q3 * kn[3])); if (lane == 15) sc[NSEG * 128] = d; }
    float m = -INFINITY;
    for (int i = lane; i < NKEY; i += 64) m = fmaxf(m, sc[i]);
    m = wave_max(m);
    float sm = 0.f;
    for (int i = lane; i < NKEY; i += 64) { const float p = __builtin_amdgcn_exp2f(sc[i] - m); sc[i] = p; sm += p; }
    sm = wave_sum(sm);
    f32x4 acc = (f32x4){0.f, 0.f, 0.f, 0.f};
#pragma unroll 1
    for (int sg = 0; sg < NSEG; ++sg) {
        const float* vb = (MOBA ? vc + (size_t)segs[sg] * 32768 + kvh * 64 : vc + ((size_t)((l * NS + s) * 256 + sg * 128)) * 256 + hd * 64) + (size_t)rg * 256 + 4 * lq;
        constexpr int NB = MOBA ? 16 : 32;
#pragma unroll
        for (int hb2 = 0; hb2 < 32 / NB; ++hb2) { f32x4 vv[NB];
#pragma unroll
            for (int i = 0; i < NB; ++i) vv[i] = *(const f32x4*)(vb + (size_t)(hb2 * 64 + 4 * i) * 256);
#pragma unroll
            for (int i = 0; i < NB; ++i) acc += vv[i] * sc[sg * 128 + hb2 * 64 + 4 * i + rg]; }
    }
    if (MOBA && rg == 0) { const f32x4 vn = *(const f32x4*)(F.out() + OFF_SV + (size_t)s * 256 + kvh * 64 + 4 * lq); acc += vn * sc[NSEG * 128]; }
#pragma unroll
    for (int e = 0; e < 4; ++e) { acc[e] += __shfl_xor(acc[e], 16); acc[e] += __shfl_xor(acc[e], 32); }
    if (lane < 16) { const float inv = __builtin_amdgcn_rcpf(sm); u32x2 w; w.x = cvtpk(acc[0] * inv, acc[1] * inv); w.y = cvtpk(acc[2] * inv, acc[3] * inv); *(u32x2*)(F.mixo(l) + row * DM + qcol + 4 * lq) = w; }
}


constexpr int N_PHASES = 29;
__host__ __device__ constexpr bool phase_exists(int p) { if (p == 0) return true; const int l = (p - 1) / 7, k = (p - 1) % 7; if (k == 1) return l == 0 || l == 2; if (k == 3) return l < 2; return true; }

__global__ void __launch_bounds__(NWAVES * 64, 2) fwd(Args args) {
    extern __shared__ __attribute__((aligned(16))) unsigned char lds[];
    Frame F;
    F.lds = (LAS unsigned char*)lds; F.MISC = (volatile LAS unsigned*)(F.lds + MISC_OFF);
    F.tid = threadIdx.x; F.lane = F.tid & 63; F.wave = __builtin_amdgcn_readfirstlane(F.tid >> 6);
    F.G = gridDim.x; { const int bx = blockIdx.x; F.vcu = (F.G % 8 == 0) ? (bx % 8) * (F.G / 8) + bx / 8 : bx; }
    F.ap = (const __attribute__((address_space(4))) Args*)__builtin_amdgcn_kernarg_segment_ptr(); F.ctl = (gu32*)(args.ws + WS_CTL);
    for (int u = F.tid; u < (LDS_BYTES - LDSCTL_OFF) / 4; u += NWAVES * 64) ((LAS unsigned*)(F.lds + LDSCTL_OFF))[u] = 0u;
    __syncthreads();
    XcdBarrier bar = xcd_barrier_post((unsigned*)(F.ctl + CW_BAR) + args.li * XCD_BAR_WORDS, F.MISC + 8);
    const int lo = args.ph_lo, hi = args.ph_hi;
#define IN(p) (lo <= (p) && (p) < hi)
#define SEAM(p) do { if ((p) + 1 < hi) xcd_barrier(bar); } while (0)

    if (IN(0)) {
        if (hi - lo > 1) xcd_barrier(bar);
#ifdef L2INV
        if (hi - lo > 1) { if (threadIdx.x == 0) asm volatile("buffer_inv sc0 sc1\n\ts_waitcnt vmcnt(0)" ::: "memory"); xcd_barrier(bar); }
#endif
        p0_prologue(F); SEAM(0); }

    for (int l = 0; l < 4; ++l) {
        const int pb = 1 + 7 * l;
        if (IN(pb)) {
            pg8::Gemm g{l == 0 ? F.hb0() : F.hbb(l - 1), wcat(F, l), AROWS, 0, DM};
            pg8::ListSched S; S.init(NPP, l == 2 ? 6 : 4, NPT, l == 0 ? 4 : 0, 4, 8, F.G, (int)blockIdx.x);
            pg8::EpiProj E{l == 0 ? F.ssq0() : F.ssqa(l - 1), F.proj(l), F.kvraw(), F.kmraw(), F.out() + OFF_PMV, NPT};
            pg8::gemm_phase<pg8::EpiProj, pg8::ListSched, true, true>(F.lds, g, S, E);
            for (int tl = (int)blockIdx.x - 128; tl >= 0 && tl < (l == 2 ? 192 : 128); tl += 128) skinny_proj(F, l, tl);
            if (l == 2 && (int)blockIdx.x >= 128) sample_kmeans(F, 684, NS * 8, (int)blockIdx.x - 128, F.G - 128);
            SEAM(pb);
        }
        if (l < 2) {
            if (l == 0 && IN(pb + 1)) { memkv_norm(F); SEAM(pb + 1); }
            if (IN(pb + 2)) {
                const int skipm = args.pad;
                if (skipm & 4) {} else if (F.vcu < NBATCH * NG) { const int b = F.vcu / NG, g = F.vcu % NG; LAS float* elds = (LAS float*)(F.lds + NWAVES * XS_WAVE);
                    s5_item<false>(F, l, b, g, F.wave, nullptr, elds);
                    __syncthreads();
                    s5_item<true>(F, l, b, g, F.wave, F.lds + F.wave * XS_WAVE, elds);
                } else if (!(skipm & 16)) { const int a = F.vcu - NBATCH * NG, na = F.G - NBATCH * NG;
                    for (int it = a * NWAVES + F.wave; it < NS * 4; it += na * NWAVES) decode_wave<false>(F, l, it >> 2, it & 3, F.lds + F.wave * 4096); }
                if (!(skipm & 8)) { const int gw = F.vcu * NWAVES + F.wave;
                    if (F.G * NWAVES == 2048) {
                        if (gw < 42 * NG) s5_sample3(F, l, gw % NG, gw / NG);
                        else for (int it = gw - 42 * NG; it < 2 * NG; it += 32) s5_sample(F, l, 126 + it / NG, it % NG);
                    } else for (int it = gw; it < NS * NG; it += F.G * NWAVES) s5_sample(F, l, it / NG, it % NG); }
                if (!(skipm & 32)) { gu32* qm = F.ctl + CW_QUEUE + (64 + l + 4 * args.li) * 64; unsigned nxt = 0u;
                  if (F.tid == 0) nxt = __hip_atomic_fetch_add(qm, 1u, RLX_AGENT);
                  for (int itn = 0;; ++itn) {
                      if (F.tid == 0) F.MISC[16 + (itn & 1)] = nxt;
                      __syncthreads();
                      const unsigned u = (unsigned)__builtin_amdgcn_readfirstlane((int)F.MISC[16 + (itn & 1)]);
                      if (u >= 256u) break;
                      if (F.tid == 0) nxt = __hip_atomic_fetch_add(qm, 1u, RLX_AGENT);
                      const int b = u >> 6, mh = (u >> 4) & 3, qb = u & 15; const size_t row0 = (size_t)b * SEQ + qb * 256;
                      attn_body::attn_unit<0, 8>(qb, F.proj(l) + row0 * DM + MIXW + mh * 64, F.memkb() + ((size_t)(l * MEMR + b * 256)) * 256 + mh * 64, F.memvb() + ((size_t)(l * MEMR + b * 256)) * 256 + mh * 64,
                                                 F.mixo(l) + row0 * DM + MIXW + mh * 64, F.g_mq() + l * 64, nullptr, (char*)lds); } }
                SEAM(pb + 2);
            }
            if (IN(pb + 3)) {
                pg8::Gemm g{F.ybuf(l), (const bf16*)(F.wsb() + WS_WGLU + (size_t)l * WGLU_STRIDE), MROWS, MIXW, MIXW};
                pg8::ListSched S; S.init(NPT, 3, 0, 0, 0, 0, F.G, (int)blockIdx.x);
                pg8::EpiGlu E{F.ybuf(l), F.mixo(l)};
                pg8::gemm_phase<pg8::EpiGlu, pg8::ListSched, true, true>(F.lds, g, S, E);
                SEAM(pb + 3);
            }
        } else {
            if (l == 2 && IN(pb + 1)) { kv_norm(F); SEAM(pb + 1); }
            if (IN(pb + 2)) {
                gu32* qa = F.ctl + CW_QUEUE + ((l - 2) + 2 * args.li) * 128; gu32* qd = qa + 64;
                constexpr unsigned NA = NBATCH * NQH * 16 + 256, NDB = (NS * NQH) / 8 + (NS * 4) / 8;
                int curq = (F.vcu < ND_FIRST) ? 1 : 0; bool switched = false; unsigned nxt = 0u;
                if (F.tid == 0) nxt = __hip_atomic_fetch_add(curq ? qd : qa, 1u, RLX_AGENT);
                for (int itn = 0;; ++itn) {
                    if (F.tid == 0) F.MISC[16 + (itn & 1)] = nxt;
                    __syncthreads();
                    const unsigned idx = (unsigned)__builtin_amdgcn_readfirstlane((int)F.MISC[16 + (itn & 1)]);
                    if (idx >= (curq ? NDB : NA)) { if (switched) break; switched = true; curq ^= 1; if (F.tid == 0) nxt = __hip_atomic_fetch_add(curq ? qd : qa, 1u, RLX_AGENT); continue; }
                    if (F.tid == 0) nxt = __hip_atomic_fetch_add(curq ? qd : qa, 1u, RLX_AGENT);
                    if (curq == 0) {
                        if (idx < (unsigned)(NBATCH * NQH * 16)) { const int qb = 15 - (int)(idx / 48u), bh = (int)(idx % 48u), b = bh / NQH, hq = bh % NQH, kvh = hq / 3; const size_t row0 = (size_t)b * SEQ + qb * 256;
                            attn_body::attn_unit<1, 8>(qb, F.proj(l) + row0 * DM + hq * 64, F.kbuf() + ((size_t)b * SEQ) * 256 + kvh * 64, F.vbuf() + ((size_t)b * SEQ) * 256 + kvh * 64,
                                                       F.mixo(l) + row0 * DM + hq * 64, F.g_q() + (l - 2) * 64, F.kmeanp() + ((size_t)b * 16) * 256 + kvh * 64, (char*)lds); }
                        else { const int u = (int)idx - NBATCH * NQH * 16, b = u >> 6, mh = (u >> 4) & 3, qb = u & 15; const size_t row0 = (size_t)b * SEQ + qb * 256;
                            attn_body::attn_unit<0, 8>(qb, F.proj(l) + row0 * DM + MIXW + mh * 64, F.memkb() + ((size_t)(l * MEMR + b * 256)) * 256 + mh * 64, F.memvb() + ((size_t)(l * MEMR + b * 256)) * 256 + mh * 64,
                                                       F.mixo(l) + row0 * DM + MIXW + mh * 64, F.g_mq() + l * 64, nullptr, (char*)lds); }
                    } else {
                        if (idx < (unsigned)((NS * NQH) / 8)) { const int it = (int)idx * 8 + F.wave; decode_wave<true>(F, l, it / NQH, it % NQH, F.lds + F.wave * 4096); }
                        else { const int it = ((int)idx - (NS * NQH) / 8) * 8 + F.wave; decode_wave<false>(F, l, it >> 2, it & 3, F.lds + F.wave * 4096); }
                    }
                }
                SEAM(pb + 2);
            }
        }
        if (IN(pb + 4)) {
            pg8::Gemm g{F.mixo(l), (const bf16*)(F.wsb() + WS_WOUT + (size_t)l * 2 * MiB), MROWS, DM, DM};
            pg8::ListSched S; S.init(NPP, 4, 0, 0, 0, 0, F.G, (int)blockIdx.x);
            pg8::EpiResid E{l == 0 ? F.x_prompt() : nullptr, l == 0 ? nullptr : F.hbb(l - 1), F.hba(l), F.ssqb(l), nullptr};
            pg8::gemm_phase<pg8::EpiResid, pg8::ListSched, true, true>(F.lds, g, S, E);
            for (int tl = F.vcu; tl < 128; tl += F.G) skinny_resid(F, F.mixo(l), (const bf16*)(F.wsb() + WS_WOUT + (size_t)l * 2 * MiB), DM, l == 0 ? F.x_sample() : nullptr, l == 0 ? nullptr : F.hbb(l - 1), F.hba(l), F.ssqb(l), false, tl);
            SEAM(pb + 4);
        }
        if (IN(pb + 5)) {
            pg8::Gemm g{F.hba(l), (const bf16*)(F.wsb() + WS_WGU + (size_t)l * WGU_STRIDE), MROWS, 2 * DFF, DM};
            pg8::ListSched S; S.init(NPT, 22, 0, 0, 0, 0, F.G, (int)blockIdx.x);
            pg8::EpiSwiglu E{F.ssqb(l), F.ffh(l)};
            pg8::gemm_phase<pg8::EpiSwiglu, pg8::ListSched, true, true>(F.lds, g, S, E);
            if (l < 2 && (int)blockIdx.x >= 150) sample_kmeans(F, 342 * l, 342 * l + 342, (int)blockIdx.x - 150, F.G - 150);
            SEAM(pb + 5);
        }
        if (IN(pb + 6)) {
            pg8::Gemm g{F.ffh(l), (const bf16*)(F.wsb() + WS_WDOWN + (size_t)l * WDOWN_STRIDE), MROWS, DM, DFF};
            pg8::ListSched S; S.init(NPP, 4, 0, 0, 0, 0, F.G, (int)blockIdx.x);
            pg8::EpiResid E{nullptr, F.hba(l), F.hbb(l), F.ssqa(l), l == 3 ? F.out() + OFF_Y : nullptr};
            pg8::gemm_phase<pg8::EpiResid, pg8::ListSched, true, true>(F.lds, g, S, E);
            for (int tl = F.vcu; tl < 128; tl += F.G) skinny_resid(F, F.ffh(l), (const bf16*)(F.wsb() + WS_WDOWN + (size_t)l * WDOWN_STRIDE), DFF, nullptr, F.hba(l), F.hbb(l), F.ssqa(l), l == 3, tl);
            SEAM(pb + 6);
        }
    }
    if (hi - lo > 1) xcd_barrier(bar);
#undef IN
#undef SEAM
}

#ifndef MK_ONE_LAUNCH
#define MK_ONE_LAUNCH 0
#endif
extern "C" void kernel_launch(void* const* d_in, const int* in_sizes, int n_in, void* d_out, int out_size, void* d_ws, size_t ws_size, hipStream_t stream) {
    static int grid = 0;
    if (grid == 0) {
        if (n_in != 33 || out_size != (int)OUT_TOTAL || ws_size < WS_END) { fprintf(stderr, "kernel_launch: unexpected shapes: n_in %d out %d ws %zu; nothing launched\n", n_in, out_size, ws_size); grid = -1; return; }
        int dev = 0, cus = 0, per_cu = 0;
        if (hipGetDevice(&dev) != hipSuccess || hipDeviceGetAttribute(&cus, hipDeviceAttributeMultiprocessorCount, dev) != hipSuccess) { fprintf(stderr, "kernel_launch: device query failed\n"); grid = -1; return; }
        if (hipFuncSetAttribute((const void*)fwd, hipFuncAttributeMaxDynamicSharedMemorySize, LDS_BYTES) != hipSuccess) { fprintf(stderr, "kernel_launch: hipFuncSetAttribute failed\n"); grid = -1; return; }
        if (hipOccupancyMaxActiveBlocksPerMultiprocessor(&per_cu, (const void*)fwd, NWAVES * 64, LDS_BYTES) != hipSuccess || per_cu < 1) fprintf(stderr, "kernel_launch: note: occupancy query reports %d workgroups per CU\n", per_cu);
        (void)hipGetLastError();
        grid = cus;
    }
    if (grid < 0) return;
    if (hipMemsetAsync((char*)d_ws + WS_CTL, 0, CTL_ZERO_BYTES, stream) != hipSuccess) { fprintf(stderr, "kernel_launch: memset failed\n"); return; }
    Args a{};
    for (int i = 0; i < 33; ++i) a.in[i] = d_in[i];
    a.out = (float*)d_out; a.ws = (unsigned char*)d_ws; a.pad = 0;
    if (MK_ONE_LAUNCH) {
        a.ph_lo = 0; a.ph_hi = N_PHASES; a.li = 0;
        hipLaunchKernelGGL(fwd, dim3(grid), dim3(NWAVES * 64), LDS_BYTES, stream, a);
        const hipError_t le = hipPeekAtLastError(); if (le != hipSuccess) fprintf(stderr, "kernel_launch: launch failed: %s\n", hipGetErrorName(le));
    } else {
        int li = 0;
        for (int p = 0; p < N_PHASES; ++p) { if (!phase_exists(p)) continue;
            a.ph_lo = p; a.ph_hi = p + 1; a.li = li++;
            hipLaunchKernelGGL(fwd, dim3(grid), dim3(NWAVES * 64), LDS_BYTES, stream, a);
            const hipError_t le = hipPeekAtLastError(); if (le != hipSuccess) { fprintf(stderr, "kernel_launch: launch %d failed: %s\n", p, hipGetErrorName(le)); break; } }
    }
}
```
